# Optimizing an MI355X kernel written in HIP

```python
import math
import jax
import jax.numpy as jnp
from jax import lax
import numpy as np

D_MODEL = 1024
BATCH = 8
SEQ = 2048
DEPTH = 2

GRID_W = 64
CTX_LEN = 256
HEAD_DIM = 64
DIFF_HEADS = 4
DIFF_V_DIM = 2 * HEAD_DIM
NA_HEADS = 8
NA_KH = 8
NA_KW = 16
Q_BLOCK = 128
ROPE_BASE = 10000.0
ROPE_AXIS_DIM = HEAD_DIM // 2
SSM_GROUP = 16
SSM_GROUPS = D_MODEL // SSM_GROUP
SSM_STATE = 64
MLP_HIDDEN = 4 * D_MODEL
N_EVEN = (DEPTH + 1) // 2
N_ODD = DEPTH // 2
A_QK = DIFF_HEADS * 2 * HEAD_DIM
A_V = DIFF_HEADS * DIFF_V_DIM
B_QKV = NA_HEADS * HEAD_DIM
IN_PROJ = 2 * A_QK + A_V + 3 * B_QKV
MIX_OUT = A_V + B_QKV
NORM_EPS = 1e-6
SUBLN_EPS = 1e-5

kernel_name = 'hybrid_diffattn_natten_s5_block'


def _rmsnorm(x, g, eps):
    xf = x.astype(jnp.float32)
    y = xf * lax.rsqrt(jnp.mean(xf * xf, axis=-1, keepdims=True) + eps)
    return (y * g.astype(jnp.float32)).astype(x.dtype)


def _rotate(x, cos, sin):
    half = x.shape[-1] // 2
    x1, x2 = x[..., :half], x[..., half:]
    cos = cos.astype(x.dtype)
    sin = sin.astype(x.dtype)
    return jnp.concatenate([x1 * cos - x2 * sin, x2 * cos + x1 * sin], axis=-1)


def _rope2d(x, cos_r, sin_r, cos_c, sin_c):
    return jnp.concatenate([_rotate(x[..., :ROPE_AXIS_DIM], cos_r, sin_r),
                            _rotate(x[..., ROPE_AXIS_DIM:], cos_c, sin_c)], axis=-1)


def _rope_tables(seq):
    t = jnp.arange(seq)
    row = (t // GRID_W).astype(jnp.float32)
    col = (t % GRID_W).astype(jnp.float32)
    n_freq = ROPE_AXIS_DIM // 2
    inv_freq = ROPE_BASE ** (-jnp.arange(n_freq, dtype=jnp.float32) / n_freq)
    ang_r = (row[:, None] * inv_freq[None, :]).reshape(seq, 1, 1, n_freq)
    ang_c = (col[:, None] * inv_freq[None, :]).reshape(seq, 1, 1, n_freq)
    return (jnp.cos(ang_r), jnp.sin(ang_r), jnp.cos(ang_c), jnp.sin(ang_c))


def _split_proj(p):
    b, n, _ = p.shape
    qa = p[..., 0:A_QK].reshape(b, n, DIFF_HEADS, 2, HEAD_DIM)
    ka = p[..., A_QK:2 * A_QK].reshape(b, n, DIFF_HEADS, 2, HEAD_DIM)
    va = p[..., 2 * A_QK:2 * A_QK + A_V].reshape(b, n, DIFF_HEADS, DIFF_V_DIM)
    base = 2 * A_QK + A_V
    qn = p[..., base:base + B_QKV].reshape(b, n, NA_HEADS, HEAD_DIM)
    kn = p[..., base + B_QKV:base + 2 * B_QKV].reshape(b, n, NA_HEADS, HEAD_DIM)
    vn = p[..., base + 2 * B_QKV:base + 3 * B_QKV].reshape(b, n, NA_HEADS, HEAD_DIM)
    return qa, ka, va, qn, kn, vn


def _diff_attend(q, k, v, lam, lam_init, g):
    s = jnp.einsum('bqhmd,bkhmd->bhmqk', q, k).astype(jnp.float32) * (HEAD_DIM ** -0.5)
    p = jax.nn.softmax(s, axis=-1)
    a = p[:, :, 0] - lam * p[:, :, 1]
    o = jnp.einsum('bhqk,bkhe->bqhe', a.astype(v.dtype), v)
    return _rmsnorm(o, g, SUBLN_EPS) * (1.0 - lam_init)


def _dense_attend(q, k, v):
    s = jnp.einsum('bqhd,bkhd->bhqk', q, k).astype(jnp.float32) * (HEAD_DIM ** -0.5)
    p = jax.nn.softmax(s, axis=-1)
    return jnp.einsum('bhqk,bkhd->bqhd', p.astype(v.dtype), v)


def _na_latent(qn, kn, vn, kc, vc, rpb, rows):
    b, s, h, d = qn.shape

    def grid(t):
        return t.reshape(b, rows, GRID_W, h, d).transpose(0, 3, 1, 2, 4)

    qg, kg, vg = grid(qn), grid(kn), grid(vn)
    kc_h = kc.transpose(0, 2, 1, 3)
    vc_h = vc.transpose(0, 2, 1, 3)
    kh = min(NA_KH, rows)
    kw = NA_KW
    col_q = jnp.arange(GRID_W)
    col_start = jnp.clip(col_q - kw // 2, 0, GRID_W - kw)
    col_idx = col_start[:, None] + jnp.arange(kw)[None, :]
    col_off = col_idx - col_q[:, None] + (NA_KW - 1)
    rpb_cols = rpb[:, :, col_off]
    scale = HEAD_DIM ** -0.5
    n_win = kh * kw

    def row_block(r):
        r_start = jnp.clip(r - kh // 2, 0, rows - kh)
        row_off = r_start + jnp.arange(kh) - r + (NA_KH - 1)
        q_r = lax.dynamic_index_in_dim(qg, r, axis=2, keepdims=False)
        k_band = lax.dynamic_slice_in_dim(kg, r_start, kh, axis=2)
        v_band = lax.dynamic_slice_in_dim(vg, r_start, kh, axis=2)
        k_win = k_band[:, :, :, col_idx]
        v_win = v_band[:, :, :, col_idx]
        bias = jnp.take(rpb_cols, row_off, axis=1).transpose(0, 2, 1, 3)
        s_win = jnp.einsum('bhqd,bhrqcd->bhqrc', q_r, k_win).astype(jnp.float32) * scale + bias.astype(jnp.float32)[None]
        s_ctx = jnp.einsum('bhqd,bhkd->bhqk', q_r, kc_h).astype(jnp.float32) * scale
        p = jax.nn.softmax(jnp.concatenate([s_win.reshape(b, h, GRID_W, n_win), s_ctx], axis=-1), axis=-1)
        p_win = p[..., :n_win].reshape(b, h, GRID_W, kh, kw).astype(vg.dtype)
        p_ctx = p[..., n_win:].astype(vg.dtype)
        return (jnp.einsum('bhqrc,bhrqcd->bhqd', p_win, v_win)
                + jnp.einsum('bhqk,bhkd->bhqd', p_ctx, vc_h))

    o = lax.map(row_block, jnp.arange(rows))
    return o.transpose(1, 0, 3, 2, 4).reshape(b, s, h * d)


def _even_mixer(h, hc, w_in_e, w_out_e, lq1, lk1, lq2, lk2, g_sub, rpb, rope, lam_init, rows, need_ctx):
    b, s, _ = h.shape
    lc = hc.shape[1]
    qa, ka, va, qn, kn, vn = _split_proj(h @ w_in_e)
    qac, kac, vac, qnc, knc, vnc = _split_proj(hc @ w_in_e)
    qa = _rope2d(qa, *rope)
    ka = _rope2d(ka, *rope)
    lam = (jnp.exp(jnp.sum(lq1.astype(jnp.float32) * lk1.astype(jnp.float32)))
           - jnp.exp(jnp.sum(lq2.astype(jnp.float32) * lk2.astype(jnp.float32))) + lam_init)
    k_all = jnp.concatenate([ka, kac], axis=1)
    v_all = jnp.concatenate([va, vac], axis=1)
    nb = s // Q_BLOCK
    qb = qa.reshape(b, nb, Q_BLOCK, DIFF_HEADS, 2, HEAD_DIM).swapaxes(0, 1)
    oa = lax.map(lambda qq: _diff_attend(qq, k_all, v_all, lam, lam_init, g_sub), qb)
    oa = oa.swapaxes(0, 1).reshape(b, s, A_V)
    ob = _na_latent(qn, kn, vn, knc, vnc, rpb, rows)
    y = jnp.concatenate([oa, ob], axis=-1) @ w_out_e
    yc = None
    if need_ctx:
        oac = _diff_attend(qac, kac, vac, lam, lam_init, g_sub).reshape(b, lc, A_V)
        obc = _dense_attend(qnc, knc, vnc).reshape(b, lc, B_QKV)
        yc = jnp.concatenate([oac, obc], axis=-1) @ w_out_e
    return y, yc


def _zoh(lam_re, lam_im, log_step, b_re, b_im):
    lr = lam_re.astype(jnp.float32)
    li = lam_im.astype(jnp.float32)
    delta = jnp.exp(log_step.astype(jnp.float32))[:, None]
    mag = jnp.exp(lr * delta)
    ar = mag * jnp.cos(li * delta)
    ai = mag * jnp.sin(li * delta)
    den = lr * lr + li * li
    nr = ar - 1.0
    cr = (nr * lr + ai * li) / den
    ci = (ai * lr - nr * li) / den
    br = b_re.astype(jnp.float32)
    bi = b_im.astype(jnp.float32)
    bbr = cr[..., None] * br - ci[..., None] * bi
    bbi = cr[..., None] * bi + ci[..., None] * br
    return ar, ai, bbr, bbi


def _complex_affine_combine(e1, e2):
    a1r, a1i, b1r, b1i = e1
    a2r, a2i, b2r, b2i = e2
    return (a2r * a1r - a2i * a1i,
            a2r * a1i + a2i * a1r,
            a2r * b1r - a2i * b1i + b2r,
            a2r * b1i + a2i * b1r + b2i)


def _ssm_scan(u, ar, ai, bbr, bbi, s0, reverse):
    bur = jnp.einsum('blgh,gph->blgp', u, bbr)
    bui = jnp.einsum('blgh,gph->blgp', u, bbi)
    a_r = jnp.broadcast_to(ar, bur.shape)
    a_i = jnp.broadcast_to(ai, bur.shape)
    acc_r, acc_i, sr, si = lax.associative_scan(_complex_affine_combine, (a_r, a_i, bur, bui), reverse=reverse, axis=1)
    if s0 is not None:
        s0r = s0[0][:, None]
        s0i = s0[1][:, None]
        sr = sr + acc_r * s0r - acc_i * s0i
        si = si + acc_r * s0i + acc_i * s0r
    return sr, si


def _readout(sr, si, c_re, c_im):
    return (jnp.einsum('blgp,ghp->blgh', sr, c_re.astype(jnp.float32))
            - jnp.einsum('blgp,ghp->blgh', si, c_im.astype(jnp.float32)))


def _s5_mixer(h, hc, lam_re, lam_im, log_step, b_re, b_im, c_re, c_im, d_skip, w_a, w_b, need_ctx):
    b, s, dm = h.shape
    lc = hc.shape[1]
    u = h.astype(jnp.float32).reshape(b, s, SSM_GROUPS, SSM_GROUP)
    uc = hc.astype(jnp.float32).reshape(b, lc, SSM_GROUPS, SSM_GROUP)
    y = jnp.zeros(u.shape, jnp.float32)
    yc = jnp.zeros(uc.shape, jnp.float32)
    for dr in range(2):
        rev = dr == 1
        ar, ai, bbr, bbi = _zoh(lam_re[dr], lam_im[dr], log_step[dr], b_re[dr], b_im[dr])
        scr, sci = _ssm_scan(uc, ar, ai, bbr, bbi, None, rev)
        last = 0 if rev else lc - 1
        sr, si = _ssm_scan(u, ar, ai, bbr, bbi, (scr[:, last], sci[:, last]), rev)
        y = y + _readout(sr, si, c_re[dr], c_im[dr])
        if need_ctx:
            yc = yc + _readout(scr, sci, c_re[dr], c_im[dr])

    def finish(yy, hh, n):
        z = yy.reshape(b, n, dm) + d_skip.astype(jnp.float32) * hh.astype(jnp.float32)
        z = jax.nn.gelu(z)
        out = (z @ w_a.astype(jnp.float32)) * jax.nn.sigmoid(z @ w_b.astype(jnp.float32))
        return out.astype(h.dtype)

    y_out = finish(y, h, s)
    yc_out = finish(yc, hc, lc) if need_ctx else None
    return y_out, yc_out


def _mlp(h, w1, w2):
    return jnp.square(jax.nn.relu(h @ w1)) @ w2


def setup_inputs(seed: int = 0) -> dict:
    key = jax.random.key(seed)
    ks = jax.random.split(key, 32)
    f32 = jnp.float32
    d = D_MODEL

    def nrm(k, shape, std):
        return jax.random.normal(k, shape, f32) * std

    return {
        'x': nrm(ks[0], (BATCH, SEQ, d), 1.0),
        'c': nrm(ks[1], (BATCH, d), 1.0),
        'ctx': nrm(ks[2], (BATCH, CTX_LEN, d), 1.0),
        'c_ctx': nrm(ks[3], (d,), 1.0),
        'w_ada': nrm(ks[4], (DEPTH, d, 6 * d), d ** -0.5),
        'b_ada': nrm(ks[5], (DEPTH, 6 * d), 0.02),
        'norm1_g': 1.0 + nrm(ks[6], (DEPTH, d), 0.02),
        'norm2_g': 1.0 + nrm(ks[7], (DEPTH, d), 0.02),
        'final_g': 1.0 + nrm(ks[8], (d,), 0.02),
        'w_in': nrm(ks[9], (N_EVEN, d, IN_PROJ), d ** -0.5),
        'w_out': nrm(ks[10], (N_EVEN, MIX_OUT, d), MIX_OUT ** -0.5),
        'lam_q1': nrm(ks[11], (N_EVEN, HEAD_DIM), 0.1),
        'lam_k1': nrm(ks[12], (N_EVEN, HEAD_DIM), 0.1),
        'lam_q2': nrm(ks[13], (N_EVEN, HEAD_DIM), 0.1),
        'lam_k2': nrm(ks[14], (N_EVEN, HEAD_DIM), 0.1),
        'subln_g': 1.0 + nrm(ks[15], (N_EVEN, DIFF_V_DIM), 0.02),
        'na_rpb': nrm(ks[16], (N_EVEN, NA_HEADS, 2 * NA_KH - 1, 2 * NA_KW - 1), 0.02),
        'ssm_lam_re': -0.5 + nrm(ks[17], (N_ODD, 2, SSM_GROUPS, SSM_STATE), 0.01),
        'ssm_lam_im': (math.pi * jnp.arange(SSM_STATE, dtype=f32))[None, None, None, :]
                      + nrm(ks[18], (N_ODD, 2, SSM_GROUPS, SSM_STATE), 0.01),
        'ssm_log_step': jax.random.uniform(ks[19], (N_ODD, 2, SSM_GROUPS), f32,
                                           minval=math.log(1e-3), maxval=math.log(1e-1)),
        'ssm_b_re': nrm(ks[20], (N_ODD, 2, SSM_GROUPS, SSM_STATE, SSM_GROUP), (2 * SSM_GROUP) ** -0.5),
        'ssm_b_im': nrm(ks[21], (N_ODD, 2, SSM_GROUPS, SSM_STATE, SSM_GROUP), (2 * SSM_GROUP) ** -0.5),
        'ssm_c_re': nrm(ks[22], (N_ODD, 2, SSM_GROUPS, SSM_GROUP, SSM_STATE), (2 * SSM_STATE) ** -0.5),
        'ssm_c_im': nrm(ks[23], (N_ODD, 2, SSM_GROUPS, SSM_GROUP, SSM_STATE), (2 * SSM_STATE) ** -0.5),
        'ssm_d': nrm(ks[24], (N_ODD, d), 1.0),
        'glu_w_a': nrm(ks[25], (N_ODD, d, d), d ** -0.5),
        'glu_w_b': nrm(ks[26], (N_ODD, d, d), d ** -0.5),
        'mlp_w1': nrm(ks[27], (DEPTH, d, MLP_HIDDEN), d ** -0.5),
        'mlp_w2': nrm(ks[28], (DEPTH, MLP_HIDDEN, d), MLP_HIDDEN ** -0.5),
    }


def reference(x, c, ctx, c_ctx, w_ada, b_ada, norm1_g, norm2_g, final_g, w_in, w_out,
              lam_q1, lam_k1, lam_q2, lam_k2, subln_g, na_rpb, ssm_lam_re, ssm_lam_im,
              ssm_log_step, ssm_b_re, ssm_b_im, ssm_c_re, ssm_c_im, ssm_d, glu_w_a, glu_w_b,
              mlp_w1, mlp_w2):
    s = x.shape[1]
    rows = s // GRID_W
    rope = _rope_tables(s)
    act_lat = jax.nn.silu(c)
    act_ctx = jax.nn.silu(c_ctx)
    for i in range(DEPTH):
        need_ctx = i < DEPTH - 1
        m = act_lat @ w_ada[i] + b_ada[i]
        mc = act_ctx @ w_ada[i] + b_ada[i]
        sh1, sc1, g1, sh2, sc2, g2 = jnp.split(m[:, None, :], 6, axis=-1)
        sh1c, sc1c, g1c, sh2c, sc2c, g2c = jnp.split(mc, 6, axis=-1)
        h = _rmsnorm(x, norm1_g[i], NORM_EPS) * (1.0 + sc1) + sh1
        hc = _rmsnorm(ctx, norm1_g[i], NORM_EPS) * (1.0 + sc1c) + sh1c
        if i % 2 == 0:
            e = i // 2
            lam_init = 0.8 - 0.6 * math.exp(-0.3 * i)
            y, yc = _even_mixer(h, hc, w_in[e], w_out[e], lam_q1[e], lam_k1[e], lam_q2[e], lam_k2[e],
                                subln_g[e], na_rpb[e], rope, lam_init, rows, need_ctx)
        else:
            o = i // 2
            y, yc = _s5_mixer(h, hc, ssm_lam_re[o], ssm_lam_im[o], ssm_log_step[o], ssm_b_re[o], ssm_b_im[o],
                              ssm_c_re[o], ssm_c_im[o], ssm_d[o], glu_w_a[o], glu_w_b[o], need_ctx)
        x = x + g1 * y
        h2 = _rmsnorm(x, norm2_g[i], NORM_EPS) * (1.0 + sc2) + sh2
        x = x + g2 * _mlp(h2, mlp_w1[i], mlp_w2[i])
        if need_ctx:
            ctx = ctx + g1c * yc
            h2c = _rmsnorm(ctx, norm2_g[i], NORM_EPS) * (1.0 + sc2c) + sh2c
            ctx = ctx + g2c * _mlp(h2c, mlp_w1[i], mlp_w2[i])
    return _rmsnorm(x, final_g, NORM_EPS)
```

```cpp
#include <hip/hip_runtime.h>
#include <hip/hip_bf16.h>
#include <cstdio>
#include <cstdint>
#include <cmath>
namespace pg8 {
#define PG8_LAS __attribute__((address_space(3)))
typedef unsigned short bf16_t;
typedef short bf16x8 __attribute__((ext_vector_type(8)));
typedef float f32x4 __attribute__((ext_vector_type(4)));
typedef float f32x2 __attribute__((ext_vector_type(2)));
typedef unsigned u32x4 __attribute__((ext_vector_type(4)));
typedef unsigned u32x2 __attribute__((ext_vector_type(2)));
constexpr int BM = 256, BK = 64, HALF = 128, HTB = HALF * BK * 2, STAGE_BYTES = 8 * HTB, NXCD = 8, WGM = 8;

__host__ __device__ __forceinline__ int lds_byte(int r, int c) { const int st = (r >> 4) * 2 + (c >> 5), rr = r & 15, cc = c & 31, ob = rr * 64 + cc * 2; return st * 1024 + (ob ^ (((ob >> 9) & 1) << 5)); }
__host__ __device__ __forceinline__ void stage_rc(int b, int& R, int& C) { const int st = b / 1024, sb = b % 1024, swz = sb ^ (((sb >> 9) & 1) << 5); R = (st >> 1) * 16 + swz / 64; C = (st & 1) * 32 + (swz % 64) / 2; }
__host__ __device__ __forceinline__ int perm32(int rho) { const int n = rho >> 4, i = rho & 15; return 8 * (i >> 2) + 4 * n + (i & 3); }

struct Unit { int pm, pn; };
struct Gemm { const bf16_t* A; const bf16_t* Bt; int lda, ldb, K; };

struct StaticOrder {
    int nM, nN, nwg, G, c;
    __host__ __device__ void init(int M, int N, int G_, int c_) { nM = M / BM; nN = N / BM; nwg = nM * nN; G = G_; c = c_; }
    __host__ __device__ bool next(int i, Unit& u) const {
        const long L = (long)i * G + c; if (L >= nwg) return false;
        int wgid = (int)L; { const int q = nwg / NXCD, r = nwg % NXCD, xcd = wgid % NXCD, off = wgid / NXCD; wgid = (xcd < r ? xcd * (q + 1) : r * (q + 1) + (xcd - r) * q) + off; }
        const int nig = WGM * nN, gid = wgid / nig, fm = gid * WGM, gsz = (nM - fm) < WGM ? (nM - fm) : WGM;
        u.pm = fm + ((wgid % nig) % gsz); u.pn = (wgid % nig) / gsz; return true;
    }
};
struct SsmOrder {
    int G, c, nrow;
    __device__ bool next(int i, Unit& u) const {
        const int L = i * G + c; if (L >= 64 * nrow) return false;
        const int g = L / nrow; u.pm = g * 5 + (L - g * nrow); u.pn = g; return true;
    }
};

__device__ __forceinline__ unsigned cvt_pk_bf16(float lo, float hi) { unsigned r; asm volatile("v_cvt_pk_bf16_f32 %0, %1, %2" : "=v"(r) : "v"(lo), "v"(hi)); return r; }
__device__ __forceinline__ float bf16lo(unsigned w) { return __uint_as_float(w << 16); }
__device__ __forceinline__ float bf16hi(unsigned w) { return __uint_as_float(w & 0xffff0000u); }

constexpr float QSCALE = 0.125f * 1.4426950408889634f;


struct EpiInProj {
    static constexpr bool PERM = false;
    bf16_t* O; const float* rope;
    __device__ __forceinline__ void operator()(const f32x4 (&acc)[2][2][4][2], const Unit& u, int wr, int wc, int fr, int fq) const {
        const int pn = u.pn; const bool dorope = (u.pm < 64) && (pn < 4);
        const float sc = (pn < 2 || pn == 6 || pn == 7) ? QSCALE : 1.0f;
        const int row0 = u.pm * BM + wr * 64 + fr, col0 = pn * BM + wc * 32 + 4 * fq;
#pragma unroll
        for (int ai = 0; ai < 2; ++ai)
#pragma unroll
            for (int m = 0; m < 4; ++m) {
                const int row = row0 + ai * HALF + m * 16;
                f32x4 cs = (f32x4){1.f, 1.f, 1.f, 1.f}, sn = (f32x4){0.f, 0.f, 0.f, 0.f};
                if (dorope) { const int t = row & 2047; const int pos = (wc & 1) ? (t & 63) : (t >> 6);
                    cs = *(const f32x4*)(rope + pos * 16 + 4 * fq); sn = *(const f32x4*)(rope + 1024 + pos * 16 + 4 * fq); }
                bf16_t* rowp = O + (size_t)row * 3072 + col0;
#pragma unroll
                for (int bj = 0; bj < 2; ++bj) {
                    const f32x4 x1 = acc[ai][bj][m][0], x2 = acc[ai][bj][m][1];
                    const f32x4 y1 = (x1 * cs - x2 * sn) * sc, y2 = (x2 * cs + x1 * sn) * sc;
                    u32x2 w1, w2; w1.x = cvt_pk_bf16(y1[0], y1[1]); w1.y = cvt_pk_bf16(y1[2], y1[3]); w2.x = cvt_pk_bf16(y2[0], y2[1]); w2.y = cvt_pk_bf16(y2[2], y2[3]);
                    *(u32x2*)(rowp + bj * HALF) = w1; *(u32x2*)(rowp + bj * HALF + 16) = w2;
                }
            }
    }
};

struct EpiResid {
    static constexpr bool PERM = false;
    const float* base_l; const float* base_c; float* out_l; float* out_c; const float* gate;
    __device__ __forceinline__ void operator()(const f32x4 (&acc)[2][2][4][2], const Unit& u, int wr, int wc, int fr, int fq) const {
        const bool lat = u.pm < 64; const int r = lat ? (u.pm >> 3) : 8;
        const size_t toff = (size_t)(lat ? u.pm : u.pm - 64) * BM * 1024;
        const float* base = (lat ? base_l : base_c) + toff; float* out = (lat ? out_l : out_c) + toff;
        const int col0 = u.pn * BM + wc * 32 + 4 * fq; const float* gv = gate + r * 6144 + col0;
        f32x4 g[2][2];
#pragma unroll
        for (int bj = 0; bj < 2; ++bj)
#pragma unroll
            for (int n = 0; n < 2; ++n) g[bj][n] = *(const f32x4*)(gv + bj * HALF + n * 16);
#pragma unroll
        for (int ai = 0; ai < 2; ++ai)
#pragma unroll
            for (int m = 0; m < 4; ++m) { const size_t p = (size_t)(wr * 64 + fr + ai * HALF + m * 16) * 1024 + col0;
#pragma unroll
                for (int bj = 0; bj < 2; ++bj)
#pragma unroll
                    for (int n = 0; n < 2; ++n) { const f32x4 b = *(const f32x4*)(base + p + bj * HALF + n * 16); *(f32x4*)(out + p + bj * HALF + n * 16) = b + g[bj][n] * acc[ai][bj][m][n]; } }
    }
};

struct EpiRelu2 {
    static constexpr bool PERM = true;
    bf16_t* O; int ldc;
    __device__ __forceinline__ void operator()(const f32x4 (&acc)[2][2][4][2], const Unit& u, int wr, int wc, int fr, int fq) const {
        const int row0 = u.pm * BM + wr * 64 + fr, col0 = u.pn * BM + wc * 32 + 8 * fq;
#pragma unroll
        for (int ai = 0; ai < 2; ++ai)
#pragma unroll
            for (int m = 0; m < 4; ++m) { bf16_t* rowp = O + (size_t)(row0 + ai * HALF + m * 16) * ldc + col0;
#pragma unroll
                for (int bj = 0; bj < 2; ++bj) { f32x4 v0 = acc[ai][bj][m][0], v1 = acc[ai][bj][m][1];
#pragma unroll
                    for (int e = 0; e < 4; ++e) { const float a = fmaxf(v0[e], 0.f), b = fmaxf(v1[e], 0.f); v0[e] = a * a; v1[e] = b * b; }
                    u32x4 w; w.x = cvt_pk_bf16(v0[0], v0[1]); w.y = cvt_pk_bf16(v0[2], v0[3]); w.z = cvt_pk_bf16(v1[0], v1[1]); w.w = cvt_pk_bf16(v1[2], v1[3]);
                    *(u32x4*)(rowp + bj * HALF) = w; } }
    }
};

struct EpiGlu {
    static constexpr bool PERM = false;
    float* x; const float* gate;
    __device__ __forceinline__ void operator()(const f32x4 (&acc)[2][2][4][2], const Unit& u, int wr, int wc, int fr, int fq) const {
        const int r = u.pm >> 3; const int col0 = u.pn * HALF + wc * 32 + 4 * fq; const float* gv = gate + r * 6144 + col0;
        f32x4 g[2];
#pragma unroll
        for (int n = 0; n < 2; ++n) g[n] = *(const f32x4*)(gv + n * 16);
#pragma unroll
        for (int ai = 0; ai < 2; ++ai)
#pragma unroll
            for (int m = 0; m < 4; ++m) { float* p = x + (size_t)(u.pm * BM + wr * 64 + fr + ai * HALF + m * 16) * 1024 + col0;
#pragma unroll
                for (int n = 0; n < 2; ++n) { const f32x4 za = acc[ai][0][m][n], zb = acc[ai][1][m][n]; f32x4 o;
#pragma unroll
                    for (int e = 0; e < 4; ++e) o[e] = za[e] * (1.0f / (1.0f + __builtin_amdgcn_exp2f(-1.4426950408889634f * zb[e])));
                    const f32x4 b = *(const f32x4*)(p + n * 16); *(f32x4*)(p + n * 16) = b + g[n] * o; } }
    }
};

struct EpiSsm1 {
    static constexpr bool PERM = false;
    float* S;
    __device__ __forceinline__ void operator()(const f32x4 (&acc)[2][2][4][2], const Unit& u, int wr, int wc, int fr, int fq) const {
        const int g = u.pn, i = u.pm - 5 * g; const int col0 = wc * 32 + 4 * fq;
#pragma unroll
        for (int ai = 0; ai < 2; ++ai)
#pragma unroll
            for (int m = 0; m < 4; ++m) { const int row = i * BM + wr * 64 + fr + ai * HALF + m * 16;
                if (row < 1152) { float* p = S + ((size_t)g * 1152 + row) * 256 + col0;
#pragma unroll
                    for (int bj = 0; bj < 2; ++bj)
#pragma unroll
                        for (int n = 0; n < 2; ++n) *(f32x4*)(p + bj * HALF + n * 16) = acc[ai][bj][m][n]; } }
    }
};

__device__ __forceinline__ float gelu_tanh(float v) {
    const float u = 0.7978845608028654f * (v + 0.044715f * v * v * v);
    const float e = __builtin_amdgcn_exp2f(2.0f * 1.4426950408889634f * u);
    const float th = 1.0f - 2.0f / (1.0f + e);
    return 0.5f * v * (1.0f + th);
}
struct EpiSsm2 {
    static constexpr bool PERM = true;
    bf16_t* Z; const bf16_t* A2; const float* dskip;
    __device__ __forceinline__ void operator()(const f32x4 (&acc)[2][2][4][2], const Unit& u, int wr, int wc, int fr, int fq) const {
        const int g = u.pn, i = u.pm - 5 * g; const int hh = 8 * (fq & 1); const int zcol = g * 16 + hh;
        const f32x4 d0 = *(const f32x4*)(dskip + zcol), d1 = *(const f32x4*)(dskip + zcol + 4);
#pragma unroll
        for (int ai = 0; ai < 2; ++ai)
#pragma unroll
            for (int m = 0; m < 4; ++m) { const int ridx = i * BM + wr * 64 + fr + ai * HALF + m * 16; const int b = ridx >> 7, c = ridx & 127;
#pragma unroll
                for (int bj = 0; bj < 2; ++bj) { const int t = 8 * bj + 2 * wc + (fq >> 1);
                    const u32x4 hv = *(const u32x4*)(A2 + ((size_t)(g * 1280 + ridx)) * 512 + t * 16 + hh);
                    const f32x4 v0 = acc[ai][bj][m][0], v1 = acc[ai][bj][m][1];
                    float z[8];
                    z[0] = v0[0] + d0[0] * bf16lo(hv.x); z[1] = v0[1] + d0[1] * bf16hi(hv.x); z[2] = v0[2] + d0[2] * bf16lo(hv.y); z[3] = v0[3] + d0[3] * bf16hi(hv.y);
                    z[4] = v1[0] + d1[0] * bf16lo(hv.z); z[5] = v1[1] + d1[1] * bf16hi(hv.z); z[6] = v1[2] + d1[2] * bf16lo(hv.w); z[7] = v1[3] + d1[3] * bf16hi(hv.w);
#pragma unroll
                    for (int e = 0; e < 8; ++e) z[e] = gelu_tanh(z[e]);
                    u32x4 w; w.x = cvt_pk_bf16(z[0], z[1]); w.y = cvt_pk_bf16(z[2], z[3]); w.z = cvt_pk_bf16(z[4], z[5]); w.w = cvt_pk_bf16(z[6], z[7]);
                    *(u32x4*)(Z + (size_t)(b * 2048 + c * 16 + t) * 1024 + zcol) = w; } }
    }
};

template <class Epi, class Sched, bool ALIGN_EPI>
__device__ __forceinline__ void gemm_phase(PG8_LAS unsigned char* lds, const Gemm g, const Sched& S, const Epi& E) {
    int tid = threadIdx.x; asm volatile("" : "+v"(tid));
    const int wid = __builtin_amdgcn_readfirstlane(tid >> 6), lane = tid & 63, wr = wid >> 2, wc = wid & 3, fr = lane & 15, fq = lane >> 4;
    const int K = g.K, nt = K / BK;
    unsigned voffA[2], voffB[2];
#pragma unroll
    for (int i = 0; i < 2; ++i) { int R, C; stage_rc(tid * 16 + i * 8192, R, C); const int Rb = Epi::PERM ? ((R & ~31) + perm32(R & 31)) : R;
        voffA[i] = (unsigned)(R * g.lda + C) * 2u; voffB[i] = (unsigned)(Rb * g.ldb + C) * 2u; }
    const size_t kstep = (size_t)(BK * 2);
    const size_t hstepA = (size_t)HALF * g.lda * 2, hstepB = (size_t)HALF * g.ldb * 2;
    const size_t tstepA = 2 * hstepA, tstepB = 2 * hstepB;
    const unsigned ldsw = (unsigned)wid * 1024u;
    const int aoff = lds_byte(wr * 64 + fr, fq * 8), boff = lds_byte(wc * 32 + fr, fq * 8);
#define PG8_SA(b, h) (((b) * 2 + (h)) * HTB)
#define PG8_SB(b, h) ((4 + (b) * 2 + (h)) * HTB)
#define PG8_STAGE(bufoff, gbase, voff) do { _Pragma("unroll") for (int _i = 0; _i < 2; ++_i) \
        __builtin_amdgcn_global_load_lds((const unsigned*)((const char*)(gbase) + (voff)[_i]), (PG8_LAS unsigned*)(lds + (bufoff) + ldsw + _i * 8192), 16, 0, 0); } while (0)
#define PG8_LDA(dst, b, h) do { _Pragma("unroll") for (int m = 0; m < 4; ++m) _Pragma("unroll") for (int k = 0; k < 2; ++k) dst[m][k] = *(const PG8_LAS bf16x8*)(lds + PG8_SA(b, h) + aoff + m * 2048 + k * 1024); } while (0)
#define PG8_LDB(dst, b, h) do { _Pragma("unroll") for (int n = 0; n < 2; ++n) _Pragma("unroll") for (int k = 0; k < 2; ++k) dst[n][k] = *(const PG8_LAS bf16x8*)(lds + PG8_SB(b, h) + boff + n * 2048 + k * 1024); } while (0)
#define PG8_MMA(ai, bj, At, Bt) do { __builtin_amdgcn_s_setprio(1); _Pragma("unroll") for (int m = 0; m < 4; ++m) _Pragma("unroll") for (int n = 0; n < 2; ++n) _Pragma("unroll") for (int k = 0; k < 2; ++k) \
        acc[ai][bj][m][n] = __builtin_amdgcn_mfma_f32_16x16x32_bf16(Bt[n][k], At[m][k], acc[ai][bj][m][n], 0, 0, 0); __builtin_amdgcn_s_setprio(0); } while (0)
#define PG8_WAIT_V(n) asm volatile("s_waitcnt vmcnt(" #n ")" ::: "memory")
#define PG8_WAIT_L(n) asm volatile("s_waitcnt lgkmcnt(" #n ")" ::: "memory")
#define PG8_BAR __builtin_amdgcn_s_barrier()
#define PG8_SCHED __builtin_amdgcn_sched_barrier(0)
    Unit cur, nxt; int ui = 0;
    if (!S.next(0, cur)) return;
    f32x4 acc[2][2][4][2];
#pragma unroll
    for (int a = 0; a < 2; ++a)
#pragma unroll
        for (int b = 0; b < 2; ++b)
#pragma unroll
            for (int m = 0; m < 4; ++m)
#pragma unroll
                for (int n = 0; n < 2; ++n) acc[a][b][m][n] = (f32x4){0.f, 0.f, 0.f, 0.f};
    bf16x8 At[4][2], B0[2][2], B1[2][2];
    const char* cA = (const char*)g.A + (size_t)cur.pm * tstepA; const char* cB = (const char*)g.Bt + (size_t)cur.pn * tstepB;
    PG8_STAGE(PG8_SB(0, 0), cB, voffB); PG8_STAGE(PG8_SB(0, 1), cB + hstepB, voffB); PG8_STAGE(PG8_SA(0, 0), cA, voffA); PG8_STAGE(PG8_SA(0, 1), cA + hstepA, voffA);
    if (wr == 1) PG8_BAR;
    PG8_WAIT_V(2); PG8_BAR;
    PG8_STAGE(PG8_SB(1, 0), cB + kstep, voffB); PG8_STAGE(PG8_SA(1, 0), cA + kstep, voffA); PG8_STAGE(PG8_SB(1, 1), cB + hstepB + kstep, voffB);
    PG8_WAIT_V(6); PG8_BAR;
    for (;;) {
        const bool has_next = S.next(ui + 1, nxt);
        const char* nA = has_next ? (const char*)g.A + (size_t)nxt.pm * tstepA : cA; const char* nB = has_next ? (const char*)g.Bt + (size_t)nxt.pn * tstepB : cB;
        for (int t = 0; t < nt; t += 2) {
            const bool last = (t == nt - 2);
            const char* a1 = cA + (size_t)(t + 1) * kstep;
            const char* a2 = last ? nA : cA + (size_t)(t + 2) * kstep; const char* b2 = last ? nB : cB + (size_t)(t + 2) * kstep;
            const char* a3 = a2 + kstep; const char* b3 = b2 + kstep;
            PG8_LDB(B0, 0, 0); PG8_LDB(B1, 0, 1); PG8_SCHED; PG8_LDA(At, 0, 0); PG8_STAGE(PG8_SA(1, 1), a1 + hstepA, voffA);
            PG8_WAIT_V(8); PG8_WAIT_L(0); PG8_BAR; PG8_MMA(0, 0, At, B0); PG8_MMA(0, 1, At, B1); PG8_BAR; PG8_SCHED;
            PG8_LDA(At, 0, 1); PG8_STAGE(PG8_SB(0, 0), b2, voffB); PG8_STAGE(PG8_SB(0, 1), b2 + hstepB, voffB); PG8_STAGE(PG8_SA(0, 0), a2, voffA);
            PG8_WAIT_V(8); PG8_WAIT_L(0); PG8_BAR; PG8_MMA(1, 0, At, B0); PG8_MMA(1, 1, At, B1); PG8_BAR; PG8_SCHED;
            PG8_LDB(B0, 1, 0); PG8_LDB(B1, 1, 1); PG8_SCHED; PG8_LDA(At, 1, 0); PG8_STAGE(PG8_SA(0, 1), a2 + hstepA, voffA);
            PG8_WAIT_V(8); PG8_WAIT_L(0); PG8_BAR; PG8_MMA(0, 0, At, B0); PG8_MMA(0, 1, At, B1); PG8_BAR; PG8_SCHED;
            PG8_LDA(At, 1, 1); PG8_STAGE(PG8_SB(1, 0), b3, voffB); PG8_STAGE(PG8_SB(1, 1), b3 + hstepB, voffB); PG8_STAGE(PG8_SA(1, 0), a3, voffA);
            PG8_WAIT_V(8); PG8_WAIT_L(0); PG8_BAR; PG8_MMA(1, 0, At, B0); PG8_MMA(1, 1, At, B1); PG8_BAR; PG8_SCHED;
        }
        if constexpr (ALIGN_EPI) { if (wr == 0) PG8_BAR; }
        E(acc, cur, wr, wc, fr, fq);
        if (!has_next) break;
#pragma unroll
        for (int a = 0; a < 2; ++a)
#pragma unroll
            for (int b = 0; b < 2; ++b)
#pragma unroll
                for (int m = 0; m < 4; ++m)
#pragma unroll
                    for (int n = 0; n < 2; ++n) acc[a][b][m][n] = (f32x4){0.f, 0.f, 0.f, 0.f};
        cur = nxt; cA = nA; cB = nB; ++ui;
        if constexpr (ALIGN_EPI) { if (wr == 1) PG8_BAR; }
    }
    PG8_WAIT_V(0);
    if constexpr (!ALIGN_EPI) { if (wr == 0) PG8_BAR; }
    PG8_BAR;
#undef PG8_SA
#undef PG8_SB
#undef PG8_STAGE
#undef PG8_LDA
#undef PG8_LDB
#undef PG8_MMA
#undef PG8_WAIT_V
#undef PG8_WAIT_L
#undef PG8_BAR
#undef PG8_SCHED
}
}
namespace att {
typedef __attribute__((address_space(3))) unsigned char lds_u8;
typedef __attribute__((address_space(3))) const unsigned char* lds_cptr;
using bf16x8 = __attribute__((ext_vector_type(8))) short;
using s16x4 = __attribute__((ext_vector_type(4))) short;
using f32x16 = __attribute__((ext_vector_type(16))) float;
using f32x4 = __attribute__((ext_vector_type(4))) float;
using u32x4 = __attribute__((ext_vector_type(4))) unsigned;
typedef unsigned short bf16_t;
constexpr int PITCH = 3072;
constexpr int OPITCH = 1024;
constexpr int STAGE_B = 32768;
constexpr int L_QREG = 65536;
constexpr int L_WSF = 132096;
constexpr int L_BIAS = 136192;
constexpr float LOG2E = 1.4426950408889634f;

__device__ __forceinline__ int crow(int r, int hi) { return (r & 3) + 8 * (r >> 2) + 4 * hi; }
#define ATT_SBAR() __builtin_amdgcn_sched_barrier(0)
__device__ __forceinline__ void glds16(const void* gsrc, unsigned lds_dst) { unsigned keep;
    asm volatile("s_mov_b32 %0, m0\n\ts_mov_b32 m0, %2\n\ts_nop 0\n\tglobal_load_lds_dwordx4 %1, off\n\ts_mov_b32 m0, %0" : "=&s"(keep) : "v"(gsrc), "s"(lds_dst) : "memory"); }
typedef float f32x2_t __attribute__((ext_vector_type(2))); typedef __bf16 bf16x2_t __attribute__((ext_vector_type(2)));
__device__ __forceinline__ unsigned cvtpk(float lo, float hi) { f32x2_t v = {lo, hi}; bf16x2_t b = __builtin_convertvector(v, bf16x2_t); return __builtin_bit_cast(unsigned, b); }

__device__ __forceinline__ void qkt(f32x16& p0, f32x16& p1, lds_cptr Kslot, const bf16x8* qr, int r32, int hi) {
    lds_cptr kb = Kslot + hi * 1024 + r32 * 16;
    const f32x16 z = f32x16{};
#pragma unroll
    for (int d0 = 0; d0 < 4; ++d0) {
        const bf16x8 b0 = *(const __attribute__((address_space(3))) bf16x8*)(kb + d0 * 2048);
        const bf16x8 b1 = *(const __attribute__((address_space(3))) bf16x8*)(kb + d0 * 2048 + 512);
        if (d0 == 0) { p0 = __builtin_amdgcn_mfma_f32_32x32x16_bf16(b0, qr[0], z, 0, 0, 0); p1 = __builtin_amdgcn_mfma_f32_32x32x16_bf16(b1, qr[0], z, 0, 0, 0); }
        else { p0 = __builtin_amdgcn_mfma_f32_32x32x16_bf16(b0, qr[d0], p0, 0, 0, 0); p1 = __builtin_amdgcn_mfma_f32_32x32x16_bf16(b1, qr[d0], p1, 0, 0, 0); } }
}
__device__ __forceinline__ void pv(f32x16* o, int vb, bf16x8 pa0, bf16x8 pa1, bf16x8 pa2, bf16x8 pa3) {
#pragma unroll
    for (int d0 = 0; d0 < 2; ++d0) { s16x4 lo[4], hi[4];
#pragma unroll
        for (int ks = 0; ks < 4; ++ks) {
            asm volatile("ds_read_b64_tr_b16 %0,%1 offset:%c2" : "=&v"(lo[ks]) : "v"(vb), "i"(d0 * 4096 + ks * 1024) : "memory");
            asm volatile("ds_read_b64_tr_b16 %0,%1 offset:%c2" : "=&v"(hi[ks]) : "v"(vb), "i"(d0 * 4096 + ks * 1024 + 512) : "memory"); }
        asm volatile("s_waitcnt lgkmcnt(0)" ::: "memory"); ATT_SBAR();
#define ATT_PK(k) (bf16x8){lo[k][0], lo[k][1], lo[k][2], lo[k][3], hi[k][0], hi[k][1], hi[k][2], hi[k][3]}
        o[d0] = __builtin_amdgcn_mfma_f32_32x32x16_bf16(pa0, ATT_PK(0), o[d0], 0, 0, 0);
        o[d0] = __builtin_amdgcn_mfma_f32_32x32x16_bf16(pa1, ATT_PK(1), o[d0], 0, 0, 0);
        o[d0] = __builtin_amdgcn_mfma_f32_32x32x16_bf16(pa2, ATT_PK(2), o[d0], 0, 0, 0);
        o[d0] = __builtin_amdgcn_mfma_f32_32x32x16_bf16(pa3, ATT_PK(3), o[d0], 0, 0, 0);
#undef ATT_PK
    }
}
__device__ __forceinline__ float rowmax32(const f32x16& p0, const f32x16& p1) {
    float a = p0[0], b = p1[0];
#pragma unroll
    for (int r = 1; r < 16; ++r) { a = __builtin_fmaxf(a, p0[r]); b = __builtin_fmaxf(b, p1[r]); }
    const float m = __builtin_fmaxf(a, b);
    auto rr = __builtin_amdgcn_permlane32_swap(__float_as_uint(m), __float_as_uint(m), false, false);
    return __builtin_fmaxf(__uint_as_float(rr[0]), __uint_as_float(rr[1]));
}
__device__ __forceinline__ float softmax_step(f32x16& p0, f32x16& p1, float& m, float& l) {
    const float rm = rowmax32(p0, p1);
    const float mn = __builtin_fmaxf(m, rm);
    const float f = __builtin_amdgcn_exp2f(m - mn);
    m = mn;
    float s = 0.f;
#pragma unroll
    for (int r = 0; r < 16; ++r) { p0[r] = __builtin_amdgcn_exp2f(p0[r] - mn); p1[r] = __builtin_amdgcn_exp2f(p1[r] - mn); s += p0[r] + p1[r]; }
    l = l * f + s;
    return f;
}

struct UnitDesc {
    int qrow0;
    int qcol, kcol, vcol;
    int latrow, t0, nlat;
    int ctxrow;
    int ocol;
    int r0, head;
};

template <bool DIFF, bool NAM>
__device__ __forceinline__ void attn_unit(const UnitDesc& U, const bf16_t* __restrict__ proj, bf16_t* __restrict__ out, lds_u8* shm3,
                                          const float* __restrict__ rpb, const float* __restrict__ subg, float lam, float outscale) {
    int tid = threadIdx.x; asm volatile("" : "+v"(tid));
    const int lane = tid & 63, r32 = lane & 31, hi = lane >> 5; const int wid = __builtin_amdgcn_readfirstlane(tid >> 6);
    const unsigned lds0 = (unsigned)(uintptr_t)shm3;
    __attribute__((address_space(3))) float* wsf = (__attribute__((address_space(3))) float*)(shm3 + L_WSF + wid * 512);
    const int ntile = U.nlat + 4;
    if (NAM) { __attribute__((address_space(3))) float* bl = (__attribute__((address_space(3))) float*)(shm3 + L_BIAS);
        for (int i = tid; i < 15 * 31; i += 512) { const int ro = i / 31, j = i - ro * 31; bl[ro * 128 + 48 + j] = rpb[(U.head * 15 + ro) * 31 + j] * LOG2E; } }
    const bf16_t* ksrc0 = proj + (size_t)lane * PITCH + U.kcol + wid * 8;
    const bf16_t* vsrc0 = proj + (size_t)(16 * (wid & 3) + (lane >> 2)) * PITCH + U.vcol + (wid >> 2) * 32 + (lane & 3) * 8;
    const unsigned dstw = lds0 + wid * 1024;
#define ATT_TILE_ROW(i) (((i) < U.nlat) ? (U.latrow + 64 * (U.t0 + (i))) : (U.ctxrow + 64 * ((i) - U.nlat)))
#define ATT_DMA_TILE(i, stage) do { const size_t ro_ = (size_t)ATT_TILE_ROW(i) * PITCH; const unsigned d_ = (unsigned)__builtin_amdgcn_readfirstlane((int)(dstw + (stage) * STAGE_B)); \
        glds16(ksrc0 + ro_, d_); if (DIFF) glds16(ksrc0 + ro_ + 64, d_ + 8192); glds16(vsrc0 + ro_, d_ + 16384); if (DIFF) glds16(vsrc0 + ro_ + 64, d_ + 24576); } while (0)
    const bf16_t* Qw = proj + (size_t)(U.qrow0 + wid * 32 + r32) * PITCH + U.qcol + hi * 8;
    bf16x8 qr[4];
    lds_u8* qreg = shm3 + L_QREG + wid * 8192;
    if (DIFF) {
#pragma unroll
        for (int sh = 0; sh < 2; ++sh)
#pragma unroll
            for (int d0 = 0; d0 < 4; ++d0) { const bf16x8 v = *(const bf16x8*)(Qw + sh * 64 + d0 * 16); *(__attribute__((address_space(3))) bf16x8*)(qreg + (sh * 4 + d0) * 1024 + lane * 16) = v; }
    } else {
#pragma unroll
        for (int d0 = 0; d0 < 4; ++d0) qr[d0] = *(const bf16x8*)(Qw + d0 * 16);
    }
    float m1 = -1e30f, l1 = 0.f, m2 = -1e30f, l2 = 0.f;
    f32x16 o[DIFF ? 8 : 2];
#pragma unroll
    for (int i = 0; i < (DIFF ? 8 : 2); ++i) o[i] = f32x16{};
    const int vbl = (int)lds0 + 16384 + ((lane >> 4) & 1) * 32 + (lane & 3) * 8 + (4 * hi + ((lane & 15) >> 2)) * 64;
    const int gr = U.r0 + (wid >> 1); const int rs = gr < 4 ? 0 : (gr > 28 ? 24 : gr - 4);
    const int qc = 32 * (wid & 1) + r32; const int cs = qc < 8 ? 0 : (qc > 56 ? 48 : qc - 8);
    ATT_DMA_TILE(0, 0);
    for (int t = 0; t < ntile; ++t) {
        const int st = t & 1;
        asm volatile("s_waitcnt vmcnt(0) lgkmcnt(0)\n\ts_barrier" ::: "memory");
        if (t + 1 < ntile) ATT_DMA_TILE(t + 1, st ^ 1);
        bool use = true; int kr = 0;
        if (NAM && t < U.nlat) { kr = U.t0 + t; use = (kr >= rs) && (kr <= rs + 7); }
        if (use) {
            lds_cptr Ks = (lds_cptr)(shm3 + st * STAGE_B);
#pragma unroll
            for (int sh = 0; sh < (DIFF ? 2 : 1); ++sh) {
                if (DIFF) {
#pragma unroll
                    for (int d0 = 0; d0 < 4; ++d0) qr[d0] = *(const __attribute__((address_space(3))) bf16x8*)(qreg + (sh * 4 + d0) * 1024 + lane * 16);
                }
                f32x16 p0, p1;
                qkt(p0, p1, Ks + sh * 8192, qr, r32, hi);
                if (NAM && t < U.nlat) {
                    const __attribute__((address_space(3))) float* brow = (const __attribute__((address_space(3))) float*)(shm3 + L_BIAS) + (kr - gr + 7) * 128 + 48 + 15 - qc + 4 * hi;
#pragma unroll
                    for (int r = 0; r < 16; ++r) { const int kc = (r & 3) + 8 * (r >> 2);
                        const int kcl = kc + 4 * hi;
                        const float b0 = brow[kc], b1 = brow[kc + 32];
                        p0[r] = ((unsigned)(kcl - cs) < 16u) ? p0[r] + b0 : -INFINITY;
                        p1[r] = ((unsigned)(kcl + 32 - cs) < 16u) ? p1[r] + b1 : -INFINITY; }
                }
                float f;
                if (sh == 0) f = softmax_step(p0, p1, m1, l1); else f = softmax_step(p0, p1, m2, l2);
                if (__any(f != 1.0f)) {
                    if (hi == 0) wsf[r32] = f;
                    asm volatile("s_waitcnt lgkmcnt(0)" ::: "memory");
                    float fr_[16];
#pragma unroll
                    for (int r = 0; r < 16; ++r) fr_[r] = wsf[crow(r, hi)];
#pragma unroll
                    for (int d = 0; d < (DIFF ? 4 : 2); ++d)
#pragma unroll
                        for (int r = 0; r < 16; ++r) o[(DIFF ? sh * 4 : 0) + d][r] *= fr_[r];
                    asm volatile("s_waitcnt lgkmcnt(0)" ::: "memory");
                }
                u32x4 pw0, pw1, pw2, pw3;
                pw0 = (u32x4){cvtpk(p0[0], p0[1]), cvtpk(p0[2], p0[3]), cvtpk(p0[4], p0[5]), cvtpk(p0[6], p0[7])};
                pw1 = (u32x4){cvtpk(p0[8], p0[9]), cvtpk(p0[10], p0[11]), cvtpk(p0[12], p0[13]), cvtpk(p0[14], p0[15])};
                pw2 = (u32x4){cvtpk(p1[0], p1[1]), cvtpk(p1[2], p1[3]), cvtpk(p1[4], p1[5]), cvtpk(p1[6], p1[7])};
                pw3 = (u32x4){cvtpk(p1[8], p1[9]), cvtpk(p1[10], p1[11]), cvtpk(p1[12], p1[13]), cvtpk(p1[14], p1[15])};
                const bf16x8 a0 = __builtin_bit_cast(bf16x8, pw0), a1 = __builtin_bit_cast(bf16x8, pw1), a2 = __builtin_bit_cast(bf16x8, pw2), a3 = __builtin_bit_cast(bf16x8, pw3);
                ATT_SBAR();
                pv(&o[(DIFF ? sh * 4 : 0)], vbl + st * STAGE_B, a0, a1, a2, a3);
                if (DIFF) pv(&o[sh * 4 + 2], vbl + st * STAGE_B + 8192, a0, a1, a2, a3);
            }
        }
    }
    { auto rr = __builtin_amdgcn_permlane32_swap(__float_as_uint(l1), __float_as_uint(l1), false, false); l1 = __uint_as_float(rr[0]) + __uint_as_float(rr[1]); }
    if (DIFF) { auto rr = __builtin_amdgcn_permlane32_swap(__float_as_uint(l2), __float_as_uint(l2), false, false); l2 = __uint_as_float(rr[0]) + __uint_as_float(rr[1]); }
    if (hi == 0) { wsf[32 + r32] = 1.0f / l1; if (DIFF) wsf[64 + r32] = lam / l2; }
    asm volatile("s_waitcnt lgkmcnt(0)" ::: "memory");
    bf16_t* Ow = out + (size_t)(U.qrow0 + wid * 32) * OPITCH + U.ocol;
    if (!DIFF) {
        float rli[16];
#pragma unroll
        for (int r = 0; r < 16; ++r) rli[r] = wsf[32 + crow(r, hi)];
        __attribute__((address_space(3))) bf16_t* stg = (__attribute__((address_space(3))) bf16_t*)qreg;
#pragma unroll
        for (int r = 0; r < 16; ++r) { const int orow = crow(r, hi);
#pragma unroll
            for (int d0 = 0; d0 < 2; ++d0) stg[orow * 64 + d0 * 32 + r32] = (bf16_t)(cvtpk(o[d0][r] * rli[r], 0.f) & 0xffffu); }
        asm volatile("s_waitcnt lgkmcnt(0)" ::: "memory");
#pragma unroll
        for (int i = 0; i < 4; ++i) { const int row = i * 8 + (lane >> 3), ch = lane & 7; const u32x4 v = *(const __attribute__((address_space(3))) u32x4*)(stg + row * 64 + ch * 8); *(u32x4*)(Ow + (size_t)row * OPITCH + ch * 8) = v; }
        asm volatile("s_waitcnt lgkmcnt(0)" ::: "memory");
    } else {
        float c1[16], c2[16];
#pragma unroll
        for (int r = 0; r < 16; ++r) { c1[r] = wsf[32 + crow(r, hi)]; c2[r] = wsf[64 + crow(r, hi)]; }
        __attribute__((address_space(3))) float* stf = (__attribute__((address_space(3))) float*)qreg;
        const int rowl = lane >> 2, qtr = lane & 3;
        float gs[32];
#pragma unroll
        for (int e = 0; e < 32; ++e) gs[e] = subg[qtr * 32 + e] * outscale;
#pragma unroll
        for (int half = 0; half < 2; ++half) {
            asm volatile("s_waitcnt lgkmcnt(0)" ::: "memory");
#pragma unroll
            for (int rr = 0; rr < 8; ++rr) { const int r = half * 8 + rr; const int rl = crow(r, hi) - 16 * half;
#pragma unroll
                for (int d0 = 0; d0 < 4; ++d0) stf[rl * 128 + d0 * 32 + r32] = o[d0][r] * c1[r] - o[4 + d0][r] * c2[r]; }
            asm volatile("s_waitcnt lgkmcnt(0)" ::: "memory");
            float v[32]; float ss = 0.f;
#pragma unroll
            for (int e4 = 0; e4 < 8; ++e4) { const f32x4 x = *(const __attribute__((address_space(3))) f32x4*)(stf + rowl * 128 + qtr * 32 + e4 * 4);
                v[e4 * 4 + 0] = x[0]; v[e4 * 4 + 1] = x[1]; v[e4 * 4 + 2] = x[2]; v[e4 * 4 + 3] = x[3]; ss += x[0] * x[0] + x[1] * x[1] + x[2] * x[2] + x[3] * x[3]; }
            ss += __shfl_xor(ss, 1); ss += __shfl_xor(ss, 2);
            const float rstd = 1.0f / sqrtf(ss * (1.0f / 128.0f) + 1e-5f);
            bf16_t* dst = Ow + (size_t)(half * 16 + rowl) * OPITCH + qtr * 32;
#pragma unroll
            for (int e8 = 0; e8 < 4; ++e8) { u32x4 w;
                w.x = cvtpk(v[e8 * 8 + 0] * rstd * gs[e8 * 8 + 0], v[e8 * 8 + 1] * rstd * gs[e8 * 8 + 1]); w.y = cvtpk(v[e8 * 8 + 2] * rstd * gs[e8 * 8 + 2], v[e8 * 8 + 3] * rstd * gs[e8 * 8 + 3]);
                w.z = cvtpk(v[e8 * 8 + 4] * rstd * gs[e8 * 8 + 4], v[e8 * 8 + 5] * rstd * gs[e8 * 8 + 5]); w.w = cvtpk(v[e8 * 8 + 6] * rstd * gs[e8 * 8 + 6], v[e8 * 8 + 7] * rstd * gs[e8 * 8 + 7]);
                *(u32x4*)(dst + e8 * 8) = w; }
        }
        asm volatile("s_waitcnt lgkmcnt(0)" ::: "memory");
    }
    asm volatile("s_waitcnt lgkmcnt(0)\n\ts_barrier" ::: "memory");
}
#undef ATT_SBAR
#undef ATT_TILE_ROW
#undef ATT_DMA_TILE
}
constexpr int NWAVES = 8;
constexpr int NB = 8, SEQ = 2048, LC = 256, DM = 1024, FF = 4096, NPROJ = 3072;
constexpr int ML = NB * SEQ;
constexpr int MC = NB * LC;
constexpr int MT = ML + MC;
constexpr float NORM_EPS = 1e-6f;

constexpr size_t MiB = 1u << 20;
constexpr size_t WS_CTL = 0, CTL_ZERO_BYTES = 64 * 1024;
constexpr size_t WS_MADA = 1 * MiB;
constexpr size_t WS_ROPE = 1 * MiB + 512 * 1024;
constexpr size_t WS_LAM  = WS_ROPE + 16384;
constexpr size_t WS_WIN = 2 * MiB, WS_WOUT = 8 * MiB, WS_W1_0 = 10 * MiB, WS_W2_0 = 18 * MiB;
constexpr size_t WS_W1_1 = 26 * MiB, WS_W2_1 = 34 * MiB, WS_WGLU = 42 * MiB;
constexpr size_t WS_SSM_WEND = 2 * MiB;
constexpr size_t WS_SSM_B2 = 10 * MiB;
constexpr size_t WS_HB = 46 * MiB;
constexpr size_t WS_BIG = 82 * MiB;
constexpr size_t WS_SEND = 162 * MiB;
constexpr size_t WS_XC = 226 * MiB;
constexpr size_t WS_END = 256 * MiB;
static_assert(WS_BIG + (size_t)MT * FF * 2 <= WS_XC, "hid fits");
static_assert(WS_SEND + (size_t)64 * 1152 * 256 * 4 <= WS_END, "S_end fits");
static_assert(WS_BIG + (size_t)64 * 1280 * 512 * 2 <= WS_SEND, "A2 fits");

constexpr int RING_BYTES = 131072;
constexpr int LDSCTL_OFF = RING_BYTES, MISC_OFF = LDSCTL_OFF + 320;
constexpr int LDS_BYTES = 147456;

#define GAS __attribute__((address_space(1)))
#define LAS __attribute__((address_space(3)))
typedef unsigned short bf16;
typedef unsigned v4u __attribute__((ext_vector_type(4)));
typedef unsigned v2u __attribute__((ext_vector_type(2)));
typedef float f32x4 __attribute__((ext_vector_type(4)));
typedef GAS unsigned gu32;
#define RLX_AGENT __ATOMIC_RELAXED, __HIP_MEMORY_SCOPE_AGENT
#define LDS_WAIT() asm volatile("s_waitcnt lgkmcnt(0)" ::: "memory")
#define VM_WAIT() asm volatile("s_waitcnt vmcnt(0)" ::: "memory")
__device__ __forceinline__ unsigned f2bf(float f) { unsigned u = __builtin_bit_cast(unsigned, f); return (u + 0x7fffu + ((u >> 16) & 1u)) >> 16; }
__device__ __forceinline__ unsigned pk2(float lo, float hi) { return f2bf(lo) | (f2bf(hi) << 16); }

#define XB_TMO      128
#define XB_XCNT(j)  (256  + 64 * (j))
#define XB_XSUB(j)  (1280 + 64 * (j))
#define XB_XGEN(j)  (2304 + 64 * (j))
#define XB_TOP      3328
#define XB_TOPGEN   3392
#define XCD_BAR_WORDS 3456
#define XB_SPIN_CAP (1u << 18)
__device__ __forceinline__ unsigned xb_ld(unsigned* p)              { return __hip_atomic_load(p, __ATOMIC_RELAXED, __HIP_MEMORY_SCOPE_AGENT); }
__device__ __forceinline__ unsigned xb_add(unsigned* p, unsigned v) { return __hip_atomic_fetch_add(p, v, __ATOMIC_RELAXED, __HIP_MEMORY_SCOPE_AGENT); }
__device__ __forceinline__ unsigned xb_xcc_id() { return (unsigned)__builtin_amdgcn_s_getreg((3 << 11) | 20) & 0xFu; }
#define XB_SPIN(cond, bar) do { unsigned _sp = 0; while (cond) { __builtin_amdgcn_s_sleep(1); \
    if ((++_sp & 255u) == 0u) { if (xb_ld(&(bar)[XB_TMO])) break; if (_sp > XB_SPIN_CAP) { atomicAdd(&(bar)[XB_TMO], 1u); break; } } } } while (0)
struct XcdBarrier { unsigned* bar; unsigned x; volatile LAS unsigned* st; };
__device__ __forceinline__ XcdBarrier xcd_barrier_post(unsigned* bar, volatile LAS unsigned* st) {
    XcdBarrier b; b.bar = bar; b.x = xb_xcc_id(); b.st = st;
    if (threadIdx.x == 0) (void)xb_add(&bar[XB_XCNT(b.x)], 1u);
    return b;
}
__device__ __forceinline__ void xcd_barrier_complete(unsigned* bar, unsigned x, unsigned& nloc, unsigned& nx) {
    const unsigned G = gridDim.x * gridDim.y * gridDim.z;
    unsigned sum, cnt, mine, sp = 0u;
    for (;;) {
        sum = 0u; cnt = 0u; mine = 0u;
#pragma unroll
        for (unsigned j = 0; j < 16; ++j) { const unsigned c = xb_ld(&bar[XB_XCNT(j)]); sum += c; cnt += (c > 0u) ? 1u : 0u; mine = (j == x) ? c : mine; }
        if (sum == G) break;
        __builtin_amdgcn_s_sleep(1);
        if ((++sp & 255u) == 0u) { if (xb_ld(&bar[XB_TMO])) break; if (sp > XB_SPIN_CAP) { atomicAdd(&bar[XB_TMO], 1u); break; } }
    }
    nloc = mine > 0u ? mine : 1u; nx = cnt > 0u ? cnt : 1u;
}
__device__ __forceinline__ void xcd_barrier(const XcdBarrier& b) {
    asm volatile("s_waitcnt vmcnt(0)" ::: "memory");
    __syncthreads();
    if (threadIdx.x == 0) {
        unsigned* bar = b.bar;
        __builtin_amdgcn_s_waitcnt(0);
        unsigned nloc = b.st[0], nx = b.st[1];
        if (nloc == 0u) { xcd_barrier_complete(bar, b.x, nloc, nx); b.st[0] = nloc; b.st[1] = nx; }
        const unsigned old = xb_add(&bar[XB_XSUB(b.x)], 1u);
        const unsigned gen = old / nloc;
        if (old + 1u == (gen + 1u) * nloc) {
            __builtin_amdgcn_fence(__ATOMIC_RELEASE, "agent");
            asm volatile("s_waitcnt vmcnt(0)" ::: "memory");
            const unsigned og = xb_add(&bar[XB_TOP], 1u);
            const unsigned tg = og / nx;
            if (og + 1u == (tg + 1u) * nx) xb_add(&bar[XB_TOPGEN], 1u);
            else XB_SPIN(xb_ld(&bar[XB_TOPGEN]) == tg, bar);
            __builtin_amdgcn_fence(__ATOMIC_ACQUIRE, "agent");
            xb_add(&bar[XB_XGEN(b.x)], 1u);
            asm volatile("s_waitcnt vmcnt(0)" ::: "memory");
        } else {
            XB_SPIN(xb_ld(&bar[XB_XGEN(b.x)]) == gen, bar);
            __builtin_amdgcn_fence(__ATOMIC_ACQUIRE, "agent");
            asm volatile("s_waitcnt vmcnt(0)" ::: "memory");
        }
    }
    __syncthreads();
}

struct Frame {
    LAS unsigned char* lds;
    int vcu, G;
};
__device__ __forceinline__ float wave_sum(float v) {
#pragma unroll
    for (int o = 1; o < 64; o <<= 1) v += __shfl_xor(v, o);
    return v;
}

__device__ __forceinline__ void p0_transpose_item(const float* W, int K, int N, bf16* WT, int radd, LAS float* scr, int item, int lane) {
    const int nblk = N / 32, kb = item / nblk, nb = item % nblk, k0 = 64 * kb, n0 = 32 * nb;
#pragma unroll 8
    for (int i = 0; i < 32; ++i) { const int kk = 2 * i + (lane >> 5); scr[kk * 33 + (lane & 31)] = W[(size_t)(k0 + kk) * N + n0 + (lane & 31)]; }
    LDS_WAIT(); asm volatile("" ::: "memory");
    const int c = lane & 7;
#pragma unroll
    for (int j = 0; j < 4; ++j) { const int n = (lane >> 3) + 8 * j; const LAS float* s = scr + (8 * c) * 33 + n;
        v4u o; o.x = pk2(s[0 * 33], s[1 * 33]); o.y = pk2(s[2 * 33], s[3 * 33]); o.z = pk2(s[4 * 33], s[5 * 33]); o.w = pk2(s[6 * 33], s[7 * 33]);
        *(GAS v4u*)(WT + (size_t)(radd + n0 + n) * K + k0 + 8 * c) = o; }
    LDS_WAIT(); asm volatile("" ::: "memory");
}

struct Args {
    const float* in[29]; float* out; unsigned char* ws; int pad0, pad1;
};

struct ModVec { f32x4 gm[4], sh[4]; };
__device__ __forceinline__ void load_modvec(ModVec& mv, const float* normg, const float* mrow  , int lane) {
#pragma unroll
    for (int j = 0; j < 4; ++j) { const int c = 4 * lane + 256 * j;
        const f32x4 g = *(const f32x4*)(normg + c), sc = *(const f32x4*)(mrow + 1024 + c); mv.sh[j] = *(const f32x4*)(mrow + c);
        mv.gm[j] = g * (sc + 1.0f); }
}
__device__ __forceinline__ void norm_row(const float* xrow, const ModVec& mv, int lane, f32x4 (&y)[4]) {
    const f32x4* xr = (const f32x4*)xrow + lane;
    f32x4 v[4]; float s = 0.f;
#pragma unroll
    for (int j = 0; j < 4; ++j) { v[j] = xr[64 * j]; s += (v[j].x * v[j].x + v[j].y * v[j].y) + (v[j].z * v[j].z + v[j].w * v[j].w); }
    const float rstd = 1.0f / sqrtf(wave_sum(s) * (1.0f / 1024.0f) + NORM_EPS);
#pragma unroll
    for (int j = 0; j < 4; ++j) y[j] = v[j] * rstd * mv.gm[j] + mv.sh[j];
}

__device__ __forceinline__ void sincos_acc(double ang, float& s, float& c) {
    double rev = ang * 0.15915494309189535; rev -= floor(rev);
    const float r = (float)rev;
    s = __builtin_amdgcn_sinf(r); c = __builtin_amdgcn_cosf(r);
}
enum { I_X = 0, I_C, I_CTX, I_CCTX, I_WADA, I_BADA, I_N1G, I_N2G, I_FG, I_WIN, I_WOUT, I_LQ1, I_LK1, I_LQ2, I_LK2, I_SUBG, I_RPB,
       I_SLRE, I_SLIM, I_SLOG, I_SBRE, I_SBIM, I_SCRE, I_SCIM, I_SD, I_GLUA, I_GLUB, I_W1, I_W2 };

__global__ void __launch_bounds__(NWAVES * 64, 2) fwd_kernel(Args args) {
    extern __shared__ __attribute__((aligned(16))) unsigned char lds[];
    Frame F;
    F.lds = (LAS unsigned char*)lds;
    volatile LAS unsigned* MISC = (volatile LAS unsigned*)(F.lds + MISC_OFF);
    F.G = gridDim.x; { const int bx = blockIdx.x; F.vcu = (F.G % 8 == 0) ? (bx % 8) * (F.G / 8) + bx / 8 : bx; }
    unsigned char* ws = args.ws;
    gu32* ctl = (gu32*)(ws + WS_CTL);
    for (int u = threadIdx.x; u < (LDS_BYTES - LDSCTL_OFF) / 4; u += NWAVES * 64) ((LAS unsigned*)(F.lds + LDSCTL_OFF))[u] = 0u;
    __syncthreads();
    XcdBarrier bar = xcd_barrier_post((unsigned*)ctl + 1024, MISC + 8);
#define GRID_BAR() xcd_barrier(bar)
    const int NGW = F.G * NWAVES;
#define FRESH_IDS() int tid = threadIdx.x; asm volatile("" : "+v"(tid)); const int lane = tid & 63; const int wave = __builtin_amdgcn_readfirstlane(tid >> 6); const int gw = F.vcu * NWAVES + wave; (void)lane; (void)gw

    const float* x_in = args.in[I_X]; const float* ctx_in = args.in[I_CTX];
    float* xl = args.out;
    float* xc = (float*)(ws + WS_XC);
    float* mada = (float*)(ws + WS_MADA);
    float* rope = (float*)(ws + WS_ROPE);
    float* lamp = (float*)(ws + WS_LAM);
    bf16* HB = (bf16*)(ws + WS_HB);
    bf16* BIG = (bf16*)(ws + WS_BIG);

    {
        FRESH_IDS();
        if (F.vcu < 192) {
            const int l = F.vcu / 96, cg = F.vcu % 96;
            LAS float* act = (LAS float*)F.lds;
            LAS float* red = (LAS float*)(F.lds + 36864);
            const float* c = args.in[I_C]; const float* cc = args.in[I_CCTX];
            for (int i = tid; i < 9216; i += 512) { const float v = (i < 8192) ? c[i] : cc[i - 8192]; act[i] = v / (1.0f + __expf(-v)); }
            __syncthreads();
            const float* W = args.in[I_WADA] + (size_t)l * 1024 * 6144 + cg * 64 + lane;
            float acc[9];
#pragma unroll
            for (int r = 0; r < 9; ++r) acc[r] = 0.f;
            const int k0 = wave * 128;
#pragma unroll 8
            for (int kk = 0; kk < 128; ++kk) { const float wv = W[(size_t)(k0 + kk) * 6144];
#pragma unroll
                for (int r = 0; r < 9; ++r) acc[r] += act[r * 1024 + k0 + kk] * wv; }
#pragma unroll
            for (int r = 0; r < 9; ++r) red[(wave * 9 + r) * 64 + lane] = acc[r];
            __syncthreads();
            for (int i = tid; i < 576; i += 512) { const int r = i / 64, cl = i % 64; float s = args.in[I_BADA][l * 6144 + cg * 64 + cl];
#pragma unroll
                for (int w = 0; w < 8; ++w) s += red[(w * 9 + r) * 64 + cl];
                mada[(l * 9 + r) * 6144 + cg * 64 + cl] = s; }
            __syncthreads();
        } else if (F.vcu == 192) {
            for (int i = tid; i < 1024; i += 512) { const int pos = i >> 4, j = i & 15; const float inv = exp2f(-(float)j * (13.287712379549449f / 16.0f)); const float ang = (float)pos * inv;
                float sn, cs; sincos_acc((double)ang, sn, cs); rope[i] = cs; rope[1024 + i] = sn; }
            if (tid == 0) { float s1 = 0.f, s2 = 0.f;
                for (int i = 0; i < 64; ++i) { s1 += args.in[I_LQ1][i] * args.in[I_LK1][i]; s2 += args.in[I_LQ2][i] * args.in[I_LK2][i]; }
                lamp[0] = expf(s1) - expf(s2) + 0.2f; }
        }
        LAS float* scr = (LAS float*)(F.lds + 57344 + wave * 8448);
        constexpr int I_A = 16 * 96, I_B = 16 * 32, I_C1 = 16 * 128, I_C2 = 64 * 32, I_G = 16 * 32;
        constexpr int NITEMS = I_A + I_B + 2 * I_C1 + 2 * I_C2 + 2 * I_G;
        for (int it = gw; it < NITEMS; it += NGW) {
            int r = it;
            if (r < I_A) { p0_transpose_item(args.in[I_WIN], 1024, 3072, (bf16*)(ws + WS_WIN), 0, scr, r, lane); continue; } r -= I_A;
            if (r < I_B) { p0_transpose_item(args.in[I_WOUT], 1024, 1024, (bf16*)(ws + WS_WOUT), 0, scr, r, lane); continue; } r -= I_B;
            if (r < I_C1) { p0_transpose_item(args.in[I_W1], 1024, 4096, (bf16*)(ws + WS_W1_0), 0, scr, r, lane); continue; } r -= I_C1;
            if (r < I_C1) { p0_transpose_item(args.in[I_W1] + (size_t)1024 * 4096, 1024, 4096, (bf16*)(ws + WS_W1_1), 0, scr, r, lane); continue; } r -= I_C1;
            if (r < I_C2) { p0_transpose_item(args.in[I_W2], 4096, 1024, (bf16*)(ws + WS_W2_0), 0, scr, r, lane); continue; } r -= I_C2;
            if (r < I_C2) { p0_transpose_item(args.in[I_W2] + (size_t)4096 * 1024, 4096, 1024, (bf16*)(ws + WS_W2_1), 0, scr, r, lane); continue; } r -= I_C2;
            { const bool isb = r >= I_G; const int rr = isb ? r - I_G : r; const int n0 = 32 * (rr % 32); const int radd = 256 * (n0 / 128) + (n0 % 128) - n0 + (isb ? 128 : 0);
              p0_transpose_item(isb ? args.in[I_GLUB] : args.in[I_GLUA], 1024, 1024, (bf16*)(ws + WS_WGLU), radd, scr, rr, lane); }
        }
    }
    GRID_BAR();

#define NORM_TO_HB(LAYER, WHICH, NORMG_IDX, SRC_L, SRC_C, NROWS) do { FRESH_IDS(); \
        const int per = ((NROWS) + NGW - 1) / NGW; const int rb = gw * per, re = (rb + per < (NROWS)) ? rb + per : (NROWS); \
        int cur_r = -1; ModVec mv; \
        for (int row = rb; row < re; ++row) { const int r = row < ML ? (row >> 11) : 8; \
            if (r != cur_r) { load_modvec(mv, args.in[NORMG_IDX] + (LAYER) * 1024, mada + ((LAYER) * 9 + r) * 6144 + (WHICH) * 3072, lane); cur_r = r; } \
            const float* xr = row < ML ? (SRC_L) + (size_t)row * 1024 : (SRC_C) + (size_t)(row - ML) * 1024; \
            f32x4 y[4]; norm_row(xr, mv, lane, y); \
            GAS unsigned long long* o8 = (GAS unsigned long long*)(HB + (size_t)row * 1024) + lane; \
            _Pragma("unroll") for (int j = 0; j < 4; ++j) o8[64 * j] = (unsigned long long)pk2(y[j].x, y[j].y) | ((unsigned long long)pk2(y[j].z, y[j].w) << 32); } \
    } while (0)
    NORM_TO_HB(0, 0, I_N1G, x_in, ctx_in, MT);
    GRID_BAR();

    {
        pg8::Gemm g{HB, (const bf16*)(ws + WS_WIN), 1024, 1024, 1024}; pg8::StaticOrder S; S.init(MT, NPROJ, F.G, (int)blockIdx.x);
        pg8::EpiInProj E{BIG, rope};
        pg8::gemm_phase<pg8::EpiInProj, pg8::StaticOrder, true>(F.lds, g, S, E);
    }
    GRID_BAR();

    {
        const float lam = lamp[0];
        const float* subg = args.in[I_SUBG]; const float* rpb = args.in[I_RPB];
        const int v = F.vcu;
        att::lds_u8* shm = (att::lds_u8*)F.lds;
        if (v < 256) {
            const int b = v >> 5, h = (v >> 3) & 3, qb = v & 7;
            att::UnitDesc U; U.qrow0 = b * 2048 + qb * 256; U.qcol = h * 128; U.kcol = 512 + h * 128; U.vcol = 1024 + h * 128;
            U.latrow = b * 2048; U.t0 = 0; U.nlat = 32; U.ctxrow = ML + b * 256; U.ocol = h * 128; U.r0 = 0; U.head = 0;
            att::attn_unit<true, false>(U, BIG, HB, shm, rpb, subg, lam, 0.8f);
        }
        for (int k = 0; k < 2; ++k) {
            const int id = 2 * v + k; if (id >= 512) break;
            const int b = id >> 6, h = (id >> 3) & 7, rq = id & 7;
            const int ra = 4 * rq, rb_ = 4 * rq + 3; const int rsa = ra < 4 ? 0 : (ra > 28 ? 24 : ra - 4), rsb = rb_ < 4 ? 0 : (rb_ > 28 ? 24 : rb_ - 4);
            att::UnitDesc U; U.qrow0 = b * 2048 + rq * 256; U.qcol = 1536 + h * 64; U.kcol = 2048 + h * 64; U.vcol = 2560 + h * 64;
            U.latrow = b * 2048; U.t0 = rsa; U.nlat = rsb + 7 - rsa + 1; U.ctxrow = ML + b * 256; U.ocol = 512 + h * 64; U.r0 = ra; U.head = h;
            att::attn_unit<false, true>(U, BIG, HB, shm, rpb, subg, lam, 1.0f);
        }
        if (v < 32) {
            const int b = v >> 2, h = v & 3;
            att::UnitDesc U; U.qrow0 = ML + b * 256; U.qcol = h * 128; U.kcol = 512 + h * 128; U.vcol = 1024 + h * 128;
            U.latrow = 0; U.t0 = 0; U.nlat = 0; U.ctxrow = ML + b * 256; U.ocol = h * 128; U.r0 = 0; U.head = 0;
            att::attn_unit<true, false>(U, BIG, HB, shm, rpb, subg, lam, 0.8f);
        } else if (v < 96) {
            const int id = v - 32; const int b = id >> 3, h = id & 7;
            att::UnitDesc U; U.qrow0 = ML + b * 256; U.qcol = 1536 + h * 64; U.kcol = 2048 + h * 64; U.vcol = 2560 + h * 64;
            U.latrow = 0; U.t0 = 0; U.nlat = 0; U.ctxrow = ML + b * 256; U.ocol = 512 + h * 64; U.r0 = 0; U.head = 0;
            att::attn_unit<false, false>(U, BIG, HB, shm, rpb, subg, lam, 1.0f);
        }
    }
    GRID_BAR();

    {
        pg8::Gemm g{HB, (const bf16*)(ws + WS_WOUT), 1024, 1024, 1024}; pg8::StaticOrder S; S.init(MT, DM, F.G, (int)blockIdx.x);
        pg8::EpiResid E{x_in, ctx_in, xl, xc, mada + 2048};
        pg8::gemm_phase<pg8::EpiResid, pg8::StaticOrder, true>(F.lds, g, S, E);
    }
    GRID_BAR();
    NORM_TO_HB(0, 1, I_N2G, xl, xc, MT);
    GRID_BAR();
    {
        pg8::Gemm g{HB, (const bf16*)(ws + WS_W1_0), 1024, 1024, 1024}; pg8::StaticOrder S; S.init(MT, FF, F.G, (int)blockIdx.x);
        pg8::EpiRelu2 E{BIG, FF};
        pg8::gemm_phase<pg8::EpiRelu2, pg8::StaticOrder, true>(F.lds, g, S, E);
    }
    GRID_BAR();
    {
        pg8::Gemm g{BIG, (const bf16*)(ws + WS_W2_0), FF, FF, FF}; pg8::StaticOrder S; S.init(MT, DM, F.G, (int)blockIdx.x);
        pg8::EpiResid E{xl, xc, xl, xc, mada + 5120};
        pg8::gemm_phase<pg8::EpiResid, pg8::StaticOrder, true>(F.lds, g, S, E);
    }
    GRID_BAR();

    bf16* A2 = BIG;
    float* SEND = (float*)(ws + WS_SEND);
    {
        FRESH_IDS();
        if (F.vcu < 64) {
            const int g = F.vcu;
            LAS float* apr = (LAS float*)F.lds;
            LAS float* api = apr + 2 * 17 * 64;
            LAS float* bbr = api + 2 * 17 * 64;
            LAS float* bbi = bbr + 2 * 64 * 16;
            LAS float* Cr = bbi + 2 * 64 * 16;
            LAS float* Ci = Cr + 2 * 16 * 64;
            LAS float* Kd = Ci + 2 * 16 * 64;
            if (tid < 128) { const int d = tid >> 6, p = tid & 63; const int gp = (d * 64 + g) * 64 + p;
                const float lr = args.in[I_SLRE][gp], li = args.in[I_SLIM][gp]; const float delta = expf(args.in[I_SLOG][d * 64 + g]);
                for (int j = 0; j <= 16; ++j) { const float mag = expf(lr * delta * (float)j); float sn, cs; sincos_acc((double)li * (double)delta * (double)j, sn, cs);
                    apr[(d * 17 + j) * 64 + p] = mag * cs; api[(d * 17 + j) * 64 + p] = mag * sn; }
                const float ar = apr[(d * 17 + 1) * 64 + p], ai = api[(d * 17 + 1) * 64 + p];
                const float den = lr * lr + li * li, nr = ar - 1.0f; const float cr = (nr * lr + ai * li) / den, ci = (ai * lr - nr * li) / den;
                for (int h = 0; h < 16; ++h) { const float br = args.in[I_SBRE][(size_t)gp * 16 + h], bi = args.in[I_SBIM][(size_t)gp * 16 + h];
                    bbr[(d * 64 + p) * 16 + h] = cr * br - ci * bi; bbi[(d * 64 + p) * 16 + h] = cr * bi + ci * br; } }
            for (int i = tid; i < 2048; i += 512) { const int d = i >> 10, h = (i >> 6) & 15, p = i & 63;
                Cr[i] = args.in[I_SCRE][((size_t)(d * 64 + g) * 16 + h) * 64 + p]; Ci[i] = args.in[I_SCIM][((size_t)(d * 64 + g) * 16 + h) * 64 + p]; }
            __syncthreads();
            for (int i = tid; i < 8192; i += 512) { const int d = i >> 12, j = (i >> 8) & 15, h = (i >> 4) & 15, hp = i & 15; float s = 0.f;
                for (int p = 0; p < 64; ++p) { const float ar = apr[(d * 17 + j) * 64 + p], ai = api[(d * 17 + j) * 64 + p]; const float br = bbr[(d * 64 + p) * 16 + hp], bi = bbi[(d * 64 + p) * 16 + hp];
                    const float tr = ar * br - ai * bi, ti = ar * bi + ai * br; s += Cr[(d * 16 + h) * 64 + p] * tr - Ci[(d * 16 + h) * 64 + p] * ti; }
                Kd[i] = s; }
            __syncthreads();
            bf16* B2 = (bf16*)(ws + WS_SSM_B2) + (size_t)g * 256 * 512;
            for (int i = tid; i < 256 * 256; i += 512) { const int row = i >> 8, cp = i & 255; const int t = row >> 4, h = row & 15; float v[2];
#pragma unroll
                for (int e = 0; e < 2; ++e) { const int col = 2 * cp + e; float val;
                    if (col < 256) { const int k = col >> 4, hp = col & 15; val = 0.f;
                        if (k <= t) val += Kd[((0 * 16 + (t - k)) * 16 + h) * 16 + hp];
                        if (k >= t) val += Kd[((1 * 16 + (k - t)) * 16 + h) * 16 + hp]; }
                    else { const int q = col - 256; const int d = q >> 7, im = (q >> 6) & 1, p = q & 63; const int j = d == 0 ? t + 1 : 16 - t;
                        const float ar = apr[(d * 17 + j) * 64 + p], ai = api[(d * 17 + j) * 64 + p]; const float cr = Cr[(d * 16 + h) * 64 + p], ci = Ci[(d * 16 + h) * 64 + p];
                        val = im ? -(cr * ai + ci * ar) : (cr * ar - ci * ai); }
                    v[e] = val; }
                *(unsigned*)(B2 + (size_t)row * 512 + 2 * cp) = pk2(v[0], v[1]); }
            bf16* WE = (bf16*)(ws + WS_SSM_WEND) + (size_t)g * 256 * 256;
            for (int i = tid; i < 256 * 128; i += 512) { const int n = i >> 7, cp = i & 127; const int d = n >> 7, im = (n >> 6) & 1, p = n & 63; float v[2];
#pragma unroll
                for (int e = 0; e < 2; ++e) { const int col = 2 * cp + e; const int k = col >> 4, hp = col & 15; const int j = d == 0 ? 15 - k : k;
                    const float ar = apr[(d * 17 + j) * 64 + p], ai = api[(d * 17 + j) * 64 + p]; const float br = bbr[(d * 64 + p) * 16 + hp], bi = bbi[(d * 64 + p) * 16 + hp];
                    v[e] = im ? (ar * bi + ai * br) : (ar * br - ai * bi); }
                *(unsigned*)(WE + (size_t)n * 256 + 2 * cp) = pk2(v[0], v[1]); }
            __syncthreads();
        }
        const int per = (MT + NGW - 1) / NGW; const int rb = gw * per, re = (rb + per < MT) ? rb + per : MT;
        int cur_r = -1; ModVec mv;
        for (int row = rb; row < re; ++row) { const int r = row < ML ? (row >> 11) : 8;
            if (r != cur_r) { load_modvec(mv, args.in[I_N1G] + 1024, mada + (9 + r) * 6144, lane); cur_r = r; }
            const float* xr = row < ML ? xl + (size_t)row * 1024 : xc + (size_t)(row - ML) * 1024;
            f32x4 y[4]; norm_row(xr, mv, lane, y);
            int ridx, k;
            if (row < ML) { const int b = row >> 11, t = row & 2047; ridx = b * 128 + (t >> 4); k = t & 15; } else { const int q = row - ML; const int b = q >> 8, t = q & 255; ridx = 1024 + b * 16 + (t >> 4); k = t & 15; }
#pragma unroll
            for (int j = 0; j < 4; ++j) { const int g = 16 * j + (lane >> 2); const int hp = 4 * (lane & 3);
                *(GAS unsigned long long*)(A2 + ((size_t)(g * 1280 + ridx)) * 512 + k * 16 + hp) = (unsigned long long)pk2(y[j].x, y[j].y) | ((unsigned long long)pk2(y[j].z, y[j].w) << 32); }
        }
    }
    GRID_BAR();
    {
        pg8::Gemm g{A2, (const bf16*)(ws + WS_SSM_WEND), 512, 256, 256}; pg8::SsmOrder S{F.G, (int)blockIdx.x, 5};
        pg8::EpiSsm1 E{SEND};
        pg8::gemm_phase<pg8::EpiSsm1, pg8::SsmOrder, true>(F.lds, g, S, E);
    }
    GRID_BAR();
    {
        FRESH_IDS();
        const int gt = (int)blockIdx.x * 512 + tid;
        if (gt < 65536) {
            const int p = gt & 63, d = (gt >> 6) & 1, b = (gt >> 7) & 7, g = gt >> 10;
            const int gp = (d * 64 + g) * 64 + p;
            const float lr = args.in[I_SLRE][gp], li = args.in[I_SLIM][gp]; const float delta = expf(args.in[I_SLOG][d * 64 + g]);
            const float mag = expf(lr * delta * 16.0f); float sn, cs; sincos_acc((double)li * (double)delta * 16.0, sn, cs);
            const float aTr = mag * cs, aTi = mag * sn;
            const float* Sg = SEND + (size_t)g * 1152 * 256 + d * 128 + p;
            bf16* Ag = A2 + (size_t)g * 1280 * 512 + 256 + d * 128 + p;
            float cr = 0.f, ci = 0.f;
            for (int s0 = 0; s0 < 144; s0 += 16) {
                float sr[16], si[16]; int ridx[16];
#pragma unroll
                for (int q = 0; q < 16; ++q) { const int s = s0 + q; int c;
                    if (s < 16) { c = d == 0 ? s : 15 - s; ridx[q] = 1024 + b * 16 + c; } else { c = d == 0 ? s - 16 : 143 - s; ridx[q] = b * 128 + c; }
                    sr[q] = Sg[(size_t)ridx[q] * 256]; si[q] = Sg[(size_t)ridx[q] * 256 + 64]; }
#pragma unroll
                for (int q = 0; q < 16; ++q) {
                    if (s0 >= 16) { Ag[(size_t)ridx[q] * 512] = (bf16)f2bf(cr); Ag[(size_t)ridx[q] * 512 + 64] = (bf16)f2bf(ci); }
                    const float nr = aTr * cr - aTi * ci + sr[q], ni = aTr * ci + aTi * cr + si[q]; cr = nr; ci = ni; }
            }
        }
    }
    GRID_BAR();
    {
        pg8::Gemm g{A2, (const bf16*)(ws + WS_SSM_B2), 512, 512, 512}; pg8::SsmOrder S{F.G, (int)blockIdx.x, 4};
        pg8::EpiSsm2 E{HB, A2, args.in[I_SD]};
        pg8::gemm_phase<pg8::EpiSsm2, pg8::SsmOrder, true>(F.lds, g, S, E);
    }
    GRID_BAR();
    {
        pg8::Gemm g{HB, (const bf16*)(ws + WS_WGLU), 1024, 1024, 1024}; pg8::StaticOrder S; S.init(ML, 2048, F.G, (int)blockIdx.x);
        pg8::EpiGlu E{xl, mada + 9 * 6144 + 2048};
        pg8::gemm_phase<pg8::EpiGlu, pg8::StaticOrder, true>(F.lds, g, S, E);
    }
    GRID_BAR();
    NORM_TO_HB(1, 1, I_N2G, xl, xc, ML);
    GRID_BAR();
    {
        pg8::Gemm g{HB, (const bf16*)(ws + WS_W1_1), 1024, 1024, 1024}; pg8::StaticOrder S; S.init(ML, FF, F.G, (int)blockIdx.x);
        pg8::EpiRelu2 E{BIG, FF};
        pg8::gemm_phase<pg8::EpiRelu2, pg8::StaticOrder, true>(F.lds, g, S, E);
    }
    GRID_BAR();
    {
        pg8::Gemm g{BIG, (const bf16*)(ws + WS_W2_1), FF, FF, FF}; pg8::StaticOrder S; S.init(ML, DM, F.G, (int)blockIdx.x);
        pg8::EpiResid E{xl, xc, xl, xc, mada + 9 * 6144 + 5120};
        pg8::gemm_phase<pg8::EpiResid, pg8::StaticOrder, true>(F.lds, g, S, E);
    }
    GRID_BAR();
    {
        FRESH_IDS();
        const float* fg = args.in[I_FG];
        f32x4 gv[4];
#pragma unroll
        for (int j = 0; j < 4; ++j) gv[j] = *(const f32x4*)(fg + 4 * lane + 256 * j);
        for (int row = gw; row < ML; row += NGW) {
            f32x4* xr = (f32x4*)(xl + (size_t)row * 1024) + lane;
            f32x4 v[4]; float s = 0.f;
#pragma unroll
            for (int j = 0; j < 4; ++j) { v[j] = xr[64 * j]; s += (v[j].x * v[j].x + v[j].y * v[j].y) + (v[j].z * v[j].z + v[j].w * v[j].w); }
            const float rstd = 1.0f / sqrtf(wave_sum(s) * (1.0f / 1024.0f) + NORM_EPS);
#pragma unroll
            for (int j = 0; j < 4; ++j) xr[64 * j] = v[j] * rstd * gv[j];
        }
    }
#undef GRID_BAR
#undef FRESH_IDS
#undef NORM_TO_HB
}

extern "C" void kernel_launch(void* const* d_in, const int* in_sizes, int n_in, void* d_out, int out_size, void* d_ws, size_t ws_size, hipStream_t stream) {
    static int grid = 0;
    if (grid == 0) {
        if (n_in != 29 || out_size != ML * DM || ws_size < WS_END) { fprintf(stderr, "kernel_launch: unexpected shapes (n_in %d out %d ws %zu)\n", n_in, out_size, ws_size); grid = -1; return; }
        int dev = 0, cus = 0;
        if (hipGetDevice(&dev) != hipSuccess || hipDeviceGetAttribute(&cus, hipDeviceAttributeMultiprocessorCount, dev) != hipSuccess) { grid = -1; return; }
        if (hipFuncSetAttribute((const void*)fwd_kernel, hipFuncAttributeMaxDynamicSharedMemorySize, LDS_BYTES) != hipSuccess) { fprintf(stderr, "kernel_launch: hipFuncSetAttribute failed\n"); grid = -1; return; }
        int per_cu = 0;
        if (hipOccupancyMaxActiveBlocksPerMultiprocessor(&per_cu, (const void*)fwd_kernel, NWAVES * 64, LDS_BYTES) != hipSuccess || per_cu < 1) fprintf(stderr, "kernel_launch: occupancy query says %d\n", per_cu);
        (void)hipGetLastError();
        grid = cus;
    }
    if (grid < 0) return;
    (void)hipMemsetAsync((char*)d_ws + WS_CTL, 0, CTL_ZERO_BYTES, stream);
    Args a{};
    for (int i = 0; i < 29; ++i) a.in[i] = (const float*)d_in[i];
    a.out = (float*)d_out; a.ws = (unsigned char*)d_ws;
    hipLaunchKernelGGL(fwd_kernel, dim3(grid), dim3(NWAVES * 64), LDS_BYTES, stream, a);
}
```

```cpp
#include <hip/hip_runtime.h>
#include <hip/hip_bf16.h>
#include <cstdio>
#include <cstdint>
#include <cmath>
namespace pg8 {
#define PG8_LAS __attribute__((address_space(3)))
typedef unsigned short bf16_t;
typedef short bf16x8 __attribute__((ext_vector_type(8)));
typedef float f32x4 __attribute__((ext_vector_type(4)));
typedef float f32x2 __attribute__((ext_vector_type(2)));
typedef unsigned u32x4 __attribute__((ext_vector_type(4)));
typedef unsigned u32x2 __attribute__((ext_vector_type(2)));
constexpr int BM = 256, BK = 64, HALF = 128, HTB = HALF * BK * 2, STAGE_BYTES = 8 * HTB, NXCD = 8, WGM = 8;

__host__ __device__ __forceinline__ int lds_byte(int r, int c) { const int st = (r >> 4) * 2 + (c >> 5), rr = r & 15, cc = c & 31, ob = rr * 64 + cc * 2; return st * 1024 + (ob ^ (((ob >> 9) & 1) << 5)); }
__host__ __device__ __forceinline__ void stage_rc(int b, int& R, int& C) { const int st = b / 1024, sb = b % 1024, swz = sb ^ (((sb >> 9) & 1) << 5); R = (st >> 1) * 16 + swz / 64; C = (st & 1) * 32 + (swz % 64) / 2; }
__host__ __device__ __forceinline__ int perm32(int rho) { const int n = rho >> 4, i = rho & 15; return 8 * (i >> 2) + 4 * n + (i & 3); }

constexpr int ACTX_TILE0 = 1472;
struct Unit { int pm, pn, kt0, nt, slab; };
struct Gemm { const bf16_t* A; const bf16_t* Bt; int lda, ldb, K; long ajump = 0; };

struct StaticOrder {
    int nM, nN, nwg, G, c, ntk;
    __host__ __device__ __forceinline__ int atile(const Unit& u) const { return u.pm; }
    __host__ __device__ __forceinline__ void init(int M, int N, int G_, int c_, int K_ = 1024) { nM = M / BM; nN = N / BM; nwg = nM * nN; G = G_; c = c_; ntk = K_ / BK; }
    __host__ __device__ __forceinline__ bool next(int i, Unit& u) const {
        const long L = (long)i * G + c; if (L >= nwg) return false;
        int wgid = (int)L; { const int q = nwg / NXCD, r = nwg % NXCD, xcd = wgid % NXCD, off = wgid / NXCD; wgid = (xcd < r ? xcd * (q + 1) : r * (q + 1) + (xcd - r) * q) + off; }
        const int nig = WGM * nN, gid = wgid / nig, fm = gid * WGM, gsz = (nM - fm) < WGM ? (nM - fm) : WGM;
        u.pm = fm + ((wgid % nig) % gsz); u.pn = (wgid % nig) / gsz; u.kt0 = 0; u.nt = ntk; u.slab = -1; return true;
    }
};
struct SplitOrder {
    int G, c, ntk, lsp;
    __device__ __forceinline__ int atile(const Unit& u) const { return u.pm; }
    __device__ __forceinline__ void init(int G_, int c_, int K_, int lsp_) { G = G_; c = c_; ntk = K_ / BK; lsp = lsp_; }
    __device__ __forceinline__ bool next(int i, Unit& u) const {
        const int L = i * G + c;
        if (L >= 256 + (32 << lsp)) return false;
        const bool lat = L < 256;
        const int wl = (L & 7) * 32 + (L >> 3); const int gid = wl >> 5, wi = wl & 31;
        const int j = L - 256;
        const int pm = lat ? gid * 8 + (wi & 7) : 64 + (j >> (lsp + 2));
        const int pn = lat ? (wi >> 3) : ((j >> lsp) & 3);
        const int sl = lat ? -1 : (j & ((1 << lsp) - 1));
        const int nt = lat ? ntk : (ntk >> lsp);
        u.pm = pm; u.pn = pn; u.slab = sl; u.nt = nt; u.kt0 = lat ? 0 : sl * nt;
        return true;
    }
};
struct CtxSliceOrder {
    int G, c, ntk, lsp;
    __device__ __forceinline__ int atile(const Unit& u) const { return u.pm; }
    __device__ __forceinline__ bool next(int i, Unit& u) const {
        const int j = i * G + c;
        if (j >= (32 << lsp)) return false;
        const int sl = j & ((1 << lsp) - 1), nt = ntk >> lsp;
        u.pm = 64 + (j >> (lsp + 2)); u.pn = (j >> lsp) & 3; u.slab = sl; u.nt = nt; u.kt0 = sl * nt;
        return true;
    }
};
struct SsmOrder {
    int G, c, nrow, ntk;
    __device__ __forceinline__ int atile(const Unit& u) const { const int i = u.pm - 5 * u.pn; return i < 4 ? u.pn * 4 + i : ACTX_TILE0 + u.pn; }
    __device__ __forceinline__ bool next(int i, Unit& u) const {
        const int L = i * G + c; if (L >= 64 * nrow) return false;
        if (nrow == 4 && G == 256) {
            const int x = c & 7, s = c >> 3, q = x * 8 + (s >> 2), e = s & 3; const int g = 4 * (q & 15) + e, it = q >> 4;
            u.pm = g * 5 + it; u.pn = g; u.kt0 = 0; u.nt = ntk; u.slab = -1; return true; }
        const int g = L / nrow; u.pm = g * 5 + (L - g * nrow); u.pn = g; u.kt0 = 0; u.nt = ntk; u.slab = -1; return true;
    }
};

__device__ __forceinline__ unsigned cvt_pk_bf16(float lo, float hi) { unsigned r; asm volatile("v_cvt_pk_bf16_f32 %0, %1, %2" : "=v"(r) : "v"(lo), "v"(hi)); return r; }
__device__ __forceinline__ float bf16lo(unsigned w) { return __uint_as_float(w << 16); }
__device__ __forceinline__ float bf16hi(unsigned w) { return __uint_as_float(w & 0xffff0000u); }

constexpr float QSCALE = 0.125f * 1.4426950408889634f;


struct EpiInProj {
    static constexpr bool PERM = true;
    bf16_t* O; const PG8_LAS float* rope;
    __device__ __forceinline__ void operator()(const f32x4 (&acc)[2][2][4][2], const Unit& u, int wr, int wc, int fr, int fq) const {
        asm volatile("" : "+v"(fr), "+v"(fq));
        const int pn = u.pn; const bool dorope = (u.pm < 64) && (pn < 4);
        const float sc = (pn < 2 || pn == 6 || pn == 7) ? QSCALE : 1.0f;
        const int row0 = u.pm * BM + wr * 64 + fr, col0 = pn * BM + wc * 32 + 8 * fq;
        const float sgn = (fq < 2) ? -1.0f : 1.0f; const int j0 = 8 * (fq & 1);
#pragma unroll
        for (int ai = 0; ai < 2; ++ai)
#pragma unroll
            for (int m = 0; m < 4; ++m) {
                const int row = row0 + ai * HALF + m * 16;
                f32x4 cs0 = (f32x4){1.f, 1.f, 1.f, 1.f}, cs1 = cs0, sn0 = (f32x4){0.f, 0.f, 0.f, 0.f}, sn1 = sn0;
                if (dorope) { const int t = row & 2047; const int pos = (wc & 1) ? (t & 63) : (t >> 6); const PG8_LAS float* rp = rope + pos * 16 + j0;
                    cs0 = *(const PG8_LAS f32x4*)rp; cs1 = *(const PG8_LAS f32x4*)(rp + 4); sn0 = *(const PG8_LAS f32x4*)(rp + 1024) * sgn; sn1 = *(const PG8_LAS f32x4*)(rp + 1028) * sgn; }
                bf16_t* rowp = O + (size_t)row * 3072 + col0;
#pragma unroll
                for (int bj = 0; bj < 2; ++bj) {
                    f32x4 x0 = acc[ai][bj][m][0], x1 = acc[ai][bj][m][1], y0 = x0, y1 = x1;
                    if (dorope) {
#pragma unroll
                        for (int e2 = 0; e2 < 4; ++e2) {
                            const auto ra = __builtin_amdgcn_permlane32_swap(__float_as_uint(x0[e2]), __float_as_uint(x0[e2]), false, false);
                            const auto rb = __builtin_amdgcn_permlane32_swap(__float_as_uint(x1[e2]), __float_as_uint(x1[e2]), false, false);
                            const float p0 = (fq < 2) ? __uint_as_float(ra[1]) : __uint_as_float(ra[0]);
                            const float p1 = (fq < 2) ? __uint_as_float(rb[1]) : __uint_as_float(rb[0]);
                            y0[e2] = x0[e2] * cs0[e2] + p0 * sn0[e2]; y1[e2] = x1[e2] * cs1[e2] + p1 * sn1[e2]; } }
                    y0 = y0 * sc; y1 = y1 * sc;
                    u32x4 w; w.x = cvt_pk_bf16(y0[0], y0[1]); w.y = cvt_pk_bf16(y0[2], y0[3]); w.z = cvt_pk_bf16(y1[0], y1[1]); w.w = cvt_pk_bf16(y1[2], y1[3]);
                    *(u32x4*)(rowp + bj * HALF) = w;
                }
            }
    }
};

template <bool BASEF32>
struct EpiResid {
    static constexpr bool PERM = true;
    const void* base_l; const void* base_c; bf16_t* out_l; bf16_t* out_c; const float* gate; bf16_t* slabs;
    __device__ __forceinline__ void operator()(const f32x4 (&acc)[2][2][4][2], const Unit& u, int wr, int wc, int fr, int fq) const {
        asm volatile("" : "+v"(fr), "+v"(fq));
        const bool lat = u.pm < 64; const int r = lat ? (u.pm >> 3) : 8;
        const size_t toff = (size_t)(lat ? u.pm : u.pm - 64) * BM * 1024;
        const int col0 = u.pn * BM + wc * 32 + 8 * fq;
        if (u.slab >= 0) {
            bf16_t* so = slabs + (size_t)u.slab * 2048 * 1024 + toff;
#pragma unroll
            for (int ai = 0; ai < 2; ++ai)
#pragma unroll
                for (int m = 0; m < 4; ++m) { const size_t p = (size_t)(wr * 64 + fr + ai * HALF + m * 16) * 1024 + col0;
#pragma unroll
                    for (int bj = 0; bj < 2; ++bj) { const f32x4 v0 = acc[ai][bj][m][0], v1 = acc[ai][bj][m][1];
                        u32x4 w; w.x = cvt_pk_bf16(v0[0], v0[1]); w.y = cvt_pk_bf16(v0[2], v0[3]); w.z = cvt_pk_bf16(v1[0], v1[1]); w.w = cvt_pk_bf16(v1[2], v1[3]);
                        *(u32x4*)(so + p + bj * HALF) = w; } }
            return; }
        bf16_t* out = (lat ? out_l : out_c) + toff;
        const float* gv = gate + r * 6144 + col0;
        f32x4 g[2][2];
#pragma unroll
        for (int bj = 0; bj < 2; ++bj)
#pragma unroll
            for (int n = 0; n < 2; ++n) g[bj][n] = *(const f32x4*)(gv + bj * HALF + n * 4);
#pragma unroll
        for (int ai = 0; ai < 2; ++ai) {
            f32x4 bf[BASEF32 ? 4 : 1][2][2]; u32x4 bw[BASEF32 ? 1 : 4][2];
#pragma unroll
            for (int m = 0; m < 4; ++m) { const size_t p = (size_t)(wr * 64 + fr + ai * HALF + m * 16) * 1024 + col0;
#pragma unroll
                for (int bj = 0; bj < 2; ++bj) {
                    if (BASEF32) { const float* bp = (const float*)(lat ? base_l : base_c) + toff + p + bj * HALF; bf[BASEF32 ? m : 0][bj][0] = *(const f32x4*)bp; bf[BASEF32 ? m : 0][bj][1] = *(const f32x4*)(bp + 4); }
                    else bw[BASEF32 ? 0 : m][bj] = *(const u32x4*)((const bf16_t*)(lat ? base_l : base_c) + toff + p + bj * HALF); } }
#pragma unroll
            for (int m = 0; m < 4; ++m) { const size_t p = (size_t)(wr * 64 + fr + ai * HALF + m * 16) * 1024 + col0;
#pragma unroll
                for (int bj = 0; bj < 2; ++bj) { f32x4 b0, b1;
                    if (BASEF32) { b0 = bf[BASEF32 ? m : 0][bj][0]; b1 = bf[BASEF32 ? m : 0][bj][1]; }
                    else { const u32x4 w = bw[BASEF32 ? 0 : m][bj];
                        b0 = (f32x4){bf16lo(w.x), bf16hi(w.x), bf16lo(w.y), bf16hi(w.y)}; b1 = (f32x4){bf16lo(w.z), bf16hi(w.z), bf16lo(w.w), bf16hi(w.w)}; }
                    const f32x4 o0 = b0 + g[bj][0] * acc[ai][bj][m][0], o1 = b1 + g[bj][1] * acc[ai][bj][m][1];
                    u32x4 wo; wo.x = cvt_pk_bf16(o0[0], o0[1]); wo.y = cvt_pk_bf16(o0[2], o0[3]); wo.z = cvt_pk_bf16(o1[0], o1[1]); wo.w = cvt_pk_bf16(o1[2], o1[3]);
                    *(u32x4*)(out + p + bj * HALF) = wo; } } }
    }
};

struct EpiResidFinal {
    static constexpr bool PERM = true;
    const bf16_t* base; const bf16_t* base2; float* out; const float* gate; const float* gain; float* stat; unsigned* cnt; PG8_LAS float* red;
    __device__ __forceinline__ void operator()(const f32x4 (&acc)[2][2][4][2], const Unit& u, int wr, int wc, int fr, int fq) const {
        { int t_ = threadIdx.x; asm volatile("" : "+v"(t_)); fr = t_ & 15; fq = (t_ >> 4) & 3; }
        const int r = u.pm >> 3; const size_t toff = (size_t)u.pm * BM * 1024; const int col0 = u.pn * BM + wc * 32 + 8 * fq;
        const float* gv = gate + r * 6144 + col0;
        f32x4 g[2][2];
#pragma unroll
        for (int bj = 0; bj < 2; ++bj)
#pragma unroll
            for (int n = 0; n < 2; ++n) g[bj][n] = *(const f32x4*)(gv + bj * HALF + n * 4);
        f32x4 o[2][2][4][2]; float ss[2][4];
#pragma unroll
        for (int ai = 0; ai < 2; ++ai) { u32x4 bw[4][2];
#pragma unroll
            for (int m = 0; m < 4; ++m)
#pragma unroll
                for (int bj = 0; bj < 2; ++bj) bw[m][bj] = *(const u32x4*)((u.pm < 48 ? base : base2) + toff + (size_t)(wr * 64 + fr + ai * HALF + m * 16) * 1024 + col0 + bj * HALF);
#pragma unroll
            for (int m = 0; m < 4; ++m) { float s_ = 0.f;
#pragma unroll
                for (int bj = 0; bj < 2; ++bj) { const u32x4 w = bw[m][bj];
                    const f32x4 b0 = (f32x4){bf16lo(w.x), bf16hi(w.x), bf16lo(w.y), bf16hi(w.y)}, b1 = (f32x4){bf16lo(w.z), bf16hi(w.z), bf16lo(w.w), bf16hi(w.w)};
                    const f32x4 o0 = b0 + g[bj][0] * acc[ai][bj][m][0], o1 = b1 + g[bj][1] * acc[ai][bj][m][1];
                    o[ai][bj][m][0] = o0; o[ai][bj][m][1] = o1;
                    s_ += (o0[0] * o0[0] + o0[1] * o0[1]) + (o0[2] * o0[2] + o0[3] * o0[3]) + (o1[0] * o1[0] + o1[1] * o1[1]) + (o1[2] * o1[2] + o1[3] * o1[3]); }
                s_ += __shfl_xor(s_, 16); s_ += __shfl_xor(s_, 32); ss[ai][m] = s_; } }
        if (fq == 0) {
#pragma unroll
            for (int ai = 0; ai < 2; ++ai)
#pragma unroll
                for (int m = 0; m < 4; ++m) red[(wr * 4 + wc) * 128 + ai * 64 + m * 16 + fr] = ss[ai][m]; }
        __syncthreads();
        int tid = threadIdx.x; asm volatile("" : "+v"(tid));
        if (tid < 256) { const int w2 = tid >> 7, rr = tid & 127;
            const float t = (red[(w2 * 4 + 0) * 128 + rr] + red[(w2 * 4 + 1) * 128 + rr]) + (red[(w2 * 4 + 2) * 128 + rr] + red[(w2 * 4 + 3) * 128 + rr]);
            __hip_atomic_store(stat + ((size_t)u.pm * 4 + u.pn) * 256 + tid, t, __ATOMIC_RELAXED, __HIP_MEMORY_SCOPE_AGENT); }
        asm volatile("s_waitcnt vmcnt(0)" ::: "memory");
        __syncthreads();
        if (tid == 0) { __hip_atomic_fetch_add(cnt + u.pm, 1u, __ATOMIC_RELAXED, __HIP_MEMORY_SCOPE_AGENT);
            unsigned sp = 0; while (__hip_atomic_load(cnt + u.pm, __ATOMIC_RELAXED, __HIP_MEMORY_SCOPE_AGENT) < 4u) { __builtin_amdgcn_s_sleep(1); if (++sp > (1u << 22)) break; } }
        __syncthreads();
        if (tid < 256) { float t = 0.f;
#pragma unroll
            for (int q = 0; q < 4; ++q) t += __hip_atomic_load(stat + ((size_t)u.pm * 4 + q) * 256 + tid, __ATOMIC_RELAXED, __HIP_MEMORY_SCOPE_AGENT);
            red[1024 + tid] = 1.0f / sqrtf(t * (1.0f / 1024.0f) + 1e-6f); }
        __syncthreads();
        f32x4 gn[2][2];
#pragma unroll
        for (int bj = 0; bj < 2; ++bj)
#pragma unroll
            for (int n = 0; n < 2; ++n) gn[bj][n] = *(const f32x4*)(gain + col0 + bj * HALF + n * 4);
#pragma unroll
        for (int ai = 0; ai < 2; ++ai)
#pragma unroll
            for (int m = 0; m < 4; ++m) { const int rl = wr * 64 + fr + ai * HALF + m * 16; const float rstd = red[1024 + wr * 128 + ai * 64 + m * 16 + fr];
                float* op = out + toff + (size_t)rl * 1024 + col0;
#pragma unroll
                for (int bj = 0; bj < 2; ++bj) { *(f32x4*)(op + bj * HALF) = o[ai][bj][m][0] * rstd * gn[bj][0]; *(f32x4*)(op + bj * HALF + 4) = o[ai][bj][m][1] * rstd * gn[bj][1]; } }
    }
};

struct EpiResidNorm {
    static constexpr bool PERM = true;
    const float* base; bf16_t* out; const float* gate; bf16_t* H; const float* n2g; const float* mod; float* stat; unsigned* cnt; PG8_LAS float* red;
    __device__ __forceinline__ void operator()(const f32x4 (&acc)[2][2][4][2], const Unit& u, int wr, int wc, int fr, int fq) const {
        { int t_ = threadIdx.x; asm volatile("" : "+v"(t_)); fr = t_ & 15; fq = (t_ >> 4) & 3; }
        const int col0 = u.pn * BM + wc * 32 + 8 * fq;
        const int r = u.pm >> 3; const size_t toff = (size_t)u.pm * BM * 1024;
        const float* gv = gate + r * 6144 + col0;
        f32x4 g[2][2];
#pragma unroll
        for (int bj = 0; bj < 2; ++bj)
#pragma unroll
            for (int n = 0; n < 2; ++n) g[bj][n] = *(const f32x4*)(gv + bj * HALF + n * 4);
        f32x4 o[2][2][4][2]; float ss[2][4];
#pragma unroll
        for (int ai = 0; ai < 2; ++ai)
#pragma unroll
            for (int m = 0; m < 4; ++m) { f32x4 bf[2][2]; float s_ = 0.f;
#pragma unroll
                for (int bj = 0; bj < 2; ++bj) { const float* bp = base + toff + (size_t)(wr * 64 + fr + ai * HALF + m * 16) * 1024 + col0 + bj * HALF; bf[bj][0] = *(const f32x4*)bp; bf[bj][1] = *(const f32x4*)(bp + 4); }
#pragma unroll
                for (int bj = 0; bj < 2; ++bj) {
                    const f32x4 o0 = bf[bj][0] + g[bj][0] * acc[ai][bj][m][0], o1 = bf[bj][1] + g[bj][1] * acc[ai][bj][m][1];
                    o[ai][bj][m][0] = o0; o[ai][bj][m][1] = o1;
                    s_ += (o0[0] * o0[0] + o0[1] * o0[1]) + (o0[2] * o0[2] + o0[3] * o0[3]) + (o1[0] * o1[0] + o1[1] * o1[1]) + (o1[2] * o1[2] + o1[3] * o1[3]); }
                s_ += __shfl_xor(s_, 16); s_ += __shfl_xor(s_, 32); ss[ai][m] = s_; }
        if (fq == 0) {
#pragma unroll
            for (int ai = 0; ai < 2; ++ai)
#pragma unroll
                for (int m = 0; m < 4; ++m) red[(wr * 4 + wc) * 128 + ai * 64 + m * 16 + fr] = ss[ai][m]; }
        __syncthreads();
        int tid = threadIdx.x; asm volatile("" : "+v"(tid));
        if (tid < 256) { const int w2 = tid >> 7, rr = tid & 127;
            const float t = (red[(w2 * 4 + 0) * 128 + rr] + red[(w2 * 4 + 1) * 128 + rr]) + (red[(w2 * 4 + 2) * 128 + rr] + red[(w2 * 4 + 3) * 128 + rr]);
            __hip_atomic_store(stat + ((size_t)u.pm * 4 + u.pn) * 256 + tid, t, __ATOMIC_RELAXED, __HIP_MEMORY_SCOPE_AGENT); }
        asm volatile("s_waitcnt vmcnt(0)" ::: "memory");
        __syncthreads();
        if (tid == 0) { __hip_atomic_fetch_add(cnt + u.pm, 1u, __ATOMIC_RELAXED, __HIP_MEMORY_SCOPE_AGENT);
            unsigned sp = 0; while (__hip_atomic_load(cnt + u.pm, __ATOMIC_RELAXED, __HIP_MEMORY_SCOPE_AGENT) < 4u) { __builtin_amdgcn_s_sleep(1); if (++sp > (1u << 22)) break; } }
        __syncthreads();
        if (tid < 256) { float t = 0.f;
#pragma unroll
            for (int q = 0; q < 4; ++q) t += __hip_atomic_load(stat + ((size_t)u.pm * 4 + q) * 256 + tid, __ATOMIC_RELAXED, __HIP_MEMORY_SCOPE_AGENT);
            red[1024 + tid] = 1.0f / sqrtf(t * (1.0f / 1024.0f) + 1e-6f); }
        __syncthreads();
#pragma unroll
        for (int bj = 0; bj < 2; ++bj) { f32x4 gm[2], sh[2];
#pragma unroll
            for (int n = 0; n < 2; ++n) { const int c = col0 + bj * HALF + n * 4;
                gm[n] = *(const f32x4*)(n2g + c) * (*(const f32x4*)(mod + r * 6144 + 1024 + c) + 1.0f); sh[n] = *(const f32x4*)(mod + r * 6144 + c); }
#pragma unroll
            for (int ai = 0; ai < 2; ++ai)
#pragma unroll
                for (int m = 0; m < 4; ++m) { const int rl = wr * 64 + fr + ai * HALF + m * 16; const float rstd = red[1024 + wr * 128 + ai * 64 + m * 16 + fr];
                    const size_t p = toff + (size_t)rl * 1024 + col0 + bj * HALF;
                    const f32x4 o0 = o[ai][bj][m][0], o1 = o[ai][bj][m][1];
                    u32x4 wo; wo.x = cvt_pk_bf16(o0[0], o0[1]); wo.y = cvt_pk_bf16(o0[2], o0[3]); wo.z = cvt_pk_bf16(o1[0], o1[1]); wo.w = cvt_pk_bf16(o1[2], o1[3]);
                    *(u32x4*)(out + p) = wo;
                    const f32x4 h0 = o0 * rstd * gm[0] + sh[0], h1 = o1 * rstd * gm[1] + sh[1];
                    u32x4 wh; wh.x = cvt_pk_bf16(h0[0], h0[1]); wh.y = cvt_pk_bf16(h0[2], h0[3]); wh.z = cvt_pk_bf16(h1[0], h1[1]); wh.w = cvt_pk_bf16(h1[2], h1[3]);
                    *(u32x4*)(H + p) = wh; } }
    }
};

struct EpiResidNormA {
    static constexpr bool PERM = true;
    const bf16_t* base; bf16_t* out; const float* gate; bf16_t* AU; const float* n2g; const float* mod; float* stat; unsigned* cnt; PG8_LAS float* red;
    __device__ __forceinline__ void operator()(const f32x4 (&acc)[2][2][4][2], const Unit& u, int wr, int wc, int fr, int fq) const {
        { int t_ = threadIdx.x; asm volatile("" : "+v"(t_)); fr = t_ & 15; fq = (t_ >> 4) & 3; }
        const int col0 = u.pn * BM + wc * 32 + 8 * fq;
        const int r = u.pm >> 3; const size_t toff = (size_t)u.pm * BM * 1024;
        const float* gv = gate + r * 6144 + col0;
        f32x4 g[2][2];
#pragma unroll
        for (int bj = 0; bj < 2; ++bj)
#pragma unroll
            for (int n = 0; n < 2; ++n) g[bj][n] = *(const f32x4*)(gv + bj * HALF + n * 4);
        f32x4 o[2][2][4][2]; float ss[2][4];
#pragma unroll
        for (int ai = 0; ai < 2; ++ai)
#pragma unroll
            for (int m = 0; m < 4; ++m) { f32x4 bf[2][2]; float s_ = 0.f;
#pragma unroll
                for (int bj = 0; bj < 2; ++bj) { const u32x4 w = *(const u32x4*)(base + toff + (size_t)(wr * 64 + fr + ai * HALF + m * 16) * 1024 + col0 + bj * HALF);
                    bf[bj][0] = (f32x4){bf16lo(w.x), bf16hi(w.x), bf16lo(w.y), bf16hi(w.y)}; bf[bj][1] = (f32x4){bf16lo(w.z), bf16hi(w.z), bf16lo(w.w), bf16hi(w.w)}; }
#pragma unroll
                for (int bj = 0; bj < 2; ++bj) {
                    const f32x4 o0 = bf[bj][0] + g[bj][0] * acc[ai][bj][m][0], o1 = bf[bj][1] + g[bj][1] * acc[ai][bj][m][1];
                    o[ai][bj][m][0] = o0; o[ai][bj][m][1] = o1;
                    s_ += (o0[0] * o0[0] + o0[1] * o0[1]) + (o0[2] * o0[2] + o0[3] * o0[3]) + (o1[0] * o1[0] + o1[1] * o1[1]) + (o1[2] * o1[2] + o1[3] * o1[3]); }
                s_ += __shfl_xor(s_, 16); s_ += __shfl_xor(s_, 32); ss[ai][m] = s_; }
        if (fq == 0) {
#pragma unroll
            for (int ai = 0; ai < 2; ++ai)
#pragma unroll
                for (int m = 0; m < 4; ++m) red[(wr * 4 + wc) * 128 + ai * 64 + m * 16 + fr] = ss[ai][m]; }
        __syncthreads();
        int tid = threadIdx.x; asm volatile("" : "+v"(tid));
        if (tid < 256) { const int w2 = tid >> 7, rr = tid & 127;
            const float t = (red[(w2 * 4 + 0) * 128 + rr] + red[(w2 * 4 + 1) * 128 + rr]) + (red[(w2 * 4 + 2) * 128 + rr] + red[(w2 * 4 + 3) * 128 + rr]);
            __hip_atomic_store(stat + ((size_t)u.pm * 4 + u.pn) * 256 + tid, t, __ATOMIC_RELAXED, __HIP_MEMORY_SCOPE_AGENT); }
        asm volatile("s_waitcnt vmcnt(0)" ::: "memory");
        __syncthreads();
        if (tid == 0) { __hip_atomic_fetch_add(cnt + u.pm, 1u, __ATOMIC_RELAXED, __HIP_MEMORY_SCOPE_AGENT);
            unsigned sp = 0; while (__hip_atomic_load(cnt + u.pm, __ATOMIC_RELAXED, __HIP_MEMORY_SCOPE_AGENT) < 4u) { __builtin_amdgcn_s_sleep(1); if (++sp > (1u << 22)) break; } }
        __syncthreads();
        if (tid < 256) { float t = 0.f;
#pragma unroll
            for (int q = 0; q < 4; ++q) t += __hip_atomic_load(stat + ((size_t)u.pm * 4 + q) * 256 + tid, __ATOMIC_RELAXED, __HIP_MEMORY_SCOPE_AGENT);
            red[1024 + tid] = 1.0f / sqrtf(t * (1.0f / 1024.0f) + 1e-6f); }
        __syncthreads();
#pragma unroll
        for (int bj = 0; bj < 2; ++bj) { f32x4 gm[2], sh[2];
#pragma unroll
            for (int n = 0; n < 2; ++n) { const int c = col0 + bj * HALF + n * 4;
                gm[n] = *(const f32x4*)(n2g + c) * (*(const f32x4*)(mod + r * 6144 + 1024 + c) + 1.0f); sh[n] = *(const f32x4*)(mod + r * 6144 + c); }
#pragma unroll
            for (int ai = 0; ai < 2; ++ai)
#pragma unroll
                for (int m = 0; m < 4; ++m) { const int rl = wr * 64 + fr + ai * HALF + m * 16; const float rstd = red[1024 + wr * 128 + ai * 64 + m * 16 + fr];
                    const size_t p = toff + (size_t)rl * 1024 + col0 + bj * HALF;
                    const int grow = u.pm * BM + rl, cc = col0 + bj * HALF;
                    bf16_t* up = AU + ((size_t)((cc >> 4) * 1024 + (grow >> 11) * 128 + ((grow & 2047) >> 4)) * 256 + (grow & 15) * 16 + (cc & 15));
                    const f32x4 o0 = o[ai][bj][m][0], o1 = o[ai][bj][m][1];
                    u32x4 wo; wo.x = cvt_pk_bf16(o0[0], o0[1]); wo.y = cvt_pk_bf16(o0[2], o0[3]); wo.z = cvt_pk_bf16(o1[0], o1[1]); wo.w = cvt_pk_bf16(o1[2], o1[3]);
                    *(u32x4*)(out + p) = wo;
                    const f32x4 h0 = o0 * rstd * gm[0] + sh[0], h1 = o1 * rstd * gm[1] + sh[1];
                    u32x4 wh; wh.x = cvt_pk_bf16(h0[0], h0[1]); wh.y = cvt_pk_bf16(h0[2], h0[3]); wh.z = cvt_pk_bf16(h1[0], h1[1]); wh.w = cvt_pk_bf16(h1[2], h1[3]);
                    *(u32x4*)up = wh; } }
    }
};

struct EpiSlab {
    static constexpr bool PERM = true;
    bf16_t* slabs;
    __device__ __forceinline__ void operator()(const f32x4 (&acc)[2][2][4][2], const Unit& u, int wr, int wc, int fr, int fq) const {
        { int t_ = threadIdx.x; asm volatile("" : "+v"(t_)); fr = t_ & 15; fq = (t_ >> 4) & 3; }
        const int col0 = u.pn * BM + wc * 32 + 8 * fq;
        bf16_t* so = slabs + (size_t)u.slab * 2048 * 1024 + (size_t)(u.pm - 64) * BM * 1024;
#pragma unroll
        for (int ai = 0; ai < 2; ++ai)
#pragma unroll
            for (int m = 0; m < 4; ++m) { const size_t p = (size_t)(wr * 64 + fr + ai * HALF + m * 16) * 1024 + col0;
#pragma unroll
                for (int bj = 0; bj < 2; ++bj) { const f32x4 v0 = acc[ai][bj][m][0], v1 = acc[ai][bj][m][1];
                    u32x4 w; w.x = cvt_pk_bf16(v0[0], v0[1]); w.y = cvt_pk_bf16(v0[2], v0[3]); w.z = cvt_pk_bf16(v1[0], v1[1]); w.w = cvt_pk_bf16(v1[2], v1[3]);
                    *(u32x4*)(so + p + bj * HALF) = w; } }
    }
};
template <bool FUSEDN>
struct EpiRelu2 {
    static constexpr bool PERM = true;
    bf16_t* O; int ldc; const float* rowss; const float* bias2;
    __device__ __forceinline__ void operator()(const f32x4 (&acc)[2][2][4][2], const Unit& u, int wr, int wc, int fr, int fq) const {
        asm volatile("" : "+v"(fr), "+v"(fq));
        const int row0 = u.pm * BM + wr * 64 + fr, col0 = u.pn * BM + wc * 32 + 8 * fq;
        f32x4 bv[2][2];
        if (FUSEDN) { const float* bp = bias2 + (u.pm >> 3) * 4096 + col0;
#pragma unroll
            for (int bj = 0; bj < 2; ++bj) { bv[bj][0] = *(const f32x4*)(bp + bj * HALF); bv[bj][1] = *(const f32x4*)(bp + bj * HALF + 4); } }
        float rs[2][4];
#pragma unroll
        for (int ai = 0; ai < 2; ++ai)
#pragma unroll
            for (int m = 0; m < 4; ++m) rs[ai][m] = FUSEDN ? rowss[row0 + ai * HALF + m * 16] : 0.f;
#pragma unroll
        for (int ai = 0; ai < 2; ++ai)
#pragma unroll
            for (int m = 0; m < 4; ++m) { const int row = row0 + ai * HALF + m * 16; bf16_t* rowp = O + (size_t)row * ldc + col0;
                float rstd = 1.0f; if (FUSEDN) rstd = 1.0f / sqrtf(rs[ai][m] * (1.0f / 1024.0f) + 1e-6f);
#pragma unroll
                for (int bj = 0; bj < 2; ++bj) { f32x4 v0 = acc[ai][bj][m][0], v1 = acc[ai][bj][m][1];
                    if (FUSEDN) { v0 = v0 * rstd + bv[bj][0]; v1 = v1 * rstd + bv[bj][1]; }
#pragma unroll
                    for (int e = 0; e < 4; ++e) { const float a = fmaxf(v0[e], 0.f), b = fmaxf(v1[e], 0.f); v0[e] = a * a; v1[e] = b * b; }
                    u32x4 w; w.x = cvt_pk_bf16(v0[0], v0[1]); w.y = cvt_pk_bf16(v0[2], v0[3]); w.z = cvt_pk_bf16(v1[0], v1[1]); w.w = cvt_pk_bf16(v1[2], v1[3]);
                    *(u32x4*)(rowp + bj * HALF) = w; } }
    }
};

struct EpiGlu {
    static constexpr bool PERM = true;
    const bf16_t* x; bf16_t* xo; bf16_t* xo2; const float* gate;
    bf16_t* hb; const float* n2g; const float* sc2; float* rowss;
    __device__ __forceinline__ void operator()(const f32x4 (&acc)[2][2][4][2], const Unit& u, int wr, int wc, int fr, int fq) const {
        asm volatile("" : "+v"(fr), "+v"(fq));
        const int r = u.pm >> 3; const int col0 = u.pn * HALF + wc * 32 + 8 * fq; const float* gv = gate + r * 6144 + col0;
        const f32x4 g0 = *(const f32x4*)gv, g1 = *(const f32x4*)(gv + 4);
        const f32x4 gm0 = *(const f32x4*)(n2g + col0) * (*(const f32x4*)(sc2 + r * 6144 + col0) + 1.0f), gm1 = *(const f32x4*)(n2g + col0 + 4) * (*(const f32x4*)(sc2 + r * 6144 + col0 + 4) + 1.0f);
        u32x4 xw[2][4];
#pragma unroll
        for (int ai = 0; ai < 2; ++ai)
#pragma unroll
            for (int m = 0; m < 4; ++m) xw[ai][m] = *(const u32x4*)(x + (size_t)(u.pm * BM + wr * 64 + fr + ai * HALF + m * 16) * 1024 + col0);
#pragma unroll
        for (int ai = 0; ai < 2; ++ai)
#pragma unroll
            for (int m = 0; m < 4; ++m) { const int row = u.pm * BM + wr * 64 + fr + ai * HALF + m * 16; bf16_t* p = (u.pm < 48 ? xo : xo2) + (size_t)row * 1024 + col0;
                const u32x4 w = xw[ai][m];
                f32x4 b0 = (f32x4){bf16lo(w.x), bf16hi(w.x), bf16lo(w.y), bf16hi(w.y)}, b1 = (f32x4){bf16lo(w.z), bf16hi(w.z), bf16lo(w.w), bf16hi(w.w)};
#pragma unroll
                for (int e = 0; e < 4; ++e) {
                    b0[e] += g0[e] * acc[ai][0][m][0][e] * (1.0f / (1.0f + __builtin_amdgcn_exp2f(-1.4426950408889634f * acc[ai][1][m][0][e])));
                    b1[e] += g1[e] * acc[ai][0][m][1][e] * (1.0f / (1.0f + __builtin_amdgcn_exp2f(-1.4426950408889634f * acc[ai][1][m][1][e]))); }
                u32x4 wo; wo.x = cvt_pk_bf16(b0[0], b0[1]); wo.y = cvt_pk_bf16(b0[2], b0[3]); wo.z = cvt_pk_bf16(b1[0], b1[1]); wo.w = cvt_pk_bf16(b1[2], b1[3]);
                *(u32x4*)p = wo;
                const f32x4 r0 = (f32x4){bf16lo(wo.x), bf16hi(wo.x), bf16lo(wo.y), bf16hi(wo.y)}, r1 = (f32x4){bf16lo(wo.z), bf16hi(wo.z), bf16lo(wo.w), bf16hi(wo.w)};
                float ss = (r0[0] * r0[0] + r0[1] * r0[1]) + (r0[2] * r0[2] + r0[3] * r0[3]) + (r1[0] * r1[0] + r1[1] * r1[1]) + (r1[2] * r1[2] + r1[3] * r1[3]);
                ss += __shfl_xor(ss, 16); ss += __shfl_xor(ss, 32);
                if (fq == 0) atomicAdd(rowss + row, ss);
                const f32x4 h0 = r0 * gm0, h1 = r1 * gm1;
                u32x4 wh; wh.x = cvt_pk_bf16(h0[0], h0[1]); wh.y = cvt_pk_bf16(h0[2], h0[3]); wh.z = cvt_pk_bf16(h1[0], h1[1]); wh.w = cvt_pk_bf16(h1[2], h1[3]);
                *(u32x4*)(hb + (size_t)row * 1024 + col0) = wh; }
    }
};

struct EpiSsm1 {
    static constexpr bool PERM = true;
    bf16_t* S;
    __device__ __forceinline__ void operator()(const f32x4 (&acc)[2][2][4][2], const Unit& u, int wr, int wc, int fr, int fq) const {
        asm volatile("" : "+v"(fr), "+v"(fq));
        const int g = u.pn, i = u.pm - 5 * g; const int col0 = wc * 32 + 8 * fq;
#pragma unroll
        for (int ai = 0; ai < 2; ++ai)
#pragma unroll
            for (int m = 0; m < 4; ++m) { const int row = i * BM + wr * 64 + fr + ai * HALF + m * 16;
                if (row < 1152) { bf16_t* p = S + ((size_t)g * 1152 + row) * 256 + col0;
#pragma unroll
                    for (int bj = 0; bj < 2; ++bj) { const f32x4 v0 = acc[ai][bj][m][0], v1 = acc[ai][bj][m][1];
                        u32x4 w; w.x = cvt_pk_bf16(v0[0], v0[1]); w.y = cvt_pk_bf16(v0[2], v0[3]); w.z = cvt_pk_bf16(v1[0], v1[1]); w.w = cvt_pk_bf16(v1[2], v1[3]);
                        *(u32x4*)(p + bj * HALF) = w; } } }
    }
};

__device__ __forceinline__ float gelu_tanh(float v) {
    const float u = 0.7978845608028654f * (v + 0.044715f * v * v * v);
    const float e = __builtin_amdgcn_exp2f(2.0f * 1.4426950408889634f * u);
    const float th = 1.0f - 2.0f / (1.0f + e);
    return 0.5f * v * (1.0f + th);
}
struct EpiSsm2 {
    static constexpr bool PERM = true;
    bf16_t* Z; const bf16_t* A2; const float* dskip;
    __device__ __forceinline__ void operator()(const f32x4 (&acc)[2][2][4][2], const Unit& u, int wr, int wc, int fr, int fq) const {
        asm volatile("" : "+v"(fr), "+v"(fq));
        const int g = u.pn, i = u.pm - 5 * g; const int hh = 8 * (fq & 1); const int zcol = g * 16 + hh;
#pragma unroll
        for (int ai = 0; ai < 2; ++ai)
#pragma unroll
            for (int m = 0; m < 4; ++m) { const int ridx = i * BM + wr * 64 + fr + ai * HALF + m * 16; const int b = ridx >> 7, c = ridx & 127;
#pragma unroll
                for (int bj = 0; bj < 2; ++bj) { const int t = 8 * bj + 2 * wc + (fq >> 1);
                    const f32x4 v0 = acc[ai][bj][m][0], v1 = acc[ai][bj][m][1];
                    float z[8];
#pragma unroll
                    for (int e = 0; e < 4; ++e) { z[e] = gelu_tanh(v0[e]); z[4 + e] = gelu_tanh(v1[e]); }
                    u32x4 w; w.x = cvt_pk_bf16(z[0], z[1]); w.y = cvt_pk_bf16(z[2], z[3]); w.z = cvt_pk_bf16(z[4], z[5]); w.w = cvt_pk_bf16(z[6], z[7]);
                    *(u32x4*)(Z + (size_t)(b * 2048 + c * 16 + t) * 1024 + zcol) = w;
                    } }
    }
};

template <class Epi, class Sched, bool ALIGN_EPI, int AJT = 0, int PRE = 0>
__device__ __forceinline__ void gemm_phase(PG8_LAS unsigned char* lds, const Gemm g, const Sched& S, const Epi& E) {
    int tid = threadIdx.x; asm volatile("" : "+v"(tid));
    const int wid = __builtin_amdgcn_readfirstlane(tid >> 6), lane = tid & 63, wr = wid >> 2, wc = wid & 3, fr = lane & 15, fq = lane >> 4;
    unsigned voffA[2], voffB[2];
#pragma unroll
    for (int i = 0; i < 2; ++i) { int R, C; stage_rc(tid * 16 + i * 8192, R, C); const int Rb = Epi::PERM ? ((R & ~31) + perm32(R & 31)) : R;
        voffA[i] = (unsigned)(R * g.lda + C) * 2u; voffB[i] = (unsigned)(Rb * g.ldb + C) * 2u; }
    const size_t kstep = (size_t)(BK * 2);
    const size_t hstepA = (size_t)HALF * g.lda * 2, hstepB = (size_t)HALF * g.ldb * 2;
    const size_t tstepA = 2 * hstepA, tstepB = 2 * hstepB;
    const unsigned ldsw = (unsigned)wid * 1024u;
    const int aoff = lds_byte(wr * 64 + fr, fq * 8), boff = lds_byte(wc * 32 + fr, fq * 8);
#define PG8_SA(b, h) (((b) * 2 + (h)) * HTB)
#define PG8_SB(b, h) ((4 + (b) * 2 + (h)) * HTB)
#define PG8_STAGE(bufoff, gbase, voff) do { _Pragma("unroll") for (int _i = 0; _i < 2; ++_i) \
        __builtin_amdgcn_global_load_lds((const unsigned*)((const char*)(gbase) + (voff)[_i]), (PG8_LAS unsigned*)(lds + (bufoff) + ldsw + _i * 8192), 16, 0, 0); } while (0)
#define PG8_LDA(dst, b, h) do { _Pragma("unroll") for (int m = 0; m < 4; ++m) _Pragma("unroll") for (int k = 0; k < 2; ++k) dst[m][k] = *(const PG8_LAS bf16x8*)(lds + PG8_SA(b, h) + aoff + m * 2048 + k * 1024); } while (0)
#define PG8_LDB(dst, b, h) do { _Pragma("unroll") for (int n = 0; n < 2; ++n) _Pragma("unroll") for (int k = 0; k < 2; ++k) dst[n][k] = *(const PG8_LAS bf16x8*)(lds + PG8_SB(b, h) + boff + n * 2048 + k * 1024); } while (0)
#define PG8_MMA(ai, bj, At, Bt) do { __builtin_amdgcn_s_setprio(1); _Pragma("unroll") for (int m = 0; m < 4; ++m) _Pragma("unroll") for (int n = 0; n < 2; ++n) _Pragma("unroll") for (int k = 0; k < 2; ++k) \
        acc[ai][bj][m][n] = __builtin_amdgcn_mfma_f32_16x16x32_bf16(Bt[n][k], At[m][k], acc[ai][bj][m][n], 0, 0, 0); __builtin_amdgcn_s_setprio(0); } while (0)
#define PG8_WAIT_V(n) asm volatile("s_waitcnt vmcnt(" #n ")" ::: "memory")
#define PG8_WAIT_L(n) asm volatile("s_waitcnt lgkmcnt(" #n ")" ::: "memory")
#define PG8_BAR __builtin_amdgcn_s_barrier()
#define PG8_SCHED __builtin_amdgcn_sched_barrier(0)
    Unit cur, nxt; int ui = 0;
    if (!S.next(0, cur)) return;
    f32x4 acc[2][2][4][2];
#pragma unroll
    for (int a = 0; a < 2; ++a)
#pragma unroll
        for (int b = 0; b < 2; ++b)
#pragma unroll
            for (int m = 0; m < 4; ++m)
#pragma unroll
                for (int n = 0; n < 2; ++n) acc[a][b][m][n] = (f32x4){0.f, 0.f, 0.f, 0.f};
    bf16x8 At[4][2], B0[2][2], B1[2][2];
    const char* cA = (const char*)g.A + (size_t)S.atile(cur) * tstepA + (size_t)cur.kt0 * kstep; const char* cB = (const char*)g.Bt + (size_t)cur.pn * tstepB + (size_t)cur.kt0 * kstep;
    if constexpr (PRE != 2) { PG8_STAGE(PG8_SB(0, 0), cB, voffB); PG8_STAGE(PG8_SB(0, 1), cB + hstepB, voffB); PG8_STAGE(PG8_SA(0, 0), cA, voffA); PG8_STAGE(PG8_SA(0, 1), cA + hstepA, voffA); }
    if constexpr (PRE == 1) { PG8_STAGE(PG8_SB(1, 0), cB + kstep, voffB); PG8_STAGE(PG8_SA(1, 0), cA + kstep, voffA); PG8_STAGE(PG8_SB(1, 1), cB + hstepB + kstep, voffB); return; }
    if (wr == 1) PG8_BAR;
    PG8_WAIT_V(2); PG8_BAR;
    if constexpr (PRE != 2) { PG8_STAGE(PG8_SB(1, 0), cB + kstep, voffB); PG8_STAGE(PG8_SA(1, 0), cA + kstep, voffA); PG8_STAGE(PG8_SB(1, 1), cB + hstepB + kstep, voffB); }
    PG8_WAIT_V(6); PG8_BAR;
    for (;;) {
        const bool has_next = S.next(ui + 1, nxt);
        const char* nA = has_next ? (const char*)g.A + (size_t)S.atile(nxt) * tstepA + (size_t)nxt.kt0 * kstep : cA; const char* nB = has_next ? (const char*)g.Bt + (size_t)nxt.pn * tstepB + (size_t)nxt.kt0 * kstep : cB;
        const int nt = cur.nt;
        for (int t = 0; t < nt; t += 2) {
            const bool last = (t == nt - 2);
            const char* a1 = cA + (size_t)(t + 1) * kstep;
            const char* a2 = last ? nA : cA + (size_t)(t + 2) * kstep; const char* b2 = last ? nB : cB + (size_t)(t + 2) * kstep;
            const char* a3 = a2 + kstep; const char* b3 = b2 + kstep;
            if constexpr (AJT > 0) { if (t + 1 >= AJT) a1 += g.ajump; if (!last) { if (t + 2 >= AJT) a2 += g.ajump; a3 = a2 + kstep; if (t + 2 < AJT && t + 3 >= AJT) a3 += g.ajump; } }
            PG8_LDB(B0, 0, 0); PG8_LDB(B1, 0, 1); PG8_SCHED; PG8_LDA(At, 0, 0); PG8_STAGE(PG8_SA(1, 1), a1 + hstepA, voffA);
            PG8_WAIT_V(8); PG8_WAIT_L(0); PG8_BAR; PG8_MMA(0, 0, At, B0); PG8_MMA(0, 1, At, B1); PG8_BAR; PG8_SCHED;
            PG8_LDA(At, 0, 1); PG8_STAGE(PG8_SB(0, 0), b2, voffB); PG8_STAGE(PG8_SB(0, 1), b2 + hstepB, voffB); PG8_STAGE(PG8_SA(0, 0), a2, voffA);
            PG8_WAIT_V(8); PG8_WAIT_L(0); PG8_BAR; PG8_MMA(1, 0, At, B0); PG8_MMA(1, 1, At, B1); PG8_BAR; PG8_SCHED;
            PG8_LDB(B0, 1, 0); PG8_LDB(B1, 1, 1); PG8_SCHED; PG8_LDA(At, 1, 0); PG8_STAGE(PG8_SA(0, 1), a2 + hstepA, voffA);
            PG8_WAIT_V(8); PG8_WAIT_L(0); PG8_BAR; PG8_MMA(0, 0, At, B0); PG8_MMA(0, 1, At, B1); PG8_BAR; PG8_SCHED;
            PG8_LDA(At, 1, 1); PG8_STAGE(PG8_SB(1, 0), b3, voffB); PG8_STAGE(PG8_SB(1, 1), b3 + hstepB, voffB); PG8_STAGE(PG8_SA(1, 0), a3, voffA);
            PG8_WAIT_V(8); PG8_WAIT_L(0); PG8_BAR; PG8_MMA(1, 0, At, B0); PG8_MMA(1, 1, At, B1); PG8_BAR; PG8_SCHED;
        }
        if constexpr (ALIGN_EPI) { if (wr == 0) PG8_BAR; }
        E(acc, cur, wr, wc, fr, fq);
        if (!has_next) break;
#pragma unroll
        for (int a = 0; a < 2; ++a)
#pragma unroll
            for (int b = 0; b < 2; ++b)
#pragma unroll
                for (int m = 0; m < 4; ++m)
#pragma unroll
                    for (int n = 0; n < 2; ++n) acc[a][b][m][n] = (f32x4){0.f, 0.f, 0.f, 0.f};
        cur = nxt; cA = nA; cB = nB; ++ui;
        if constexpr (ALIGN_EPI) { if (wr == 1) PG8_BAR; }
    }
    PG8_WAIT_V(0);
    if constexpr (!ALIGN_EPI) { if (wr == 0) PG8_BAR; }
    PG8_BAR;
#undef PG8_SA
#undef PG8_SB
#undef PG8_STAGE
#undef PG8_LDA
#undef PG8_LDB
#undef PG8_MMA
#undef PG8_WAIT_V
#undef PG8_WAIT_L
#undef PG8_BAR
#undef PG8_SCHED
}
}
namespace att {
typedef __attribute__((address_space(3))) unsigned char lds_u8;
typedef __attribute__((address_space(3))) const unsigned char* lds_cptr;
using bf16x8 = __attribute__((ext_vector_type(8))) short;
using s16x4 = __attribute__((ext_vector_type(4))) short;
using f32x16 = __attribute__((ext_vector_type(16))) float;
using f32x4 = __attribute__((ext_vector_type(4))) float;
using u32x4 = __attribute__((ext_vector_type(4))) unsigned;
typedef unsigned short bf16_t;
#define ATT_LF __attribute__((address_space(3))) float
constexpr int PITCH = 3072;
constexpr int OPITCH = 1024;
constexpr int STAGE_B = 32768;
constexpr int L_OST = 98304;
constexpr int L_WSF = 132096;
constexpr int L_BIAS = 136192;
constexpr int XSTR = 132;
constexpr float LOG2E = 1.4426950408889634f;

__device__ __forceinline__ int crow(int r, int hi) { return (r & 3) + 8 * (r >> 2) + 4 * hi; }
#define ATT_SBAR() __builtin_amdgcn_sched_barrier(0)
__device__ __forceinline__ void glds16(const void* gsrc, unsigned lds_dst) { unsigned keep;
    asm volatile("s_mov_b32 %0, m0\n\ts_mov_b32 m0, %2\n\ts_nop 0\n\tglobal_load_lds_dwordx4 %1, off\n\ts_mov_b32 m0, %0" : "=&s"(keep) : "v"(gsrc), "s"(lds_dst) : "memory"); }
typedef float f32x2_t __attribute__((ext_vector_type(2))); typedef __bf16 bf16x2_t __attribute__((ext_vector_type(2)));
__device__ __forceinline__ unsigned cvtpk(float lo, float hi) { f32x2_t v = {lo, hi}; bf16x2_t b = __builtin_convertvector(v, bf16x2_t); return __builtin_bit_cast(unsigned, b); }

typedef short v4i16_t __attribute__((ext_vector_type(4)));
__device__ __forceinline__ s16x4 vtr(lds_cptr p) { return __builtin_bit_cast(s16x4, __builtin_amdgcn_ds_read_tr16_b64_v4i16((__attribute__((address_space(3))) v4i16_t*)p)); }
__device__ __forceinline__ void qkt(f32x16& p0, f32x16& p1, lds_cptr Kslot, const bf16x8* qr, int r32, int hi) {
    lds_cptr kb = Kslot + r32 * 128; const int sw = (r32 >> 1) & 7;
    const f32x16 z = f32x16{};
#pragma unroll
    for (int d0 = 0; d0 < 4; ++d0) {
        const int off = ((2 * d0 + hi) ^ sw) << 4;
        const bf16x8 b0 = *(const __attribute__((address_space(3))) bf16x8*)(kb + off);
        const bf16x8 b1 = *(const __attribute__((address_space(3))) bf16x8*)(kb + off + 4096);
        if (d0 == 0) { p0 = __builtin_amdgcn_mfma_f32_32x32x16_bf16(b0, qr[0], z, 0, 0, 0); p1 = __builtin_amdgcn_mfma_f32_32x32x16_bf16(b1, qr[0], z, 0, 0, 0); }
        else { p0 = __builtin_amdgcn_mfma_f32_32x32x16_bf16(b0, qr[d0], p0, 0, 0, 0); p1 = __builtin_amdgcn_mfma_f32_32x32x16_bf16(b1, qr[d0], p1, 0, 0, 0); } }
}
#define ATT_TRG(lo_, hi_, vb_, off_) do { _Pragma("unroll") for (int ks = 0; ks < 4; ++ks) { \
        asm volatile("ds_read_b64_tr_b16 %0,%1 offset:%c2" : "=&v"(lo_[ks]) : "v"(vb_), "i"((off_) + ks * 2048) : "memory"); \
        asm volatile("ds_read_b64_tr_b16 %0,%1 offset:%c2" : "=&v"(hi_[ks]) : "v"(vb_), "i"((off_) + ks * 2048 + 1024) : "memory"); } } while (0)
#define ATT_PK(lo_, hi_, k) (bf16x8){lo_[k][0], lo_[k][1], lo_[k][2], lo_[k][3], hi_[k][0], hi_[k][1], hi_[k][2], hi_[k][3]}
#define ATT_MM(acc_, lo_, hi_) do { __builtin_amdgcn_s_setprio(1); \
        acc_ = __builtin_amdgcn_mfma_f32_32x32x16_bf16(pa0, ATT_PK(lo_, hi_, 0), acc_, 0, 0, 0); acc_ = __builtin_amdgcn_mfma_f32_32x32x16_bf16(pa1, ATT_PK(lo_, hi_, 1), acc_, 0, 0, 0); \
        acc_ = __builtin_amdgcn_mfma_f32_32x32x16_bf16(pa2, ATT_PK(lo_, hi_, 2), acc_, 0, 0, 0); acc_ = __builtin_amdgcn_mfma_f32_32x32x16_bf16(pa3, ATT_PK(lo_, hi_, 3), acc_, 0, 0, 0); \
        __builtin_amdgcn_s_setprio(0); } while (0)
template <int NS>
__device__ __forceinline__ void pv(f32x16* o, int vbA, int vbB, bf16x8 pa0, bf16x8 pa1, bf16x8 pa2, bf16x8 pa3) {
    s16x4 loA[4], hiA[4], loB[4], hiB[4];
    asm volatile("s_waitcnt lgkmcnt(0)" ::: "memory");
    ATT_TRG(loA, hiA, vbA, 0);
    ATT_TRG(loB, hiB, vbB, 0);
    asm volatile("s_waitcnt lgkmcnt(8)" ::: "memory"); ATT_SBAR();
    ATT_MM(o[0], loA, hiA);
    if (NS == 2) {
        ATT_SBAR(); ATT_TRG(loA, hiA, vbA, 8192);
        asm volatile("s_waitcnt lgkmcnt(8)" ::: "memory"); ATT_SBAR();
        ATT_MM(o[1], loB, hiB);
        ATT_SBAR(); ATT_TRG(loB, hiB, vbB, 8192);
        asm volatile("s_waitcnt lgkmcnt(8)" ::: "memory"); ATT_SBAR();
        ATT_MM(o[2], loA, hiA);
        asm volatile("s_waitcnt lgkmcnt(0)" ::: "memory"); ATT_SBAR();
        ATT_MM(o[3], loB, hiB);
    } else {
        asm volatile("s_waitcnt lgkmcnt(0)" ::: "memory"); ATT_SBAR();
        ATT_MM(o[1], loB, hiB);
    }
}
__device__ __forceinline__ float rowmax32(const f32x16& p0, const f32x16& p1) {
    float a = p0[0], b = p1[0];
#pragma unroll
    for (int r = 1; r < 16; ++r) { a = __builtin_fmaxf(a, p0[r]); b = __builtin_fmaxf(b, p1[r]); }
    const float m = __builtin_fmaxf(a, b);
    auto rr = __builtin_amdgcn_permlane32_swap(__float_as_uint(m), __float_as_uint(m), false, false);
    return __builtin_fmaxf(__uint_as_float(rr[0]), __uint_as_float(rr[1]));
}
template <int XM> __device__ __forceinline__ float softmax_step(f32x16& p0, f32x16& p1, float& m, float& l) {
    constexpr float THR = 6.0f;
    const float rm = rowmax32(p0, p1);
    float f = 1.0f;
    if (__any(rm > m + THR)) { const float mn = __builtin_fmaxf(m, rm); f = __builtin_amdgcn_exp2f(m - mn); m = mn; l *= f; }
    float s = 0.f;
#pragma unroll
    for (int r = 0; r < 16; ++r) {
        if (XM == 3) { p0[r] = (p0[r] - m) * 0.001f + 0.01f; p1[r] = (p1[r] - m) * 0.001f + 0.01f; }
        else { p0[r] = __builtin_amdgcn_exp2f(p0[r] - m); p1[r] = __builtin_amdgcn_exp2f(p1[r] - m); }
        s += p0[r] + p1[r]; }
    l += s;
    return f;
}

struct UnitDesc {
    int qrow0;
    int qcol, kcol, vcol;
    int latrow, t0, nlat;
    int ctxrow;
    int ocol;
    int r0, head;
};

template <bool DIFF, bool NAM, int XM = 0>
__device__ __forceinline__ void attn_unit(const UnitDesc& U, const bf16_t* __restrict__ proj, bf16_t* __restrict__ out, lds_u8* shm3,
                                          const float* __restrict__ rpb, const float* __restrict__ subg, float lam, float outscale) {
    if (XM == 7) return;
    int tid = threadIdx.x; asm volatile("" : "+v"(tid));
    const int lane = tid & 63, r32 = lane & 31, hi = lane >> 5; const int wid = __builtin_amdgcn_readfirstlane(tid >> 6);
    const unsigned lds0 = (unsigned)(uintptr_t)shm3;
    ATT_LF* wsf = (ATT_LF*)(shm3 + L_WSF + wid * 512);
    constexpr int SUBS = DIFF ? 1 : 2;
    const int ntile = U.nlat + 4;
    const int nstage = (XM == 6) ? 1 : (ntile + SUBS - 1) / SUBS;
    const int qblk = DIFF ? (wid >> 1) : wid, sh = DIFF ? (wid & 1) : 0;
    if (NAM) { ATT_LF* bl = (ATT_LF*)(shm3 + L_BIAS);
        for (int i = tid; i < 15 * 31; i += 512) { const int ro = i / 31, j = i - ro * 31; bl[ro * 128 + 48 + j] = rpb[(U.head * 15 + ro) * 31 + j] * LOG2E; } }
    const bf16_t* ksrc0 = proj + (size_t)(8 * wid + (lane >> 3)) * PITCH + U.kcol + (((lane & 7) ^ ((4 * wid + (lane >> 4)) & 7)) << 3);
    const bf16_t* vsrc0 = proj + (size_t)(8 * wid + (lane >> 3)) * PITCH + U.vcol + (((lane & 7) ^ (((lane >> 4) & 1) << 2)) << 3);
    const unsigned dstw = lds0 + wid * 1024;
#define ATT_TILE_ROW(i) (((i) < U.nlat) ? (U.latrow + 64 * (U.t0 + (i))) : (U.ctxrow + 64 * ((i) - U.nlat)))
#define ATT_DMA_STAGE(s_) do { if (XM == 5 || XM >= 9) break; const int s__ = (s_); const unsigned d_ = (unsigned)__builtin_amdgcn_readfirstlane((int)(dstw + (s__ & 3) * STAGE_B)); \
        if (DIFF) { const size_t ro_ = (size_t)ATT_TILE_ROW(s__) * PITCH; glds16(ksrc0 + ro_, d_); glds16(ksrc0 + ro_ + 64, d_ + 8192); glds16(vsrc0 + ro_, d_ + 16384); glds16(vsrc0 + ro_ + 64, d_ + 24576); } \
        else { const size_t ro_ = (size_t)ATT_TILE_ROW(2 * s__) * PITCH; glds16(ksrc0 + ro_, d_); glds16(vsrc0 + ro_, d_ + 16384); \
               { const int t1_ = (2 * s__ + 1 < ntile) ? 2 * s__ + 1 : 2 * s__; const size_t r1_ = (size_t)ATT_TILE_ROW(t1_) * PITCH; glds16(ksrc0 + r1_, d_ + 8192); glds16(vsrc0 + r1_, d_ + 24576); } } } while (0)
    const bf16_t* Qw = proj + (size_t)(U.qrow0 + qblk * 32 + r32) * PITCH + U.qcol + sh * 64 + hi * 8;
    bf16x8 qr[4];
#pragma unroll
    for (int d0 = 0; d0 < 4; ++d0) qr[d0] = *(const bf16x8*)(Qw + d0 * 16);
    float m1 = -1e30f, l1 = 0.f;
    constexpr int NO = DIFF ? 4 : 2;
    f32x16 o[NO];
#pragma unroll
    for (int i = 0; i < NO; ++i) o[i] = f32x16{};
    const int dsw_ = ((lane & 15) >> 3) & 1;
    const int vbl = (int)lds0 + 16384 + (4 * hi + ((lane & 15) >> 2)) * 128 + ((lane >> 4) & 1) * 32 + (lane & 3) * 8;
    const int vblA = vbl + dsw_ * 64, vblB = vbl + (1 - dsw_) * 64;
    const int gr = U.r0 + (wid >> 1); const int rs = gr < 4 ? 0 : (gr > 28 ? 24 : gr - 4);
    const int qc = 32 * (wid & 1) + r32; const int cs = qc < 8 ? 0 : (qc > 56 ? 48 : qc - 8);
#define ATT_USE(j) ((j) < ntile && (!NAM || (j) >= U.nlat || ((U.t0 + (j)) >= rs && (U.t0 + (j)) <= rs + 7)))
#define ATT_KSLOT(j) ((lds_cptr)(shm3 + (((j) / SUBS) & 3) * STAGE_B + (DIFF ? sh * 8192 : ((j) & 1) * 8192)))
#define ATT_WAIT_BAR(N) do { if (XM < 9) asm volatile("s_waitcnt vmcnt(" #N ") lgkmcnt(0)\n\ts_barrier" ::: "memory"); } while (0)
    ATT_DMA_STAGE(0);
    if (nstage > 1) ATT_DMA_STAGE(1);
    if (nstage > 2) ATT_DMA_STAGE(2);
    if (nstage > 2) ATT_WAIT_BAR(8); else if (nstage > 1) ATT_WAIT_BAR(4); else ATT_WAIT_BAR(0);
    f32x16 sc0 = f32x16{}, sc1 = f32x16{}, sn0 = f32x16{}, sn1 = f32x16{};
    if (ATT_USE(0)) qkt(sc0, sc1, ATT_KSLOT(0), qr, r32, hi);
    for (int s = 0; s < nstage; ++s) {
#pragma unroll
        for (int sub = 0; sub < SUBS; ++sub) {
            const int j = s * SUBS + sub;
            if (sub == SUBS - 1 && s + 1 < nstage) {
                if (s + 2 < nstage) ATT_WAIT_BAR(4); else ATT_WAIT_BAR(0);
                if (s + 3 < nstage) ATT_DMA_STAGE(s + 3);
            }
            const bool un = ATT_USE(j + 1), uc = ATT_USE(j);
            if (un) { if (XM == 4 || XM == 12) { sn0 = f32x16{}; sn1 = f32x16{}; asm volatile("" : "+v"(sn0), "+v"(sn1)); } else qkt(sn0, sn1, ATT_KSLOT(j + 1), qr, r32, hi); }
            if (uc) {
                if (NAM && j < U.nlat) {
                    const int kr = U.t0 + j;
                    const ATT_LF* brow = (const ATT_LF*)(shm3 + L_BIAS) + (kr - gr + 7) * 128 + 48 + 15 - qc + 4 * hi;
#pragma unroll
                    for (int r = 0; r < 16; ++r) { const int kc = (r & 3) + 8 * (r >> 2); const int kcl = kc + 4 * hi;
                        const float b0 = brow[kc], b1 = brow[kc + 32];
                        sc0[r] = ((unsigned)(kcl - cs) < 16u) ? sc0[r] + b0 : -INFINITY;
                        sc1[r] = ((unsigned)(kcl + 32 - cs) < 16u) ? sc1[r] + b1 : -INFINITY;
                        if ((r & 3) == 3) ATT_SBAR(); }
                }
                if (XM < 10) { const float rm = rowmax32(sc0, sc1);
                  if (__any(rm > m1 + 6.0f)) {
                      const float mn = __builtin_fmaxf(m1, rm); const float f = __builtin_amdgcn_exp2f(m1 - mn); m1 = mn; l1 *= f;
                      if (hi == 0) wsf[r32] = f;
                      asm volatile("s_waitcnt lgkmcnt(0)" ::: "memory");
                      float fr_[16];
#pragma unroll
                      for (int r = 0; r < 16; ++r) fr_[r] = wsf[crow(r, hi)];
#pragma unroll
                      for (int d = 0; d < NO; ++d)
#pragma unroll
                          for (int r = 0; r < 16; ++r) o[d][r] *= fr_[r];
                      asm volatile("s_waitcnt lgkmcnt(0)" ::: "memory");
                  } }
                { const int vbo = (s & 3) * STAGE_B + (DIFF ? 0 : sub * 8192);
                  lds_cptr vpA = (lds_cptr)(uintptr_t)(unsigned)(vblA + vbo), vpB = (lds_cptr)(uintptr_t)(unsigned)(vblB + vbo);
                  float ssum = 0.f;
                  bf16x8 vfc[NO], vfn[NO]; bf16x8 pac, pan;
#define ATT_VLD(dst, ks_) do { if (XM == 11 || XM == 13) { _Pragma("unroll") for (int d = 0; d < NO; ++d) { dst[d] = (bf16x8){1, 2, 3, 4, 5, 6, 7, 8}; asm volatile("" : "+v"(dst[d])); } break; } _Pragma("unroll") for (int d = 0; d < NO; ++d) { lds_cptr vp_ = ((d & 1) ? vpB : vpA) + (d >> 1) * 8192 + (ks_) * 2048; \
                      const s16x4 lo_ = vtr(vp_), hi_ = vtr(vp_ + 1024); dst[d] = (bf16x8){lo_[0], lo_[1], lo_[2], lo_[3], hi_[0], hi_[1], hi_[2], hi_[3]}; } } while (0)
#define ATT_EXP8(dst, ks_) do { float e_[8]; _Pragma("unroll") for (int i = 0; i < 8; ++i) { const float x_ = ((ks_) < 2) ? sc0[((ks_) & 1) * 8 + i] : sc1[((ks_) & 1) * 8 + i]; e_[i] = (XM >= 10) ? x_ : __builtin_amdgcn_exp2f(x_ - m1); ssum += e_[i]; } \
                      const u32x4 pw_ = (u32x4){cvtpk(e_[0], e_[1]), cvtpk(e_[2], e_[3]), cvtpk(e_[4], e_[5]), cvtpk(e_[6], e_[7])}; dst = __builtin_bit_cast(bf16x8, pw_); } while (0)
                  ATT_VLD(vfc, 0); ATT_EXP8(pac, 0);
#pragma unroll
                  for (int ks = 0; ks < 4; ++ks) {
                      if (ks < 3) { ATT_VLD(vfn, ks + 1); ATT_EXP8(pan, ks + 1); }
#pragma unroll
                      for (int d = 0; d < NO; ++d) { if (XM == 13) { asm volatile("" :: "v"(pac), "v"(vfc[d])); } else o[d] = __builtin_amdgcn_mfma_f32_32x32x16_bf16(pac, vfc[d], o[d], 0, 0, 0); }
                      if (ks < 3) {
#pragma unroll
                          for (int d = 0; d < NO; ++d) { vfc[d] = vfn[d];
                              __builtin_amdgcn_sched_group_barrier(0x008, 1, 0); __builtin_amdgcn_sched_group_barrier(0x100, 2, 0); __builtin_amdgcn_sched_group_barrier(0x002, DIFF ? 7 : 14, 0); }
                          pac = pan; }
                  }
#undef ATT_VLD
#undef ATT_EXP8
                  l1 += ssum; }
            }
            sc0 = sn0; sc1 = sn1;
        }
    }
    { auto rr = __builtin_amdgcn_permlane32_swap(__float_as_uint(l1), __float_as_uint(l1), false, false); l1 = __uint_as_float(rr[0]) + __uint_as_float(rr[1]); }
    if (hi == 0) wsf[32 + r32] = (DIFF && sh == 1) ? lam / l1 : 1.0f / l1;
    asm volatile("s_waitcnt lgkmcnt(0)" ::: "memory");
    float rli[16];
#pragma unroll
    for (int r = 0; r < 16; ++r) rli[r] = wsf[32 + crow(r, hi)];
    if (!DIFF) {
        bf16_t* Ow = out + (size_t)(U.qrow0 + wid * 32) * OPITCH + U.ocol;
        asm volatile("s_waitcnt lgkmcnt(0)\n\ts_barrier" ::: "memory");
        __attribute__((address_space(3))) bf16_t* stg = (__attribute__((address_space(3))) bf16_t*)(shm3 + wid * 4096);
#pragma unroll
        for (int r = 0; r < 16; ++r) { const int orow = crow(r, hi);
#pragma unroll
            for (int d0 = 0; d0 < 2; ++d0) stg[orow * 64 + d0 * 32 + r32] = (bf16_t)(cvtpk(o[d0][r] * rli[r], 0.f) & 0xffffu); }
        asm volatile("s_waitcnt lgkmcnt(0)" ::: "memory");
#pragma unroll
        for (int i = 0; i < 4; ++i) { const int row = i * 8 + (lane >> 3), ch = lane & 7; const u32x4 v = *(const __attribute__((address_space(3))) u32x4*)(stg + row * 64 + ch * 8); *(u32x4*)(Ow + (size_t)row * OPITCH + ch * 8) = v; }
        asm volatile("s_waitcnt lgkmcnt(0)\n\ts_barrier" ::: "memory");
    } else {
        asm volatile("s_waitcnt lgkmcnt(0)\n\ts_barrier" ::: "memory");
        ATT_LF* X = (ATT_LF*)shm3 + qblk * 32 * XSTR;
        if (sh == 1) {
#pragma unroll
            for (int r = 0; r < 16; ++r)
#pragma unroll
                for (int d0 = 0; d0 < 4; ++d0) X[crow(r, hi) * XSTR + d0 * 32 + r32] = o[d0][r] * rli[r];
        }
        asm volatile("s_waitcnt lgkmcnt(0)\n\ts_barrier" ::: "memory");
        if (sh == 0) {
#pragma unroll
            for (int r = 0; r < 16; ++r)
#pragma unroll
                for (int d0 = 0; d0 < 4; ++d0) { ATT_LF* p = X + crow(r, hi) * XSTR + d0 * 32 + r32; *p = o[d0][r] * rli[r] - *p; }
            asm volatile("s_waitcnt lgkmcnt(0)" ::: "memory");
            const int rowl = lane >> 1, hf = lane & 1;
            float v[64]; float ss = 0.f;
#pragma unroll
            for (int e4 = 0; e4 < 16; ++e4) { const f32x4 x = *(const __attribute__((address_space(3))) f32x4*)(X + rowl * XSTR + hf * 64 + e4 * 4);
                v[e4 * 4 + 0] = x[0]; v[e4 * 4 + 1] = x[1]; v[e4 * 4 + 2] = x[2]; v[e4 * 4 + 3] = x[3]; ss += x[0] * x[0] + x[1] * x[1] + x[2] * x[2] + x[3] * x[3]; }
            ss += __shfl_xor(ss, 1);
            const float rstd = outscale / sqrtf(ss * (1.0f / 128.0f) + 1e-5f);
            bf16_t* dst = out + (size_t)(U.qrow0 + qblk * 32 + rowl) * OPITCH + U.ocol + hf * 64;
#pragma unroll
            for (int e8 = 0; e8 < 8; ++e8) { const f32x4 g0 = *(const f32x4*)(subg + hf * 64 + e8 * 8), g1 = *(const f32x4*)(subg + hf * 64 + e8 * 8 + 4); u32x4 w;
                w.x = cvtpk(v[e8 * 8 + 0] * rstd * g0[0], v[e8 * 8 + 1] * rstd * g0[1]); w.y = cvtpk(v[e8 * 8 + 2] * rstd * g0[2], v[e8 * 8 + 3] * rstd * g0[3]);
                w.z = cvtpk(v[e8 * 8 + 4] * rstd * g1[0], v[e8 * 8 + 5] * rstd * g1[1]); w.w = cvtpk(v[e8 * 8 + 6] * rstd * g1[2], v[e8 * 8 + 7] * rstd * g1[3]);
                *(u32x4*)(dst + e8 * 8) = w; }
        }
        asm volatile("s_waitcnt lgkmcnt(0)\n\ts_barrier" ::: "memory");
    }
#undef ATT_TILE_ROW
#undef ATT_DMA_STAGE
#undef ATT_USE
#undef ATT_KSLOT
#undef ATT_WAIT_BAR
}
#undef ATT_SBAR
#undef ATT_TRG
#undef ATT_PK
#undef ATT_MM
#undef ATT_LF
}
constexpr int NWAVES = 8;
constexpr int NB = 8, SEQ = 2048, LC = 256, DM = 1024, FF = 4096, NPROJ = 3072;
constexpr int ML = NB * SEQ;
constexpr int MC = NB * LC;
constexpr int MT = ML + MC;
constexpr float NORM_EPS = 1e-6f;

constexpr size_t MiB = 1u << 20;
constexpr size_t WS_CTL = 0, CTL_ZERO_BYTES = 256 * 1024;
constexpr size_t WS_ROWSS1 = 64 * 1024;
constexpr size_t WS_BIAS2 = 1 * MiB + 512 * 1024 + 32 * 1024;
constexpr size_t WS_MADA = 1 * MiB;
constexpr size_t WS_ROPE = 1 * MiB + 512 * 1024;
constexpr size_t WS_LAM  = WS_ROPE + 16384;
constexpr size_t WS_MP = 1 * MiB + 512 * 1024 + 192 * 1024;
constexpr size_t WS_WIN = 2 * MiB, WS_WOUT = 8 * MiB, WS_W1_0 = 10 * MiB, WS_W2_0 = 18 * MiB;
constexpr size_t WS_W1_1 = 26 * MiB, WS_W2_1 = 34 * MiB, WS_WGLU = 42 * MiB;
constexpr size_t WS_SSM_WEND = 2 * MiB;
constexpr size_t WS_SSM_B2 = 10 * MiB;
constexpr size_t WS_HB = 46 * MiB;
constexpr size_t WS_BIG = 82 * MiB;
constexpr size_t WS_SEND = 162 * MiB;
constexpr size_t WS_XC = 226 * MiB;
constexpr size_t WS_H2B = 210 * MiB;
constexpr size_t WS_KD = 254 * MiB;
constexpr size_t WS_END = 256 * MiB;
static_assert(WS_BIG + (size_t)MT * FF * 2 <= WS_XC, "hid fits");
static_assert(WS_SEND + (size_t)64 * 1152 * 256 * 4 <= WS_END, "S_end fits");
static_assert(WS_BIG + (size_t)64 * 1280 * 512 * 2 <= WS_SEND, "A2 fits");

constexpr int RING_BYTES = 131072;
constexpr int LDSCTL_OFF = RING_BYTES, MISC_OFF = LDSCTL_OFF + 320;
constexpr int LDS_BYTES = 147456;

#define GAS __attribute__((address_space(1)))
#define LAS __attribute__((address_space(3)))
typedef unsigned short bf16;
typedef unsigned v4u __attribute__((ext_vector_type(4)));
typedef unsigned v2u __attribute__((ext_vector_type(2)));
typedef float f32x4 __attribute__((ext_vector_type(4)));
typedef GAS unsigned gu32;
#define RLX_AGENT __ATOMIC_RELAXED, __HIP_MEMORY_SCOPE_AGENT
#define LDS_WAIT() asm volatile("s_waitcnt lgkmcnt(0)" ::: "memory")
#define VM_WAIT() asm volatile("s_waitcnt vmcnt(0)" ::: "memory")
__device__ __forceinline__ unsigned f2bf(float f) { unsigned u = __builtin_bit_cast(unsigned, f); return (u + 0x7fffu + ((u >> 16) & 1u)) >> 16; }
__device__ __forceinline__ unsigned pk2(float lo, float hi) { return f2bf(lo) | (f2bf(hi) << 16); }

#define XB_TMO      128
#define XB_XCNT(j)  (256  + 64 * (j))
#define XB_XSUB(j)  (1280 + 64 * (j))
#define XB_XGEN(j)  (2304 + 64 * (j))
#define XB_TOP      3328
#define XB_TOPGEN   3392
#define XCD_BAR_WORDS 3456
#define XB_SPIN_CAP (1u << 18)
__device__ __forceinline__ unsigned xb_ld(unsigned* p)              { return __hip_atomic_load(p, __ATOMIC_RELAXED, __HIP_MEMORY_SCOPE_AGENT); }
__device__ __forceinline__ unsigned xb_add(unsigned* p, unsigned v) { return __hip_atomic_fetch_add(p, v, __ATOMIC_RELAXED, __HIP_MEMORY_SCOPE_AGENT); }
__device__ __forceinline__ unsigned xb_xcc_id() { return (unsigned)__builtin_amdgcn_s_getreg((3 << 11) | 20) & 0xFu; }
#define XB_SPIN(cond, bar) do { unsigned _sp = 0; while (cond) { __builtin_amdgcn_s_sleep(1); \
    if ((++_sp & 255u) == 0u) { if (xb_ld(&(bar)[XB_TMO])) break; if (_sp > XB_SPIN_CAP) { atomicAdd(&(bar)[XB_TMO], 1u); break; } } } } while (0)
struct XcdBarrier { unsigned* bar; unsigned x; volatile LAS unsigned* st; };
__device__ __forceinline__ XcdBarrier xcd_barrier_post(unsigned* bar, volatile LAS unsigned* st) {
    XcdBarrier b; b.bar = bar; b.x = xb_xcc_id(); b.st = st;
    if (threadIdx.x == 0) (void)xb_add(&bar[XB_XCNT(b.x)], 1u);
    return b;
}
__device__ __forceinline__ void xcd_barrier_complete(unsigned* bar, unsigned x, unsigned& nloc, unsigned& nx) {
    const unsigned G = gridDim.x * gridDim.y * gridDim.z;
    unsigned sum, cnt, mine, sp = 0u;
    for (;;) {
        sum = 0u; cnt = 0u; mine = 0u;
#pragma unroll
        for (unsigned j = 0; j < 16; ++j) { const unsigned c = xb_ld(&bar[XB_XCNT(j)]); sum += c; cnt += (c > 0u) ? 1u : 0u; mine = (j == x) ? c : mine; }
        if (sum == G) break;
        __builtin_amdgcn_s_sleep(1);
        if ((++sp & 255u) == 0u) { if (xb_ld(&bar[XB_TMO])) break; if (sp > XB_SPIN_CAP) { atomicAdd(&bar[XB_TMO], 1u); break; } }
    }
    nloc = mine > 0u ? mine : 1u; nx = cnt > 0u ? cnt : 1u;
}
__device__ __forceinline__ void xcd_barrier(const XcdBarrier& b) {
    asm volatile("s_waitcnt vmcnt(0)" ::: "memory");
    __syncthreads();
    if (threadIdx.x == 0) {
        unsigned* bar = b.bar;
        __builtin_amdgcn_s_waitcnt(0);
        unsigned nloc = b.st[0], nx = b.st[1];
        if (nloc == 0u) { xcd_barrier_complete(bar, b.x, nloc, nx); b.st[0] = nloc; b.st[1] = nx; }
        const unsigned k = b.st[2]; b.st[2] = k + 1u;
        const unsigned old = xb_add(&bar[XB_XSUB(b.x)], 1u);
        if (old + 1u == (k + 1u) * nloc) {
            __builtin_amdgcn_fence(__ATOMIC_RELEASE, "agent");
            asm volatile("s_waitcnt vmcnt(0)" ::: "memory");
            (void)xb_add(&bar[XB_TOP], 1u);
        }
        XB_SPIN(xb_ld(&bar[XB_TOP]) < (k + 1u) * nx, bar);
        __builtin_amdgcn_fence(__ATOMIC_ACQUIRE, "agent");
        asm volatile("s_waitcnt vmcnt(0)" ::: "memory");
    }
    __syncthreads();
}

struct Frame {
    LAS unsigned char* lds;
    int vcu, G;
};
__device__ __forceinline__ float wave_sum(float v) {
#pragma unroll
    for (int o = 1; o < 64; o <<= 1) v += __shfl_xor(v, o);
    return v;
}

__device__ __forceinline__ void p0_transpose_item(const float* W, int K, int N, bf16* WT, int radd, LAS float* scr, int item, int lane) {
    const int nblk = N / 64, kb = item / nblk, nb = item % nblk, k0 = 64 * kb, n0 = 64 * nb;
    float v_[64];
    const float* wp = W + (size_t)k0 * N + n0 + lane;
#pragma unroll
    for (int i = 0; i < 64; ++i) v_[i] = wp[(size_t)i * N];
    LAS unsigned short* t = (LAS unsigned short*)scr;
#pragma unroll
    for (int i = 0; i < 64; ++i) t[i * 66 + lane] = (unsigned short)f2bf(v_[i]);
    LDS_WAIT(); asm volatile("" ::: "memory");
    const int c = lane & 7;
#pragma unroll
    for (int j = 0; j < 8; ++j) { const int n = (lane >> 3) + 8 * j; const LAS unsigned short* s = t + (8 * c) * 66 + n;
        v4u o; o.x = (unsigned)s[0 * 66] | ((unsigned)s[1 * 66] << 16); o.y = (unsigned)s[2 * 66] | ((unsigned)s[3 * 66] << 16); o.z = (unsigned)s[4 * 66] | ((unsigned)s[5 * 66] << 16); o.w = (unsigned)s[6 * 66] | ((unsigned)s[7 * 66] << 16);
        *(GAS v4u*)(WT + (size_t)(radd + n0 + n) * K + k0 + 8 * c) = o; }
    LDS_WAIT(); asm volatile("" ::: "memory");
}

struct Args {
    const float* in[29]; float* out; unsigned char* ws; int pad0, pad1;
};

struct ModVec { f32x4 gm[4], sh[4]; };
__device__ __forceinline__ void load_modvec(ModVec& mv, const float* normg, const float* mrow  , int lane) {
#pragma unroll
    for (int j = 0; j < 4; ++j) { const int c = 4 * lane + 256 * j;
        const f32x4 g = *(const f32x4*)(normg + c), sc = *(const f32x4*)(mrow + 1024 + c); mv.sh[j] = *(const f32x4*)(mrow + c);
        mv.gm[j] = g * (sc + 1.0f); }
}
__device__ __forceinline__ void load_modvec4(ModVec& mv, const float* normg, const float* mp_r  , int lane) {
#pragma unroll
    for (int j = 0; j < 4; ++j) { const int c = 4 * lane + 256 * j;
        f32x4 sh = *(const f32x4*)(mp_r + c), sc = *(const f32x4*)(mp_r + 1024 + c);
#pragma unroll
        for (int q = 1; q < 4; ++q) { sh += *(const f32x4*)(mp_r + q * 9 * 2048 + c); sc += *(const f32x4*)(mp_r + q * 9 * 2048 + 1024 + c); }
        mv.sh[j] = sh; mv.gm[j] = *(const f32x4*)(normg + c) * (sc + 1.0f); }
}
__device__ __forceinline__ void norm_load(const float* xrow, int lane, f32x4 (&v)[4]) {
    const f32x4* xr = (const f32x4*)xrow + lane;
#pragma unroll
    for (int j = 0; j < 4; ++j) v[j] = xr[64 * j];
}
__device__ __forceinline__ f32x4 bf4_to_f32(v2u w) { return (f32x4){__uint_as_float(w.x << 16), __uint_as_float(w.x & 0xffff0000u), __uint_as_float(w.y << 16), __uint_as_float(w.y & 0xffff0000u)}; }
__device__ __forceinline__ void norm_load(const bf16* xrow, int lane, f32x4 (&v)[4]) {
#pragma unroll
    for (int j = 0; j < 4; ++j) v[j] = bf4_to_f32(*(const v2u*)(xrow + 4 * lane + 256 * j));
}
template <int NS>
__device__ __forceinline__ f32x4 slab_sum(const bf16* srow, int c) {
    constexpr size_t SS = (size_t)2048 * 1024; f32x4 s = (f32x4){0.f, 0.f, 0.f, 0.f};
#pragma unroll
    for (int i = 0; i < NS; ++i) s += bf4_to_f32(*(const v2u*)(srow + i * SS + c));
    return s;
}
template <int NS>
__device__ __forceinline__ void norm_load_fix(const bf16* brow, const bf16* srow, const float* gate, int lane, f32x4 (&v)[4]) {
#pragma unroll
    for (int j = 0; j < 4; ++j) { const int c = 4 * lane + 256 * j; v[j] = bf4_to_f32(*(const v2u*)(brow + c)) + *(const f32x4*)(gate + c) * slab_sum<NS>(srow, c); }
}
template <int NS>
__device__ __forceinline__ void norm_load_fix(const float* brow, const bf16* srow, const float* gate, int lane, f32x4 (&v)[4]) {
#pragma unroll
    for (int j = 0; j < 4; ++j) { const int c = 4 * lane + 256 * j; v[j] = *(const f32x4*)(brow + c) + *(const f32x4*)(gate + c) * slab_sum<NS>(srow, c); }
}
__device__ __forceinline__ void norm_finish(const f32x4 (&v)[4], const ModVec& mv, f32x4 (&y)[4]) {
    float s = 0.f;
#pragma unroll
    for (int j = 0; j < 4; ++j) s += (v[j].x * v[j].x + v[j].y * v[j].y) + (v[j].z * v[j].z + v[j].w * v[j].w);
    const float rstd = 1.0f / sqrtf(wave_sum(s) * (1.0f / 1024.0f) + NORM_EPS);
#pragma unroll
    for (int j = 0; j < 4; ++j) y[j] = v[j] * rstd * mv.gm[j] + mv.sh[j];
}

__device__ __forceinline__ void sincos_acc(double ang, float& s, float& c) {
    double rev = ang * 0.15915494309189535; rev -= floor(rev);
    const float r = (float)rev;
    s = __builtin_amdgcn_sinf(r); c = __builtin_amdgcn_cosf(r);
}
enum { I_X = 0, I_C, I_CTX, I_CCTX, I_WADA, I_BADA, I_N1G, I_N2G, I_FG, I_WIN, I_WOUT, I_LQ1, I_LK1, I_LQ2, I_LK2, I_SUBG, I_RPB,
       I_SLRE, I_SLIM, I_SLOG, I_SBRE, I_SBIM, I_SCRE, I_SCIM, I_SD, I_GLUA, I_GLUB, I_W1, I_W2 };

__global__ void __launch_bounds__(NWAVES * 64, 2) fwd_kernel(Args args) {
    extern __shared__ __attribute__((aligned(16))) unsigned char lds[];
    Frame F;
    F.lds = (LAS unsigned char*)lds;
    volatile LAS unsigned* MISC = (volatile LAS unsigned*)(F.lds + MISC_OFF);
    F.G = gridDim.x; { const int bx = blockIdx.x; F.vcu = (F.G % 8 == 0) ? (bx % 8) * (F.G / 8) + bx / 8 : bx; }
    unsigned* barwords; { unsigned char* ws0 = args.ws; barwords = (unsigned*)(ws0 + WS_CTL) + 1024; }
    for (int u = threadIdx.x; u < (LDS_BYTES - LDSCTL_OFF) / 4; u += NWAVES * 64) ((LAS unsigned*)(F.lds + LDSCTL_OFF))[u] = 0u;
    __syncthreads();
    XcdBarrier bar = xcd_barrier_post(barwords, MISC + 8);
#ifdef PROBE_TS
    unsigned long long* tsbuf = (unsigned long long*)(args.ws + 32768);
    int ts_n = 0;
#define TS_STAMP() do { if (blockIdx.x == 0 && threadIdx.x == 0) { tsbuf[ts_n] = __builtin_amdgcn_s_memrealtime(); } ++ts_n; } while (0)
    TS_STAMP();
#define GRID_BAR() do { xcd_barrier(bar); TS_STAMP(); } while (0)
#else
#define GRID_BAR() xcd_barrier(bar)
#endif
    const int NGW = F.G * NWAVES;
#define FRESH_IDS() int tid = threadIdx.x; asm volatile("" : "+v"(tid)); const int lane = tid & 63; const int wave = __builtin_amdgcn_readfirstlane(tid >> 6); const int gw = F.vcu * NWAVES + wave; (void)lane; (void)gw

    typedef const float* const __attribute__((address_space(4)))* ArgTab;
#define PHASE_ENV() unsigned long long kap_ = (unsigned long long)__builtin_amdgcn_kernarg_segment_ptr(); asm volatile("" : "+s"(kap_)); const ArgTab atab_ = (ArgTab)kap_; \
        unsigned char* ws = (unsigned char*)atab_[30]; bf16* xl = (bf16*)atab_[29]; float* outf = (float*)atab_[29]; const float* x_in = atab_[I_X]; const float* ctx_in = atab_[I_CTX]; \
        bf16* xc = (bf16*)(ws + WS_XC); float* mada = (float*)(ws + WS_MADA); float* rope = (float*)(ws + WS_ROPE); float* lamp = (float*)(ws + WS_LAM); \
        bf16* HB = (bf16*)(ws + WS_HB); bf16* BIG = (bf16*)(ws + WS_BIG); \
        (void)xl; (void)outf; (void)x_in; (void)ctx_in; (void)xc; (void)mada; (void)rope; (void)lamp; (void)HB; (void)BIG
#define AIN(i) (atab_[i])
#define SLAB7 (xl + (size_t)ML * 1024)
#define ADALN_ITEM(L_, CG_) do { const int l = (L_), cg = (CG_); \
            LAS float* act = (LAS float*)F.lds;                 \
            LAS float* red = (LAS float*)(F.lds + 36864);       \
            const float* c = AIN(I_C); const float* cc = AIN(I_CCTX); \
            for (int i = tid; i < 9216; i += 512) { const float v = (i < 8192) ? c[i] : cc[i - 8192]; act[i] = v / (1.0f + __expf(-v)); } \
            __syncthreads(); \
            const float* W = AIN(I_WADA) + (size_t)l * 1024 * 6144 + cg * 64 + lane; \
            float acc[9]; \
            _Pragma("unroll") for (int r = 0; r < 9; ++r) acc[r] = 0.f; \
            const int k0 = wave * 128; \
            for (int k4 = 0; k4 < 128; k4 += 32) { float wv[32]; \
                _Pragma("unroll") for (int i = 0; i < 32; ++i) wv[i] = W[(size_t)(k0 + k4 + i) * 6144]; \
                _Pragma("unroll") for (int i = 0; i < 32; ++i) \
                    _Pragma("unroll") for (int r = 0; r < 9; ++r) acc[r] += act[r * 1024 + k0 + k4 + i] * wv[i]; } \
            _Pragma("unroll") for (int r = 0; r < 9; ++r) red[(wave * 9 + r) * 64 + lane] = acc[r]; \
            __syncthreads(); \
            for (int i = tid; i < 576; i += 512) { const int r = i / 64, cl = i % 64; float s_ = AIN(I_BADA)[l * 6144 + cg * 64 + cl]; \
                _Pragma("unroll") for (int w = 0; w < 8; ++w) s_ += red[(w * 9 + r) * 64 + cl]; \
                mada[(l * 9 + r) * 6144 + cg * 64 + cl] = s_; } \
            __syncthreads(); } while (0)
#define ADALN_QITEM(CG_, KQ_) do { const int cg = (CG_), kq = (KQ_); \
            LAS float* act = (LAS float*)F.lds;                 \
            LAS float* red = (LAS float*)(F.lds + 36864);       \
            const float* c = AIN(I_C); const float* cc = AIN(I_CCTX); \
            for (int i = tid; i < 9 * 256; i += 512) { const int r = i >> 8, k = kq * 256 + (i & 255); const float v = (r < 8) ? c[r * 1024 + k] : cc[k]; act[i] = v / (1.0f + __expf(-v)); } \
            __syncthreads(); \
            const float* W = AIN(I_WADA) + cg * 64 + lane; \
            float acc[9]; \
            _Pragma("unroll") for (int r = 0; r < 9; ++r) acc[r] = 0.f; \
            const int kl = wave * 32; \
            { float wv[32]; \
                _Pragma("unroll") for (int i = 0; i < 32; ++i) wv[i] = W[(size_t)(kq * 256 + kl + i) * 6144]; \
                _Pragma("unroll") for (int i = 0; i < 32; ++i) \
                    _Pragma("unroll") for (int r = 0; r < 9; ++r) acc[r] += act[r * 256 + kl + i] * wv[i]; } \
            _Pragma("unroll") for (int r = 0; r < 9; ++r) red[(wave * 9 + r) * 64 + lane] = acc[r]; \
            __syncthreads(); \
            for (int i = tid; i < 576; i += 512) { const int r = i / 64, cl = i % 64; float s_ = (kq == 0) ? AIN(I_BADA)[cg * 64 + cl] : 0.f; \
                _Pragma("unroll") for (int w = 0; w < 8; ++w) s_ += red[(w * 9 + r) * 64 + cl]; \
                ((float*)(ws + WS_MP))[(kq * 9 + r) * 2048 + cg * 64 + cl] = s_; } \
            __syncthreads(); } while (0)
#define KD_ITEM(G_, LQ_) do { const int g = (G_), lq = (LQ_); \
            LAS float* apr = (LAS float*)F.lds;                 \
            LAS float* api = apr + 512; \
            LAS float* bbr = api + 512;                         \
            LAS float* bbi = bbr + 2048; \
            LAS float* Cr = bbi + 2048;                         \
            LAS float* Ci = Cr + 2048; \
            { const int d = tid >> 8, jj = (tid >> 6) & 3, p = tid & 63; const int gp = (d * 64 + g) * 64 + p; \
                const float lr = AIN(I_SLRE)[gp], li = AIN(I_SLIM)[gp]; const float delta = expf(AIN(I_SLOG)[d * 64 + g]); \
                const f32x4 br4 = *(const f32x4*)(AIN(I_SBRE) + (size_t)gp * 16 + 4 * jj), bi4 = *(const f32x4*)(AIN(I_SBIM) + (size_t)gp * 16 + 4 * jj); \
                { const int j = 4 * lq + jj; const float mag = expf(lr * delta * (float)j); float sn, cs; sincos_acc((double)li * (double)delta * (double)j, sn, cs); \
                    apr[(d * 4 + jj) * 64 + p] = mag * cs; api[(d * 4 + jj) * 64 + p] = mag * sn; } \
                float sn1, cs1; sincos_acc((double)li * (double)delta, sn1, cs1); const float mag1 = expf(lr * delta); \
                const float ar = mag1 * cs1, ai = mag1 * sn1; \
                const float den = lr * lr + li * li, nr = ar - 1.0f; const float cr = (nr * lr + ai * li) / den, ci = (ai * lr - nr * li) / den; \
                f32x4 or_, oi_; \
                _Pragma("unroll") for (int e = 0; e < 4; ++e) { or_[e] = cr * br4[e] - ci * bi4[e]; oi_[e] = cr * bi4[e] + ci * br4[e]; } \
                *(LAS f32x4*)(bbr + (d * 64 + p) * 16 + 4 * jj) = or_; *(LAS f32x4*)(bbi + (d * 64 + p) * 16 + 4 * jj) = oi_; } \
            for (int i = tid; i < 2048; i += 512) { const int d = i >> 10, h = (i >> 6) & 15, p = i & 63; \
                Cr[i] = AIN(I_SCRE)[((size_t)(d * 64 + g) * 16 + h) * 64 + p]; Ci[i] = AIN(I_SCIM)[((size_t)(d * 64 + g) * 16 + h) * 64 + p]; } \
            __syncthreads(); \
            { const int d = tid >> 8, jj = (tid >> 6) & 3, h = (tid >> 2) & 15, hq = tid & 3;     \
                float s0 = 0.f, s1 = 0.f, s2 = 0.f, s3 = 0.f; \
                for (int p = 0; p < 64; ++p) { const float ar = apr[(d * 4 + jj) * 64 + p], ai = api[(d * 4 + jj) * 64 + p]; const float cr = Cr[(d * 16 + h) * 64 + p], ci = Ci[(d * 16 + h) * 64 + p]; \
                    const float wr_ = cr * ar - ci * ai, wi_ = cr * ai + ci * ar;              \
                    const f32x4 br = *(const LAS f32x4*)(bbr + (d * 64 + p) * 16 + 4 * hq), bi = *(const LAS f32x4*)(bbi + (d * 64 + p) * 16 + 4 * hq); \
                    s0 += wr_ * br[0] - wi_ * bi[0]; s1 += wr_ * br[1] - wi_ * bi[1]; s2 += wr_ * br[2] - wi_ * bi[2]; s3 += wr_ * br[3] - wi_ * bi[3]; } \
                float* kd = (float*)(ws + WS_KD) + ((((size_t)g * 2 + d) * 16 + (4 * lq + jj)) * 16 + h) * 16 + 4 * hq; \
                *(f32x4*)kd = (f32x4){s0, s1, s2, s3}; } \
            __syncthreads(); } while (0)

    { PHASE_ENV();
        FRESH_IDS();
        for (int it = F.vcu; it < 128; it += F.G) ADALN_QITEM(it >> 2, it & 3);
        if (F.vcu == 128 % F.G) {
            for (int i = tid; i < 1024; i += 512) { const int pos = i >> 4, j = i & 15; const float inv = exp2f(-(float)j * (13.287712379549449f / 16.0f)); const float ang = (float)pos * inv;
                float sn, cs; sincos_acc((double)ang, sn, cs); rope[i] = cs; rope[1024 + i] = sn; }
            if (tid == 0) { float s1 = 0.f, s2 = 0.f;
                for (int i = 0; i < 64; ++i) { s1 += AIN(I_LQ1)[i] * AIN(I_LK1)[i]; s2 += AIN(I_LQ2)[i] * AIN(I_LK2)[i]; }
                lamp[0] = expf(s1) - expf(s2) + 0.2f; }
        }
        LAS float* scr = (LAS float*)(F.lds + 57344 + wave * 8448);
        constexpr int I_A = 16 * 48;
        for (int it = gw; it < I_A; it += NGW) p0_transpose_item(AIN(I_WIN), 1024, 3072, (bf16*)(ws + WS_WIN), 0, scr, it, lane);
    }
    GRID_BAR();

#define NORM_ROW_OF(q) ((q) < perl ? (((q) < nl_) ? gw * perl + (q) : -1) : ((((q) - perl) < nc_) ? ML + gw * perc + ((q) - perl) : -1))
#define NORM_TO_HB(LAYER, WHICH, NORMG_IDX, SRC_L, SRC_C, NROWS, SLABS, GATE, XCOUT, LATROWS) do { PHASE_ENV(); FRESH_IDS(); \
        const int latn_ = (LATROWS);        \
        const int perl = (latn_ + NGW - 1) / NGW, perc = ((NROWS) > ML) ? (MC + NGW - 1) / NGW : 0; \
        const int nl_ = (latn_ - gw * perl) < perl ? ((latn_ - gw * perl) > 0 ? (latn_ - gw * perl) : 0) : perl; \
        const int nc_ = perc ? ((MC - gw * perc) < perc ? ((MC - gw * perc) > 0 ? (MC - gw * perc) : 0) : perc) : 0; \
        int cur_r = -1; ModVec mv; const bf16* slabs_ = (SLABS); bf16* xcout_ = (XCOUT); \
        for (int q0 = 0; q0 < perl + perc; q0 += 3) { f32x4 v[3][4]; \
            _Pragma("unroll") for (int u = 0; u < 3; ++u) { const int row = (q0 + u < perl + perc) ? NORM_ROW_OF(q0 + u) : -1; if (row >= 0) { \
                if (row < ML) norm_load((SRC_L) + (size_t)row * 1024, lane, v[u]); \
                else if (slabs_) { norm_load_fix<4>((SRC_C) + (size_t)(row - ML) * 1024, slabs_ + (size_t)(row - ML) * 1024, (GATE), lane, v[u]); \
                    if (xcout_) { _Pragma("unroll") for (int j = 0; j < 4; ++j) { v2u w_; w_.x = pk2(v[u][j].x, v[u][j].y); w_.y = pk2(v[u][j].z, v[u][j].w); *(v2u*)(xcout_ + (size_t)(row - ML) * 1024 + 4 * lane + 256 * j) = w_; } } } \
                else norm_load((SRC_C) + (size_t)(row - ML) * 1024, lane, v[u]); } } \
            _Pragma("unroll") for (int u = 0; u < 3; ++u) { const int row = (q0 + u < perl + perc) ? NORM_ROW_OF(q0 + u) : -1; if (row >= 0) { const int r = row < ML ? (row >> 11) : 8; \
                if (r != cur_r) { if ((LAYER) == 0 && (WHICH) == 0) load_modvec4(mv, atab_[NORMG_IDX], (const float*)(ws + WS_MP) + r * 2048, lane); \
                    else load_modvec(mv, atab_[NORMG_IDX] + (LAYER) * 1024, mada + ((LAYER) * 9 + r) * 6144 + (WHICH) * 3072, lane); cur_r = r; } \
                f32x4 y[4]; norm_finish(v[u], mv, y); \
                GAS unsigned long long* o8 = (GAS unsigned long long*)(HB + (size_t)row * 1024) + lane; \
                _Pragma("unroll") for (int j = 0; j < 4; ++j) o8[64 * j] = (unsigned long long)pk2(y[j].x, y[j].y) | ((unsigned long long)pk2(y[j].z, y[j].w) << 32); } } } \
    } while (0)
    NORM_TO_HB(0, 0, I_N1G, x_in, ctx_in, MT, (const bf16*)nullptr, mada, (bf16*)nullptr, ML);
    GRID_BAR();

    { PHASE_ENV();
        pg8::Gemm g{HB, (const bf16*)(ws + WS_WIN), 1024, 1024, 1024}; pg8::StaticOrder S; S.init(MT, NPROJ, F.G, (int)blockIdx.x);
        LAS float* ropel = (LAS float*)(F.lds + 132096);
        for (int i = threadIdx.x; i < 2048; i += NWAVES * 64) ropel[i] = rope[i];
        __syncthreads();
        pg8::EpiInProj E{BIG, ropel};
        pg8::gemm_phase<pg8::EpiInProj, pg8::StaticOrder, true>(F.lds, g, S, E);
        const int nfull = (MT / 256) * (NPROJ / 256) - (((MT / 256) * (NPROJ / 256)) / F.G) * F.G;
        if ((int)blockIdx.x >= nfull) {
            FRESH_IDS();
            const int tb = (int)blockIdx.x - nfull, ntb = F.G - nfull;
            __syncthreads();
            for (int it = tb; it < 160; it += ntb) { const int l_ = it < 64 ? 0 : 1, cg_ = it < 64 ? 32 + it : it - 64; ADALN_ITEM(l_, cg_); }
            const int cw = tb * NWAVES + wave, ncw = ntb * NWAVES;
            LAS float* scr = (LAS float*)(F.lds + 57344 + wave * 8448);
            constexpr int I_B = 16 * 16, I_C1 = 16 * 64;
            constexpr int NITEMS = I_B + I_C1;
            for (int it = cw; it < NITEMS; it += ncw) {
                int r = it;
                if (r < I_B) { p0_transpose_item(AIN(I_WOUT), 1024, 1024, (bf16*)(ws + WS_WOUT), 0, scr, r, lane); continue; } r -= I_B;
                p0_transpose_item(AIN(I_W1) + (size_t)1024 * 4096, 1024, 4096, (bf16*)(ws + WS_W1_1), 0, scr, r, lane);
            }
        }
    }
    GRID_BAR();

#ifdef ATT_XM
    { PHASE_ENV();
        const float lam = lamp[0];
        const float* subg = AIN(I_SUBG); const float* rpb = AIN(I_RPB);
        const int v = F.vcu;
        att::lds_u8* shm = (att::lds_u8*)F.lds;
        const int nG = F.G;
#define ATT_FOR_UNITS(NUNITS, PERCU, IDEXPR) for (int k_ = 0; k_ < ((nG == 256) ? (PERCU) : ((NUNITS) + nG - 1) / nG); ++k_) { const int id = (nG == 256) ? (IDEXPR) : (k_ * nG + v); if (id < 0 || id >= (NUNITS)) continue;
        const int xq = v >> 5, iq = v & 31;
        const bool edge = ((iq & 7) == 0) || ((iq & 7) == 7); const int eidx = (iq >> 3) * 2 + ((iq & 7) == 7 ? 1 : 0), midx = (iq >> 3) * 6 + (iq & 7) - 1;
        ATT_FOR_UNITS(512, 2, ((xq * 4 + 2 * k_ + (iq >> 4)) * 16 + (iq & 15)))
            const int b = id >> 6, h = (id >> 4) & 3, qb = id & 15;
            att::UnitDesc U; U.qrow0 = b * 2048 + qb * 128; U.qcol = h * 128; U.kcol = 512 + h * 128; U.vcol = 1024 + h * 128;
            U.latrow = b * 2048; U.t0 = 0; U.nlat = 32; U.ctxrow = ML + b * 256; U.ocol = h * 128; U.r0 = 0; U.head = 0;
            att::attn_unit<true, false, ATT_XM>(U, BIG, HB, shm, rpb, subg, lam, 0.8f);
        }
        ATT_FOR_UNITS(512, 2, ((xq * 8 + 4 * k_ + (iq >> 3)) * 8 + (iq & 7)))
            const int b = id >> 6, h = (id >> 3) & 7, rq = id & 7;
            const int ra = 4 * rq, rb_ = 4 * rq + 3; const int rsa = ra < 4 ? 0 : (ra > 28 ? 24 : ra - 4), rsb = rb_ < 4 ? 0 : (rb_ > 28 ? 24 : rb_ - 4);
            att::UnitDesc U; U.qrow0 = b * 2048 + rq * 256; U.qcol = 1536 + h * 64; U.kcol = 2048 + h * 64; U.vcol = 2560 + h * 64;
            U.latrow = b * 2048; U.t0 = rsa; U.nlat = rsb + 7 - rsa + 1; U.ctxrow = ML + b * 256; U.ocol = 512 + h * 64; U.r0 = ra; U.head = h;
            att::attn_unit<false, true, ATT_XM>(U, BIG, HB, shm, rpb, subg, lam, 1.0f);
        }
        ATT_FOR_UNITS(64, 1, (edge ? xq * 8 + eidx : -1))
            const int b = id >> 3, h = (id >> 1) & 3, hf = id & 1;
            att::UnitDesc U; U.qrow0 = ML + b * 256 + hf * 128; U.qcol = h * 128; U.kcol = 512 + h * 128; U.vcol = 1024 + h * 128;
            U.latrow = 0; U.t0 = 0; U.nlat = 0; U.ctxrow = ML + b * 256; U.ocol = h * 128; U.r0 = 0; U.head = 0;
            att::attn_unit<true, false, ATT_XM>(U, BIG, HB, shm, rpb, subg, lam, 0.8f);
        }
        ATT_FOR_UNITS(64, 1, (edge ? xq * 8 + eidx : -1))
            const int b = id >> 3, h = id & 7;
            att::UnitDesc U; U.qrow0 = ML + b * 256; U.qcol = 1536 + h * 64; U.kcol = 2048 + h * 64; U.vcol = 2560 + h * 64;
            U.latrow = 0; U.t0 = 0; U.nlat = 0; U.ctxrow = ML + b * 256; U.ocol = 512 + h * 64; U.r0 = 0; U.head = 0;
            att::attn_unit<false, false, ATT_XM>(U, BIG, HB, shm, rpb, subg, lam, 1.0f);
        }
        {
            FRESH_IDS();
            const bool sel = (nG == 256) ? !edge : true;
            if (sel) { const int tb = (nG == 256) ? (xq * 24 + midx) : v, ntb = (nG == 256) ? 192 : nG;
                __syncthreads();
                LAS float* scr = (LAS float*)(F.lds + 57344 + wave * 8448);
                for (int it = tb * NWAVES + wave; it < 16 * 64; it += ntb * NWAVES) p0_transpose_item(AIN(I_W1), 1024, 4096, (bf16*)(ws + WS_W1_0), 0, scr, it, lane); }
        }
#undef ATT_FOR_UNITS
    }
    GRID_BAR();

#endif
    { PHASE_ENV();
        const float lam = lamp[0];
        const float* subg = AIN(I_SUBG); const float* rpb = AIN(I_RPB);
        const int v = F.vcu;
        att::lds_u8* shm = (att::lds_u8*)F.lds;
        const int nG = F.G;
#define ATT_FOR_UNITS(NUNITS, PERCU, IDEXPR) for (int k_ = 0; k_ < ((nG == 256) ? (PERCU) : ((NUNITS) + nG - 1) / nG); ++k_) { const int id = (nG == 256) ? (IDEXPR) : (k_ * nG + v); if (id < 0 || id >= (NUNITS)) continue;
        const int xq = v >> 5, iq = v & 31;
        const bool edge = ((iq & 7) == 0) || ((iq & 7) == 7); const int eidx = (iq >> 3) * 2 + ((iq & 7) == 7 ? 1 : 0), midx = (iq >> 3) * 6 + (iq & 7) - 1;
        ATT_FOR_UNITS(512, 2, ((xq * 4 + 2 * k_ + (iq >> 4)) * 16 + (iq & 15)))
            const int b = id >> 6, h = (id >> 4) & 3, qb = id & 15;
            att::UnitDesc U; U.qrow0 = b * 2048 + qb * 128; U.qcol = h * 128; U.kcol = 512 + h * 128; U.vcol = 1024 + h * 128;
            U.latrow = b * 2048; U.t0 = 0; U.nlat = 32; U.ctxrow = ML + b * 256; U.ocol = h * 128; U.r0 = 0; U.head = 0;
            att::attn_unit<true, false>(U, BIG, HB, shm, rpb, subg, lam, 0.8f);
        }
        ATT_FOR_UNITS(512, 2, ((xq * 8 + 4 * k_ + (iq >> 3)) * 8 + (iq & 7)))
            const int b = id >> 6, h = (id >> 3) & 7, rq = id & 7;
            const int ra = 4 * rq, rb_ = 4 * rq + 3; const int rsa = ra < 4 ? 0 : (ra > 28 ? 24 : ra - 4), rsb = rb_ < 4 ? 0 : (rb_ > 28 ? 24 : rb_ - 4);
            att::UnitDesc U; U.qrow0 = b * 2048 + rq * 256; U.qcol = 1536 + h * 64; U.kcol = 2048 + h * 64; U.vcol = 2560 + h * 64;
            U.latrow = b * 2048; U.t0 = rsa; U.nlat = rsb + 7 - rsa + 1; U.ctxrow = ML + b * 256; U.ocol = 512 + h * 64; U.r0 = ra; U.head = h;
            att::attn_unit<false, true>(U, BIG, HB, shm, rpb, subg, lam, 1.0f);
        }
        ATT_FOR_UNITS(64, 1, (edge ? xq * 8 + eidx : -1))
            const int b = id >> 3, h = (id >> 1) & 3, hf = id & 1;
            att::UnitDesc U; U.qrow0 = ML + b * 256 + hf * 128; U.qcol = h * 128; U.kcol = 512 + h * 128; U.vcol = 1024 + h * 128;
            U.latrow = 0; U.t0 = 0; U.nlat = 0; U.ctxrow = ML + b * 256; U.ocol = h * 128; U.r0 = 0; U.head = 0;
            att::attn_unit<true, false>(U, BIG, HB, shm, rpb, subg, lam, 0.8f);
        }
        ATT_FOR_UNITS(64, 1, (edge ? xq * 8 + eidx : -1))
            const int b = id >> 3, h = id & 7;
            att::UnitDesc U; U.qrow0 = ML + b * 256; U.qcol = 1536 + h * 64; U.kcol = 2048 + h * 64; U.vcol = 2560 + h * 64;
            U.latrow = 0; U.t0 = 0; U.nlat = 0; U.ctxrow = ML + b * 256; U.ocol = 512 + h * 64; U.r0 = 0; U.head = 0;
            att::attn_unit<false, false>(U, BIG, HB, shm, rpb, subg, lam, 1.0f);
        }
        {
            FRESH_IDS();
            const bool sel = (nG == 256) ? !edge : true;
            if (sel) { const int tb = (nG == 256) ? (xq * 24 + midx) : v, ntb = (nG == 256) ? 192 : nG;
                __syncthreads();
                LAS float* scr = (LAS float*)(F.lds + 57344 + wave * 8448);
                for (int it = tb * NWAVES + wave; it < 16 * 64; it += ntb * NWAVES) p0_transpose_item(AIN(I_W1), 1024, 4096, (bf16*)(ws + WS_W1_0), 0, scr, it, lane); }
        }
#undef ATT_FOR_UNITS
    }
    GRID_BAR();

    { PHASE_ENV();
        pg8::Gemm g{HB, (const bf16*)(ws + WS_WOUT), 1024, 1024, 1024}; pg8::SplitOrder S; S.init(F.G, (int)blockIdx.x, 1024, 2);
        if (F.G == 256) {
            { pg8::StaticOrder SL; SL.init(ML, DM, F.G, (int)blockIdx.x);
              pg8::EpiResidNorm E{x_in, xl, mada + 2048, HB, AIN(I_N2G), mada + 3072, (float*)(ws + WS_MP), (unsigned*)(ws + 2304), (LAS float*)(F.lds + 132096)};
              pg8::gemm_phase<pg8::EpiResidNorm, pg8::StaticOrder, true>(F.lds, g, SL, E); }
            { pg8::CtxSliceOrder SC{F.G, (int)blockIdx.x, 16, 2};
              pg8::EpiSlab E{(bf16*)BIG};
              pg8::gemm_phase<pg8::EpiSlab, pg8::CtxSliceOrder, true>(F.lds, g, SC, E); }
        } else {
            pg8::EpiResid<true> E{x_in, ctx_in, xl, xc, mada + 2048, (bf16*)BIG};
            pg8::gemm_phase<pg8::EpiResid<true>, pg8::SplitOrder, true>(F.lds, g, S, E);
        }
        const int nfull = 384 - (384 / F.G) * F.G;
        if ((int)blockIdx.x >= nfull) {
            FRESH_IDS();
            LAS float* scr = (LAS float*)(F.lds + 57344 + wave * 8448);
            constexpr int I_G = 16 * 16;
            for (int it = ((int)blockIdx.x - nfull) * NWAVES + wave; it < 2 * I_G; it += (F.G - nfull) * NWAVES) {
                const bool isb = it >= I_G; const int rr = isb ? it - I_G : it; const int n0 = 64 * (rr % 16); const int radd = 256 * (n0 / 128) + (n0 % 128) - n0 + (isb ? 128 : 0);
                p0_transpose_item(isb ? AIN(I_GLUB) : AIN(I_GLUA), 1024, 1024, (bf16*)(ws + WS_WGLU), radd, scr, rr, lane); }
        }
    }
    GRID_BAR();
    NORM_TO_HB(0, 1, I_N2G, xl, ctx_in, MT, (const bf16*)BIG, mada + 8 * 6144 + 2048, xc, (F.G == 256) ? 0 : ML);
    GRID_BAR();
    { PHASE_ENV();
        pg8::Gemm g{HB, (const bf16*)(ws + WS_W1_0), 1024, 1024, 1024}; pg8::StaticOrder S; S.init(MT, FF, F.G, (int)blockIdx.x);
        pg8::EpiRelu2<false> E{BIG, FF, nullptr, nullptr};
        pg8::gemm_phase<pg8::EpiRelu2<false>, pg8::StaticOrder, true>(F.lds, g, S, E);
        const int nfull = (MT / 256) * (FF / 256) - (((MT / 256) * (FF / 256)) / F.G) * F.G;
        if ((int)blockIdx.x >= nfull) {
            FRESH_IDS();
            const int tb = (int)blockIdx.x - nfull, ntb = F.G - nfull;
            __syncthreads();
            for (int it = tb; it < 256; it += ntb) KD_ITEM(it >> 2, it & 3);
            const int cw = tb * NWAVES + wave, ncw = ntb * NWAVES;
            LAS float* scr = (LAS float*)(F.lds + 57344 + wave * 8448);
            for (int it = cw; it < 64 * 16; it += ncw) p0_transpose_item(AIN(I_W2), 4096, 1024, (bf16*)(ws + WS_W2_0), 0, scr, it, lane);
        }
    }
    GRID_BAR();
    { PHASE_ENV();
        pg8::Gemm g{BIG, (const bf16*)(ws + WS_W2_0), FF, FF, FF}; pg8::SplitOrder S; S.init(F.G, (int)blockIdx.x, FF, 3);
        if (F.G == 256) {
            { pg8::StaticOrder SL; SL.init(ML, DM, F.G, (int)blockIdx.x, FF);
              pg8::EpiResidNormA E{xl, xl, mada + 5120, (bf16*)(ws + WS_HB), AIN(I_N1G) + 1024, mada + 9 * 6144, (float*)(ws + WS_MP), (unsigned*)(ws + 2560), (LAS float*)(F.lds + 132096)};
              pg8::gemm_phase<pg8::EpiResidNormA, pg8::StaticOrder, true>(F.lds, g, SL, E); }
            { pg8::CtxSliceOrder SC{F.G, (int)blockIdx.x, 64, 3};
              pg8::EpiSlab E{SLAB7};
              pg8::gemm_phase<pg8::EpiSlab, pg8::CtxSliceOrder, true>(F.lds, g, SC, E); }
        } else {
            pg8::EpiResid<false> E{xl, xc, xl, xc, mada + 5120, SLAB7};
            pg8::gemm_phase<pg8::EpiResid<false>, pg8::SplitOrder, true>(F.lds, g, S, E);
        }
    }
    GRID_BAR();

#define AUL HB
#define AUC ((bf16*)(ws + 230 * MiB))
#define ACR ((bf16*)(ws + WS_BIG + 32 * MiB))
#define ZB BIG
#define X3A ((bf16*)(ws + 2 * MiB))
#define X3B ((bf16*)(ws + 242 * MiB) - (size_t)12288 * 1024)
#define SEND ((bf16*)(ws + WS_SEND))
    { PHASE_ENV();
        FRESH_IDS();
        v2u rawn[2][4], rawm[2][4];
#define P8_ROW0(ci_) (((ci_) >> 7) * 2048 + ((ci_) & 127) * 16)
        const int ci0 = (F.G == 256) ? 1024 + F.vcu : F.vcu;
        if (ci0 < 1024) {
#pragma unroll
            for (int u = 0; u < 2; ++u)
#pragma unroll
                for (int j = 0; j < 4; ++j) rawn[u][j] = *(const v2u*)(xl + (size_t)(P8_ROW0(ci0) + 2 * wave + u) * 1024 + 4 * lane + 256 * j); }
        if (ci0 + F.G < 1024) {
#pragma unroll
            for (int u = 0; u < 2; ++u)
#pragma unroll
                for (int j = 0; j < 4; ++j) rawm[u][j] = *(const v2u*)(xl + (size_t)(P8_ROW0(ci0 + F.G) + 2 * wave + u) * 1024 + 4 * lane + 256 * j); }
        {
            const int g = F.vcu >> 2, q = F.vcu & 3;
            LAS float* apr = (LAS float*)F.lds;
            LAS float* api = apr + 2 * 17 * 64;
            LAS float* bbr = api + 2 * 17 * 64;
            LAS float* bbi = bbr + 2 * 64 * 16;
            LAS float* Cr = bbi + 2 * 64 * 16;
            LAS float* Ci = Cr + 2 * 16 * 64;
            { const int d = tid >> 8, jq = (tid >> 6) & 3, p = tid & 63; const int gp = (d * 64 + g) * 64 + p;
                const float lr = AIN(I_SLRE)[gp], li = AIN(I_SLIM)[gp]; const float delta = expf(AIN(I_SLOG)[d * 64 + g]);
                const f32x4 br4 = *(const f32x4*)(AIN(I_SBRE) + (size_t)gp * 16 + 4 * jq), bi4 = *(const f32x4*)(AIN(I_SBIM) + (size_t)gp * 16 + 4 * jq);
#pragma unroll
                for (int jj = 0; jj < 5; ++jj) { const int j = jq + 4 * jj; if (j <= 16) { const float mag = expf(lr * delta * (float)j); float sn, cs; sincos_acc((double)li * (double)delta * (double)j, sn, cs);
                    apr[(d * 17 + j) * 64 + p] = mag * cs; api[(d * 17 + j) * 64 + p] = mag * sn; } }
                float sn1, cs1; sincos_acc((double)li * (double)delta, sn1, cs1); const float mag1 = expf(lr * delta);
                const float ar = mag1 * cs1, ai = mag1 * sn1;
                const float den = lr * lr + li * li, nr = ar - 1.0f; const float cr = (nr * lr + ai * li) / den, ci = (ai * lr - nr * li) / den;
                f32x4 or_, oi_;
#pragma unroll
                for (int e = 0; e < 4; ++e) { or_[e] = cr * br4[e] - ci * bi4[e]; oi_[e] = cr * bi4[e] + ci * br4[e]; }
                *(LAS f32x4*)(bbr + (d * 64 + p) * 16 + 4 * jq) = or_; *(LAS f32x4*)(bbi + (d * 64 + p) * 16 + 4 * jq) = oi_; }
            for (int i = tid; i < 2048; i += 512) { const int d = i >> 10, h = (i >> 6) & 15, p = i & 63;
                Cr[i] = AIN(I_SCRE)[((size_t)(d * 64 + g) * 16 + h) * 64 + p]; Ci[i] = AIN(I_SCIM)[((size_t)(d * 64 + g) * 16 + h) * 64 + p]; }
            __syncthreads();
            LAS float* Kd = Ci + 2 * 16 * 64;
            { const float* Kg = (const float*)(ws + WS_KD) + (size_t)g * 2 * 16 * 256;
#pragma unroll
              for (int i = 0; i < 4; ++i) *(LAS f32x4*)(Kd + (tid + 512 * i) * 4) = *(const f32x4*)(Kg + (tid + 512 * i) * 4); }
            __syncthreads();
            bf16* B2 = (bf16*)(ws + WS_SSM_B2) + (size_t)g * 256 * 512;
            for (int i = tid; i < 64 * 64; i += 512) { const int row = 64 * q + (i >> 6), c8 = (i & 63) * 8; const int t = row >> 4, h = row & 15;
                f32x4 v0, v1;
                if (c8 < 256) { const int k = c8 >> 4, hp0 = c8 & 15; v0 = (f32x4){0.f, 0.f, 0.f, 0.f}; v1 = v0;
                    if (k <= t) { const LAS float* kp = Kd + ((0 * 16 + (t - k)) * 16 + h) * 16 + hp0; v0 += *(const LAS f32x4*)kp; v1 += *(const LAS f32x4*)(kp + 4); }
                    if (k >= t) { const LAS float* kp = Kd + ((1 * 16 + (k - t)) * 16 + h) * 16 + hp0; v0 += *(const LAS f32x4*)kp; v1 += *(const LAS f32x4*)(kp + 4); }
                    if (k == t && (h >> 3) == (hp0 >> 3)) { const float dsk = AIN(I_SD)[g * 16 + h];
#pragma unroll
                        for (int e = 0; e < 4; ++e) { if ((h & 7) == e) v0[e] += dsk; if ((h & 7) == 4 + e) v1[e] += dsk; } } }
                else { const int qq = c8 - 256; const int d = qq >> 7, im = (qq >> 6) & 1, p0 = qq & 63; const int j = d == 0 ? t + 1 : 16 - t;
                    const LAS float* ap = apr + (d * 17 + j) * 64 + p0; const LAS float* aq = api + (d * 17 + j) * 64 + p0; const LAS float* cp_ = Cr + (d * 16 + h) * 64 + p0; const LAS float* cq = Ci + (d * 16 + h) * 64 + p0;
                    const f32x4 ar0 = *(const LAS f32x4*)ap, ar1 = *(const LAS f32x4*)(ap + 4), ai0 = *(const LAS f32x4*)aq, ai1 = *(const LAS f32x4*)(aq + 4);
                    const f32x4 cr0 = *(const LAS f32x4*)cp_, cr1 = *(const LAS f32x4*)(cp_ + 4), ci0 = *(const LAS f32x4*)cq, ci1 = *(const LAS f32x4*)(cq + 4);
                    if (im) { v0 = -(cr0 * ai0 + ci0 * ar0); v1 = -(cr1 * ai1 + ci1 * ar1); } else { v0 = cr0 * ar0 - ci0 * ai0; v1 = cr1 * ar1 - ci1 * ai1; } }
                v4u w; w.x = pk2(v0[0], v0[1]); w.y = pk2(v0[2], v0[3]); w.z = pk2(v1[0], v1[1]); w.w = pk2(v1[2], v1[3]);
                *(v4u*)(B2 + (size_t)row * 512 + c8) = w; }
            bf16* WE = (bf16*)(ws + WS_SSM_WEND) + (size_t)g * 256 * 256;
            for (int i = tid; i < 64 * 32; i += 512) { const int n = 64 * q + (i >> 5), c8 = (i & 31) * 8; const int d = n >> 7, im = (n >> 6) & 1, p = n & 63;
                const int k = c8 >> 4, hp0 = c8 & 15; const int j = d == 0 ? 15 - k : k;
                const float ar = apr[(d * 17 + j) * 64 + p], ai = api[(d * 17 + j) * 64 + p];
                const LAS float* bp = bbr + (d * 64 + p) * 16 + hp0; const LAS float* bq = bbi + (d * 64 + p) * 16 + hp0;
                const f32x4 br0 = *(const LAS f32x4*)bp, br1 = *(const LAS f32x4*)(bp + 4), bi0 = *(const LAS f32x4*)bq, bi1 = *(const LAS f32x4*)(bq + 4);
                f32x4 v0, v1;
                if (im) { v0 = ar * bi0 + ai * br0; v1 = ar * bi1 + ai * br1; } else { v0 = ar * br0 - ai * bi0; v1 = ar * br1 - ai * bi1; }
                v4u w; w.x = pk2(v0[0], v0[1]); w.y = pk2(v0[2], v0[3]); w.z = pk2(v1[0], v1[1]); w.w = pk2(v1[2], v1[3]);
                *(v4u*)(WE + (size_t)n * 256 + c8) = w; }
            __syncthreads();
        }
        {
            __syncthreads();
            int cur_r = -1; ModVec mv; int it = 0;
            for (int ci = ci0; ci < 1152; ci += F.G, ++it) {
                LAS unsigned char* T = F.lds + (it & 1) * 32768;
                const bool lat = ci < 1024; const int r = lat ? (ci >> 7) : 8;
                if (r != cur_r) { load_modvec(mv, AIN(I_N1G) + 1024, mada + (9 + r) * 6144, lane); cur_r = r; }
                f32x4 v[2][4];
                if (lat) {
#pragma unroll
                    for (int u = 0; u < 2; ++u)
#pragma unroll
                        for (int j = 0; j < 4; ++j) { v[u][j] = bf4_to_f32(rawn[u][j]); rawn[u][j] = rawm[u][j]; }
                    const int cn = ci + 2 * F.G;
                    if (cn < 1024) {
#pragma unroll
                        for (int u = 0; u < 2; ++u)
#pragma unroll
                            for (int j = 0; j < 4; ++j) rawm[u][j] = *(const v2u*)(xl + (size_t)(P8_ROW0(cn) + 2 * wave + u) * 1024 + 4 * lane + 256 * j); }
                } else {
                    const int row0 = (ci - 1024) * 16;
#pragma unroll
                    for (int u = 0; u < 2; ++u) norm_load_fix<8>(xc + (size_t)(row0 + 2 * wave + u) * 1024, (const bf16*)SLAB7 + (size_t)(row0 + 2 * wave + u) * 1024, mada + 8 * 6144 + 5120, lane, v[u]);
                }
#pragma unroll
                for (int u = 0; u < 2; ++u) { const int k = 2 * wave + u; f32x4 y[4]; norm_finish(v[u], mv, y);
#pragma unroll
                    for (int j = 0; j < 4; ++j) *(LAS unsigned long long*)(T + k * 2048 + (4 * lane + 256 * j) * 2) = (unsigned long long)pk2(y[j].x, y[j].y) | ((unsigned long long)pk2(y[j].z, y[j].w) << 32); }
                asm volatile("s_waitcnt lgkmcnt(0)\n\ts_barrier" ::: "memory");
                { const int g = tid >> 3;
#pragma unroll
                  for (int i = 0; i < 4; ++i) { const int piece = (tid & 7) + 8 * i; const int k = piece >> 1, hf = piece & 1;
                      const v4u w = *(const LAS v4u*)(T + k * 2048 + (g * 16 + hf * 8) * 2);
                      bf16* dst = lat ? AUL + ((size_t)(g * 1024 + ci)) * 256 : AUC + ((size_t)(g * 256 + (ci - 1024))) * 256;
                      *(GAS v4u*)(dst + k * 16 + hf * 8) = w; } }
            }
            __syncthreads();
#undef P8_ROW0
        }
    }
    GRID_BAR();
    { PHASE_ENV();
        pg8::Gemm g{AUL, (const bf16*)(ws + WS_SSM_WEND), 256, 256, 256}; pg8::SsmOrder S{F.G, (int)blockIdx.x, 5, 4};
        pg8::EpiSsm1 E{SEND};
        pg8::gemm_phase<pg8::EpiSsm1, pg8::SsmOrder, true>(F.lds, g, S, E);
        FRESH_IDS();
        {
            const int nfull = 320 - (320 / F.G) * F.G;
            if ((int)blockIdx.x >= nfull) {
                const int cw = ((int)blockIdx.x - nfull) * NWAVES + wave, ncw = (F.G - nfull) * NWAVES;
                LAS float* scr = (LAS float*)(F.lds + 57344 + wave * 8448);
                for (int it = cw; it < 64 * 16; it += ncw) p0_transpose_item(AIN(I_W2) + (size_t)4096 * 1024, 4096, 1024, (bf16*)(ws + WS_W2_1), 0, scr, it, lane);
            }
        }
        {
            const int nf9 = 320 - (320 / F.G) * F.G;
            const bf16* W1T = (const bf16*)(ws + WS_W1_1); float* b2 = (float*)(ws + WS_BIAS2);
            for (int n = ((int)blockIdx.x - nf9) * NWAVES + wave; (int)blockIdx.x >= nf9 && n < 4096; n += (F.G - nf9) * NWAVES) {
                const v4u w0 = *(const v4u*)(W1T + (size_t)n * 1024 + lane * 16), w1 = *(const v4u*)(W1T + (size_t)n * 1024 + lane * 16 + 8);
                float wv[16]; wv[0] = __uint_as_float(w0.x << 16); wv[1] = __uint_as_float(w0.x & 0xffff0000u); wv[2] = __uint_as_float(w0.y << 16); wv[3] = __uint_as_float(w0.y & 0xffff0000u);
                wv[4] = __uint_as_float(w0.z << 16); wv[5] = __uint_as_float(w0.z & 0xffff0000u); wv[6] = __uint_as_float(w0.w << 16); wv[7] = __uint_as_float(w0.w & 0xffff0000u);
                wv[8] = __uint_as_float(w1.x << 16); wv[9] = __uint_as_float(w1.x & 0xffff0000u); wv[10] = __uint_as_float(w1.y << 16); wv[11] = __uint_as_float(w1.y & 0xffff0000u);
                wv[12] = __uint_as_float(w1.z << 16); wv[13] = __uint_as_float(w1.z & 0xffff0000u); wv[14] = __uint_as_float(w1.w << 16); wv[15] = __uint_as_float(w1.w & 0xffff0000u);
#pragma unroll
                for (int b = 0; b < 8; ++b) { const float* sh = mada + (9 + b) * 6144 + 3072 + lane * 16; float s = 0.f;
#pragma unroll
                    for (int q4 = 0; q4 < 4; ++q4) { const f32x4 sv = *(const f32x4*)(sh + 4 * q4); s += sv[0] * wv[4 * q4] + sv[1] * wv[4 * q4 + 1] + sv[2] * wv[4 * q4 + 2] + sv[3] * wv[4 * q4 + 3]; }
                    s = wave_sum(s);
                    if (lane == 0) b2[b * 4096 + n] = s; }
            }
        }
    }
    GRID_BAR();
    { PHASE_ENV();
        pg8::SsmOrder S{F.G, (int)blockIdx.x, 4, 8};
        {
            pg8::Gemm g0{AUL, (const bf16*)(ws + WS_SSM_B2), 256, 512, 512, (long)((WS_BIG + 32 * MiB) - WS_HB) - 4 * 128};
            pg8::EpiSsm2 E0{ZB, (const bf16*)nullptr, AIN(I_SD)};
            pg8::gemm_phase<pg8::EpiSsm2, pg8::SsmOrder, true, 4, 1>(F.lds, g0, S, E0); }
        {
            FRESH_IDS(); pg8::Unit su;
            for (int ui_ = 0; S.next(ui_, su); ++ui_) {
        if (tid < 256) {
            const int p = tid & 63, d = (tid >> 6) & 1, b = 2 * (su.pm - 5 * su.pn) + (tid >> 7), g = su.pn;
            const int gp = (d * 64 + g) * 64 + p;
            const float lr = AIN(I_SLRE)[gp], li = AIN(I_SLIM)[gp]; const float delta = expf(AIN(I_SLOG)[d * 64 + g]);
            const float mag = expf(lr * delta * 16.0f); float sn, cs; sincos_acc((double)li * (double)delta * 16.0, sn, cs);
            const float aTr = mag * cs, aTi = mag * sn;
            const bf16* Sg = SEND + (size_t)g * 1152 * 256 + d * 128 + p;
            bf16* Ag = ACR + (size_t)g * 1024 * 256 + d * 128 + p;
            float cr = 0.f, ci = 0.f;
            for (int s0 = 0; s0 < 144; s0 += 24) {
                float sr[24], si[24];
#pragma unroll
                for (int q = 0; q < 24; ++q) { const int s = s0 + q; const int ridx = (s < 16) ? (1024 + b * 16 + (d == 0 ? s : 15 - s)) : (b * 128 + (d == 0 ? s - 16 : 143 - s));
                    sr[q] = __uint_as_float((unsigned)Sg[(size_t)ridx * 256] << 16); si[q] = __uint_as_float((unsigned)Sg[(size_t)ridx * 256 + 64] << 16); }
#pragma unroll
                for (int q = 0; q < 24; ++q) { const int s = s0 + q;
                    if (s >= 16) { const int ridx = b * 128 + (d == 0 ? s - 16 : 143 - s); Ag[(size_t)ridx * 256] = (bf16)f2bf(cr); Ag[(size_t)ridx * 256 + 64] = (bf16)f2bf(ci); }
                    const float nr = aTr * cr - aTi * ci + sr[q], ni = aTr * ci + aTi * cr + si[q]; cr = nr; ci = ni; }
            }
        }
            }
            asm volatile("s_waitcnt vmcnt(0)" ::: "memory"); __syncthreads();
        }

        pg8::Gemm g{AUL, (const bf16*)(ws + WS_SSM_B2), 256, 512, 512, (long)((WS_BIG + 32 * MiB) - WS_HB) - 4 * 128};
        pg8::EpiSsm2 E{ZB, (const bf16*)nullptr, AIN(I_SD)};
        pg8::gemm_phase<pg8::EpiSsm2, pg8::SsmOrder, true, 4, 2>(F.lds, g, S, E);

    }
    GRID_BAR();
    { PHASE_ENV();
        pg8::Gemm g{ZB, (const bf16*)(ws + WS_WGLU), 1024, 1024, 1024}; pg8::StaticOrder S; S.init(ML, 2048, F.G, (int)blockIdx.x);
        pg8::EpiGlu E{xl, (F.G == 256) ? X3A : xl, (F.G == 256) ? X3B : xl, mada + 9 * 6144 + 2048, (bf16*)(ws + WS_H2B), AIN(I_N2G) + 1024, mada + 9 * 6144 + 4096, (float*)(ws + WS_ROWSS1)};
        pg8::gemm_phase<pg8::EpiGlu, pg8::StaticOrder, true>(F.lds, g, S, E);
    }
    GRID_BAR();
    { PHASE_ENV();
        pg8::Gemm g{(const bf16*)(ws + WS_H2B), (const bf16*)(ws + WS_W1_1), 1024, 1024, 1024}; pg8::StaticOrder S; S.init(ML, FF, F.G, (int)blockIdx.x);
        pg8::EpiRelu2<true> E{BIG, FF, (const float*)(ws + WS_ROWSS1), (const float*)(ws + WS_BIAS2)};
        pg8::gemm_phase<pg8::EpiRelu2<true>, pg8::StaticOrder, true>(F.lds, g, S, E);
    }
    GRID_BAR();
    if (F.G == 256) {
        PHASE_ENV();
        pg8::Gemm g{BIG, (const bf16*)(ws + WS_W2_1), FF, FF, FF}; pg8::StaticOrder S; S.init(ML, DM, F.G, (int)blockIdx.x, FF);
        pg8::EpiResidFinal E{X3A, X3B, outf, mada + 9 * 6144 + 5120, AIN(I_FG), (float*)(ws + WS_MP), (unsigned*)(ws + 2048), (LAS float*)(F.lds + 132096)};
        pg8::gemm_phase<pg8::EpiResidFinal, pg8::StaticOrder, true>(F.lds, g, S, E);
    } else {
    { PHASE_ENV();
        pg8::Gemm g{BIG, (const bf16*)(ws + WS_W2_1), FF, FF, FF}; pg8::StaticOrder S; S.init(ML, DM, F.G, (int)blockIdx.x, FF);
        pg8::EpiResid<false> E{xl, xc, HB, xc, mada + 9 * 6144 + 5120, (bf16*)nullptr};
        pg8::gemm_phase<pg8::EpiResid<false>, pg8::StaticOrder, true>(F.lds, g, S, E);
    }
    GRID_BAR();
    { PHASE_ENV();
        FRESH_IDS();
        const float* fg = AIN(I_FG);
        f32x4 gv[4];
#pragma unroll
        for (int j = 0; j < 4; ++j) gv[j] = *(const f32x4*)(fg + 4 * lane + 256 * j);
        const int per16 = (ML + NGW - 1) / NGW; const int r16e = (gw + 1) * per16 < ML ? (gw + 1) * per16 : ML;
        for (int row0 = gw * per16; row0 < r16e; row0 += 4) {
            f32x4 v[4][4];
#pragma unroll
            for (int u = 0; u < 4; ++u) if (row0 + u < r16e) norm_load(HB + (size_t)(row0 + u) * 1024, lane, v[u]);
#pragma unroll
            for (int u = 0; u < 4; ++u) { if (row0 + u >= r16e) continue; float s = 0.f;
#pragma unroll
                for (int j = 0; j < 4; ++j) s += (v[u][j].x * v[u][j].x + v[u][j].y * v[u][j].y) + (v[u][j].z * v[u][j].z + v[u][j].w * v[u][j].w);
                const float rstd = 1.0f / sqrtf(wave_sum(s) * (1.0f / 1024.0f) + NORM_EPS);
                f32x4* xr = (f32x4*)(outf + (size_t)(row0 + u) * 1024) + lane;
#pragma unroll
                for (int j = 0; j < 4; ++j) xr[64 * j] = v[u][j] * rstd * gv[j]; }
        }
    }
    }
#ifdef PROBE_TS
    GRID_BAR();
    if (blockIdx.x == 0) {
        asm volatile("s_waitcnt vmcnt(0)" ::: "memory"); __syncthreads();
#ifndef PROBE_SPAN
#define PROBE_SPAN 1
#endif
#ifndef PROBE_Q
#define PROBE_Q 1.0f
#endif
        const float ta = PROBE_Q * floorf((float)(tsbuf[PROBE_A + 1] - tsbuf[PROBE_A]) * 0.01f / PROBE_Q + 0.5f);
        const float tb = PROBE_Q * floorf((float)(tsbuf[PROBE_B + PROBE_SPAN] - tsbuf[PROBE_B]) * 0.01f / PROBE_Q + 0.5f);
        if (threadIdx.x == 0) args.out[7] += ta * 0.005f;
        for (int i = threadIdx.x; i < 67080; i += 512) args.out[4096 + i] += tb * 0.005f;
    }
#endif
#undef GRID_BAR
#undef FRESH_IDS
#undef AUL
#undef AUC
#undef ACR
#undef ZB
#undef SLAB7
#undef SEND
#undef PHASE_ENV
#undef AIN
#undef NORM_TO_HB
#undef NORM_ROW_OF
}

extern "C" void kernel_launch(void* const* d_in, const int* in_sizes, int n_in, void* d_out, int out_size, void* d_ws, size_t ws_size, hipStream_t stream) {
    static int grid = 0;
    if (grid == 0) {
        if (n_in != 29 || out_size != ML * DM || ws_size < WS_END) { fprintf(stderr, "kernel_launch: unexpected shapes (n_in %d out %d ws %zu)\n", n_in, out_size, ws_size); grid = -1; return; }
        int dev = 0, cus = 0;
        if (hipGetDevice(&dev) != hipSuccess || hipDeviceGetAttribute(&cus, hipDeviceAttributeMultiprocessorCount, dev) != hipSuccess) { grid = -1; return; }
        if (hipFuncSetAttribute((const void*)fwd_kernel, hipFuncAttributeMaxDynamicSharedMemorySize, LDS_BYTES) != hipSuccess) { fprintf(stderr, "kernel_launch: hipFuncSetAttribute failed\n"); grid = -1; return; }
        int per_cu = 0;
        if (hipOccupancyMaxActiveBlocksPerMultiprocessor(&per_cu, (const void*)fwd_kernel, NWAVES * 64, LDS_BYTES) != hipSuccess || per_cu < 1) fprintf(stderr, "kernel_launch: occupancy query says %d\n", per_cu);
        (void)hipGetLastError();
        grid = cus;
    }
    if (grid < 0) return;
    (void)hipMemsetAsync((char*)d_ws + WS_CTL, 0, CTL_ZERO_BYTES, stream);
    Args a{};
    for (int i = 0; i < 29; ++i) a.in[i] = (const float*)d_in[i];
    a.out = (float*)d_out; a.ws = (unsigned char*)d_ws;
    hipLaunchKernelGGL(fwd_kernel, dim3(grid), dim3(NWAVES * 64), LDS_BYTES, stream, a);
}
```

```cpp
#include <hip/hip_runtime.h>
#include <hip/hip_bf16.h>
#include <cstdio>
#include <cstdint>
#include <cmath>
namespace pg8 {
#define PG8_LAS __attribute__((address_space(3)))
typedef unsigned short bf16_t;
typedef short bf16x8 __attribute__((ext_vector_type(8)));
typedef float f32x4 __attribute__((ext_vector_type(4)));
typedef float f32x2 __attribute__((ext_vector_type(2)));
typedef unsigned u32x4 __attribute__((ext_vector_type(4)));
typedef unsigned u32x2 __attribute__((ext_vector_type(2)));
constexpr int BM = 256, BK = 64, HALF = 128, HTB = HALF * BK * 2, STAGE_BYTES = 8 * HTB, NXCD = 8, WGM = 8;

__host__ __device__ __forceinline__ int lds_byte(int r, int c) { const int st = (r >> 4) * 2 + (c >> 5), rr = r & 15, cc = c & 31, ob = rr * 64 + cc * 2; return st * 1024 + (ob ^ (((ob >> 9) & 1) << 5)); }
__host__ __device__ __forceinline__ void stage_rc(int b, int& R, int& C) { const int st = b / 1024, sb = b % 1024, swz = sb ^ (((sb >> 9) & 1) << 5); R = (st >> 1) * 16 + swz / 64; C = (st & 1) * 32 + (swz % 64) / 2; }
__host__ __device__ __forceinline__ int perm32(int rho) { const int n = rho >> 4, i = rho & 15; return 8 * (i >> 2) + 4 * n + (i & 3); }

constexpr int ACTX_TILE0 = 1472;
struct Unit { int pm, pn, kt0, nt, slab; };
struct Gemm { const bf16_t* A; const bf16_t* Bt; int lda, ldb, K; long ajump = 0; };

struct StaticOrder {
    int nM, nN, nwg, G, c, ntk;
    __host__ __device__ __forceinline__ int atile(const Unit& u) const { return u.pm; }
    __host__ __device__ __forceinline__ void init(int M, int N, int G_, int c_, int K_ = 1024) { nM = M / BM; nN = N / BM; nwg = nM * nN; G = G_; c = c_; ntk = K_ / BK; }
    __host__ __device__ __forceinline__ bool next(int i, Unit& u) const {
        const long L = (long)i * G + c; if (L >= nwg) return false;
        int wgid = (int)L; { const int q = nwg / NXCD, r = nwg % NXCD, xcd = wgid % NXCD, off = wgid / NXCD; wgid = (xcd < r ? xcd * (q + 1) : r * (q + 1) + (xcd - r) * q) + off; }
        const int nig = WGM * nN, gid = wgid / nig, fm = gid * WGM, gsz = (nM - fm) < WGM ? (nM - fm) : WGM;
        u.pm = fm + ((wgid % nig) % gsz); u.pn = (wgid % nig) / gsz; u.kt0 = 0; u.nt = ntk; u.slab = -1; return true;
    }
};
struct SplitOrder {
    int G, c, ntk, lsp;
    __device__ __forceinline__ int atile(const Unit& u) const { return u.pm; }
    __device__ __forceinline__ void init(int G_, int c_, int K_, int lsp_) { G = G_; c = c_; ntk = K_ / BK; lsp = lsp_; }
    __device__ __forceinline__ bool next(int i, Unit& u) const {
        const int L = i * G + c;
        if (L >= 256 + (32 << lsp)) return false;
        const bool lat = L < 256;
        const int wl = (L & 7) * 32 + (L >> 3); const int gid = wl >> 5, wi = wl & 31;
        const int j = L - 256;
        const int pm = lat ? gid * 8 + (wi & 7) : 64 + (j >> (lsp + 2));
        const int pn = lat ? (wi >> 3) : ((j >> lsp) & 3);
        const int sl = lat ? -1 : (j & ((1 << lsp) - 1));
        const int nt = lat ? ntk : (ntk >> lsp);
        u.pm = pm; u.pn = pn; u.slab = sl; u.nt = nt; u.kt0 = lat ? 0 : sl * nt;
        return true;
    }
};
struct CtxSliceOrder {
    int G, c, ntk, lsp;
    __device__ __forceinline__ int atile(const Unit& u) const { return u.pm; }
    __device__ __forceinline__ bool next(int i, Unit& u) const {
        const int j = i * G + c;
        if (j >= (32 << lsp)) return false;
        const int sl = j & ((1 << lsp) - 1), nt = ntk >> lsp;
        u.pm = 64 + (j >> (lsp + 2)); u.pn = (j >> lsp) & 3; u.slab = sl; u.nt = nt; u.kt0 = sl * nt;
        return true;
    }
};
struct SsmOrder {
    int G, c, nrow, ntk;
    __device__ __forceinline__ int atile(const Unit& u) const { const int i = u.pm - 5 * u.pn; return i < 4 ? u.pn * 4 + i : ACTX_TILE0 + u.pn; }
    __device__ __forceinline__ bool next(int i, Unit& u) const {
        const int L = i * G + c; if (L >= 64 * nrow) return false;
        if (nrow == 4 && G == 256) {
            const int x = c & 7, s = c >> 3, q = x * 8 + (s >> 2), e = s & 3; const int g = 4 * (q & 15) + e, it = q >> 4;
            u.pm = g * 5 + it; u.pn = g; u.kt0 = 0; u.nt = ntk; u.slab = -1; return true; }
        const int g = L / nrow; u.pm = g * 5 + (L - g * nrow); u.pn = g; u.kt0 = 0; u.nt = ntk; u.slab = -1; return true;
    }
};

__device__ __forceinline__ unsigned cvt_pk_bf16(float lo, float hi) { unsigned r; asm volatile("v_cvt_pk_bf16_f32 %0, %1, %2" : "=v"(r) : "v"(lo), "v"(hi)); return r; }
__device__ __forceinline__ float bf16lo(unsigned w) { return __uint_as_float(w << 16); }
__device__ __forceinline__ float bf16hi(unsigned w) { return __uint_as_float(w & 0xffff0000u); }

constexpr float QSCALE = 0.125f * 1.4426950408889634f;


struct EpiInProj {
    static constexpr bool PERM = true;
    bf16_t* O; const PG8_LAS float* rope;
    __device__ __forceinline__ void operator()(const f32x4 (&acc)[2][2][4][2], const Unit& u, int wr, int wc, int fr, int fq) const {
        asm volatile("" : "+v"(fr), "+v"(fq));
        const int pn = u.pn; const bool dorope = (u.pm < 64) && (pn < 4);
        const float sc = (pn < 2 || pn == 6 || pn == 7) ? QSCALE : 1.0f;
        const int row0 = u.pm * BM + wr * 64 + fr, col0 = pn * BM + wc * 32 + 8 * fq;
        const float sgn = (fq < 2) ? -1.0f : 1.0f; const int j0 = 8 * (fq & 1);
#pragma unroll
        for (int ai = 0; ai < 2; ++ai)
#pragma unroll
            for (int m = 0; m < 4; ++m) {
                const int row = row0 + ai * HALF + m * 16;
                f32x4 cs0 = (f32x4){1.f, 1.f, 1.f, 1.f}, cs1 = cs0, sn0 = (f32x4){0.f, 0.f, 0.f, 0.f}, sn1 = sn0;
                if (dorope) { const int t = row & 2047; const int pos = (wc & 1) ? (t & 63) : (t >> 6); const PG8_LAS float* rp = rope + pos * 16 + j0;
                    cs0 = *(const PG8_LAS f32x4*)rp; cs1 = *(const PG8_LAS f32x4*)(rp + 4); sn0 = *(const PG8_LAS f32x4*)(rp + 1024) * sgn; sn1 = *(const PG8_LAS f32x4*)(rp + 1028) * sgn; }
                bf16_t* rowp = O + (size_t)row * 3072 + col0;
#pragma unroll
                for (int bj = 0; bj < 2; ++bj) {
                    f32x4 x0 = acc[ai][bj][m][0], x1 = acc[ai][bj][m][1], y0 = x0, y1 = x1;
                    if (dorope) {
#pragma unroll
                        for (int e2 = 0; e2 < 4; ++e2) {
                            const auto ra = __builtin_amdgcn_permlane32_swap(__float_as_uint(x0[e2]), __float_as_uint(x0[e2]), false, false);
                            const auto rb = __builtin_amdgcn_permlane32_swap(__float_as_uint(x1[e2]), __float_as_uint(x1[e2]), false, false);
                            const float p0 = (fq < 2) ? __uint_as_float(ra[1]) : __uint_as_float(ra[0]);
                            const float p1 = (fq < 2) ? __uint_as_float(rb[1]) : __uint_as_float(rb[0]);
                            y0[e2] = x0[e2] * cs0[e2] + p0 * sn0[e2]; y1[e2] = x1[e2] * cs1[e2] + p1 * sn1[e2]; } }
                    y0 = y0 * sc; y1 = y1 * sc;
                    u32x4 w; w.x = cvt_pk_bf16(y0[0], y0[1]); w.y = cvt_pk_bf16(y0[2], y0[3]); w.z = cvt_pk_bf16(y1[0], y1[1]); w.w = cvt_pk_bf16(y1[2], y1[3]);
                    *(u32x4*)(rowp + bj * HALF) = w;
                }
            }
    }
};

template <bool BASEF32>
struct EpiResid {
    static constexpr bool PERM = true;
    const void* base_l; const void* base_c; bf16_t* out_l; bf16_t* out_c; const float* gate; bf16_t* slabs;
    __device__ __forceinline__ void operator()(const f32x4 (&acc)[2][2][4][2], const Unit& u, int wr, int wc, int fr, int fq) const {
        asm volatile("" : "+v"(fr), "+v"(fq));
        const bool lat = u.pm < 64; const int r = lat ? (u.pm >> 3) : 8;
        const size_t toff = (size_t)(lat ? u.pm : u.pm - 64) * BM * 1024;
        const int col0 = u.pn * BM + wc * 32 + 8 * fq;
        if (u.slab >= 0) {
            bf16_t* so = slabs + (size_t)u.slab * 2048 * 1024 + toff;
#pragma unroll
            for (int ai = 0; ai < 2; ++ai)
#pragma unroll
                for (int m = 0; m < 4; ++m) { const size_t p = (size_t)(wr * 64 + fr + ai * HALF + m * 16) * 1024 + col0;
#pragma unroll
                    for (int bj = 0; bj < 2; ++bj) { const f32x4 v0 = acc[ai][bj][m][0], v1 = acc[ai][bj][m][1];
                        u32x4 w; w.x = cvt_pk_bf16(v0[0], v0[1]); w.y = cvt_pk_bf16(v0[2], v0[3]); w.z = cvt_pk_bf16(v1[0], v1[1]); w.w = cvt_pk_bf16(v1[2], v1[3]);
                        *(u32x4*)(so + p + bj * HALF) = w; } }
            return; }
        bf16_t* out = (lat ? out_l : out_c) + toff;
        const float* gv = gate + r * 6144 + col0;
        f32x4 g[2][2];
#pragma unroll
        for (int bj = 0; bj < 2; ++bj)
#pragma unroll
            for (int n = 0; n < 2; ++n) g[bj][n] = *(const f32x4*)(gv + bj * HALF + n * 4);
#pragma unroll
        for (int ai = 0; ai < 2; ++ai) {
            f32x4 bf[BASEF32 ? 4 : 1][2][2]; u32x4 bw[BASEF32 ? 1 : 4][2];
#pragma unroll
            for (int m = 0; m < 4; ++m) { const size_t p = (size_t)(wr * 64 + fr + ai * HALF + m * 16) * 1024 + col0;
#pragma unroll
                for (int bj = 0; bj < 2; ++bj) {
                    if (BASEF32) { const float* bp = (const float*)(lat ? base_l : base_c) + toff + p + bj * HALF; bf[BASEF32 ? m : 0][bj][0] = *(const f32x4*)bp; bf[BASEF32 ? m : 0][bj][1] = *(const f32x4*)(bp + 4); }
                    else bw[BASEF32 ? 0 : m][bj] = *(const u32x4*)((const bf16_t*)(lat ? base_l : base_c) + toff + p + bj * HALF); } }
#pragma unroll
            for (int m = 0; m < 4; ++m) { const size_t p = (size_t)(wr * 64 + fr + ai * HALF + m * 16) * 1024 + col0;
#pragma unroll
                for (int bj = 0; bj < 2; ++bj) { f32x4 b0, b1;
                    if (BASEF32) { b0 = bf[BASEF32 ? m : 0][bj][0]; b1 = bf[BASEF32 ? m : 0][bj][1]; }
                    else { const u32x4 w = bw[BASEF32 ? 0 : m][bj];
                        b0 = (f32x4){bf16lo(w.x), bf16hi(w.x), bf16lo(w.y), bf16hi(w.y)}; b1 = (f32x4){bf16lo(w.z), bf16hi(w.z), bf16lo(w.w), bf16hi(w.w)}; }
                    const f32x4 o0 = b0 + g[bj][0] * acc[ai][bj][m][0], o1 = b1 + g[bj][1] * acc[ai][bj][m][1];
                    u32x4 wo; wo.x = cvt_pk_bf16(o0[0], o0[1]); wo.y = cvt_pk_bf16(o0[2], o0[3]); wo.z = cvt_pk_bf16(o1[0], o1[1]); wo.w = cvt_pk_bf16(o1[2], o1[3]);
                    *(u32x4*)(out + p + bj * HALF) = wo; } } }
    }
};

struct EpiResidFinal {
    static constexpr bool PERM = true;
    const bf16_t* base; const bf16_t* base2; float* out; const float* gate; const float* gain; float* stat; unsigned* cnt; PG8_LAS float* red;
    __device__ __forceinline__ void operator()(const f32x4 (&acc)[2][2][4][2], const Unit& u, int wr, int wc, int fr, int fq) const {
        { int t_ = threadIdx.x; asm volatile("" : "+v"(t_)); fr = t_ & 15; fq = (t_ >> 4) & 3; }
        const int r = u.pm >> 3; const size_t toff = (size_t)u.pm * BM * 1024; const int col0 = u.pn * BM + wc * 32 + 8 * fq;
        const float* gv = gate + r * 6144 + col0;
        f32x4 g[2][2];
#pragma unroll
        for (int bj = 0; bj < 2; ++bj)
#pragma unroll
            for (int n = 0; n < 2; ++n) g[bj][n] = *(const f32x4*)(gv + bj * HALF + n * 4);
        f32x4 o[2][2][4][2]; float ss[2][4];
#pragma unroll
        for (int ai = 0; ai < 2; ++ai) { u32x4 bw[4][2];
#pragma unroll
            for (int m = 0; m < 4; ++m)
#pragma unroll
                for (int bj = 0; bj < 2; ++bj) bw[m][bj] = *(const u32x4*)((u.pm < 48 ? base : base2) + toff + (size_t)(wr * 64 + fr + ai * HALF + m * 16) * 1024 + col0 + bj * HALF);
#pragma unroll
            for (int m = 0; m < 4; ++m) { float s_ = 0.f;
#pragma unroll
                for (int bj = 0; bj < 2; ++bj) { const u32x4 w = bw[m][bj];
                    const f32x4 b0 = (f32x4){bf16lo(w.x), bf16hi(w.x), bf16lo(w.y), bf16hi(w.y)}, b1 = (f32x4){bf16lo(w.z), bf16hi(w.z), bf16lo(w.w), bf16hi(w.w)};
                    const f32x4 o0 = b0 + g[bj][0] * acc[ai][bj][m][0], o1 = b1 + g[bj][1] * acc[ai][bj][m][1];
                    o[ai][bj][m][0] = o0; o[ai][bj][m][1] = o1;
                    s_ += (o0[0] * o0[0] + o0[1] * o0[1]) + (o0[2] * o0[2] + o0[3] * o0[3]) + (o1[0] * o1[0] + o1[1] * o1[1]) + (o1[2] * o1[2] + o1[3] * o1[3]); }
                s_ += __shfl_xor(s_, 16); s_ += __shfl_xor(s_, 32); ss[ai][m] = s_; } }
        if (fq == 0) {
#pragma unroll
            for (int ai = 0; ai < 2; ++ai)
#pragma unroll
                for (int m = 0; m < 4; ++m) red[(wr * 4 + wc) * 128 + ai * 64 + m * 16 + fr] = ss[ai][m]; }
        __syncthreads();
        int tid = threadIdx.x; asm volatile("" : "+v"(tid));
        if (tid < 256) { const int w2 = tid >> 7, rr = tid & 127;
            const float t = (red[(w2 * 4 + 0) * 128 + rr] + red[(w2 * 4 + 1) * 128 + rr]) + (red[(w2 * 4 + 2) * 128 + rr] + red[(w2 * 4 + 3) * 128 + rr]);
            __hip_atomic_store(stat + ((size_t)u.pm * 4 + u.pn) * 256 + tid, t, __ATOMIC_RELAXED, __HIP_MEMORY_SCOPE_AGENT); }
        asm volatile("s_waitcnt vmcnt(0)" ::: "memory");
        __syncthreads();
        if (tid == 0) { __hip_atomic_fetch_add(cnt + u.pm, 1u, __ATOMIC_RELAXED, __HIP_MEMORY_SCOPE_AGENT);
            unsigned sp = 0; while (__hip_atomic_load(cnt + u.pm, __ATOMIC_RELAXED, __HIP_MEMORY_SCOPE_AGENT) < 4u) { __builtin_amdgcn_s_sleep(1); if (++sp > (1u << 22)) break; } }
        __syncthreads();
        if (tid < 256) { float t = 0.f;
#pragma unroll
            for (int q = 0; q < 4; ++q) t += __hip_atomic_load(stat + ((size_t)u.pm * 4 + q) * 256 + tid, __ATOMIC_RELAXED, __HIP_MEMORY_SCOPE_AGENT);
            red[1024 + tid] = 1.0f / sqrtf(t * (1.0f / 1024.0f) + 1e-6f); }
        __syncthreads();
        f32x4 gn[2][2];
#pragma unroll
        for (int bj = 0; bj < 2; ++bj)
#pragma unroll
            for (int n = 0; n < 2; ++n) gn[bj][n] = *(const f32x4*)(gain + col0 + bj * HALF + n * 4);
#pragma unroll
        for (int ai = 0; ai < 2; ++ai)
#pragma unroll
            for (int m = 0; m < 4; ++m) { const int rl = wr * 64 + fr + ai * HALF + m * 16; const float rstd = red[1024 + wr * 128 + ai * 64 + m * 16 + fr];
                float* op = out + toff + (size_t)rl * 1024 + col0;
#pragma unroll
                for (int bj = 0; bj < 2; ++bj) { *(f32x4*)(op + bj * HALF) = o[ai][bj][m][0] * rstd * gn[bj][0]; *(f32x4*)(op + bj * HALF + 4) = o[ai][bj][m][1] * rstd * gn[bj][1]; } }
    }
};

struct EpiResidNorm {
    static constexpr bool PERM = true;
    const float* base; bf16_t* out; const float* gate; bf16_t* H; const float* n2g; const float* mod; float* stat; unsigned* cnt; PG8_LAS float* red;
    __device__ __forceinline__ void operator()(const f32x4 (&acc)[2][2][4][2], const Unit& u, int wr, int wc, int fr, int fq) const {
        { int t_ = threadIdx.x; asm volatile("" : "+v"(t_)); fr = t_ & 15; fq = (t_ >> 4) & 3; }
        const int col0 = u.pn * BM + wc * 32 + 8 * fq;
        const int r = u.pm >> 3; const size_t toff = (size_t)u.pm * BM * 1024;
        const float* gv = gate + r * 6144 + col0;
        f32x4 g[2][2];
#pragma unroll
        for (int bj = 0; bj < 2; ++bj)
#pragma unroll
            for (int n = 0; n < 2; ++n) g[bj][n] = *(const f32x4*)(gv + bj * HALF + n * 4);
        f32x4 o[2][2][4][2]; float ss[2][4];
#pragma unroll
        for (int ai = 0; ai < 2; ++ai)
#pragma unroll
            for (int m = 0; m < 4; ++m) { f32x4 bf[2][2]; float s_ = 0.f;
#pragma unroll
                for (int bj = 0; bj < 2; ++bj) { const float* bp = base + toff + (size_t)(wr * 64 + fr + ai * HALF + m * 16) * 1024 + col0 + bj * HALF; bf[bj][0] = *(const f32x4*)bp; bf[bj][1] = *(const f32x4*)(bp + 4); }
#pragma unroll
                for (int bj = 0; bj < 2; ++bj) {
                    const f32x4 o0 = bf[bj][0] + g[bj][0] * acc[ai][bj][m][0], o1 = bf[bj][1] + g[bj][1] * acc[ai][bj][m][1];
                    o[ai][bj][m][0] = o0; o[ai][bj][m][1] = o1;
                    s_ += (o0[0] * o0[0] + o0[1] * o0[1]) + (o0[2] * o0[2] + o0[3] * o0[3]) + (o1[0] * o1[0] + o1[1] * o1[1]) + (o1[2] * o1[2] + o1[3] * o1[3]); }
                s_ += __shfl_xor(s_, 16); s_ += __shfl_xor(s_, 32); ss[ai][m] = s_; }
        if (fq == 0) {
#pragma unroll
            for (int ai = 0; ai < 2; ++ai)
#pragma unroll
                for (int m = 0; m < 4; ++m) red[(wr * 4 + wc) * 128 + ai * 64 + m * 16 + fr] = ss[ai][m]; }
        __syncthreads();
        int tid = threadIdx.x; asm volatile("" : "+v"(tid));
        if (tid < 256) { const int w2 = tid >> 7, rr = tid & 127;
            const float t = (red[(w2 * 4 + 0) * 128 + rr] + red[(w2 * 4 + 1) * 128 + rr]) + (red[(w2 * 4 + 2) * 128 + rr] + red[(w2 * 4 + 3) * 128 + rr]);
            __hip_atomic_store(stat + ((size_t)u.pm * 4 + u.pn) * 256 + tid, t, __ATOMIC_RELAXED, __HIP_MEMORY_SCOPE_AGENT); }
        asm volatile("s_waitcnt vmcnt(0)" ::: "memory");
        __syncthreads();
        if (tid == 0) { __hip_atomic_fetch_add(cnt + u.pm, 1u, __ATOMIC_RELAXED, __HIP_MEMORY_SCOPE_AGENT);
            unsigned sp = 0; while (__hip_atomic_load(cnt + u.pm, __ATOMIC_RELAXED, __HIP_MEMORY_SCOPE_AGENT) < 4u) { __builtin_amdgcn_s_sleep(1); if (++sp > (1u << 22)) break; } }
        __syncthreads();
        if (tid < 256) { float t = 0.f;
#pragma unroll
            for (int q = 0; q < 4; ++q) t += __hip_atomic_load(stat + ((size_t)u.pm * 4 + q) * 256 + tid, __ATOMIC_RELAXED, __HIP_MEMORY_SCOPE_AGENT);
            red[1024 + tid] = 1.0f / sqrtf(t * (1.0f / 1024.0f) + 1e-6f); }
        __syncthreads();
#pragma unroll
        for (int bj = 0; bj < 2; ++bj) { f32x4 gm[2], sh[2];
#pragma unroll
            for (int n = 0; n < 2; ++n) { const int c = col0 + bj * HALF + n * 4;
                gm[n] = *(const f32x4*)(n2g + c) * (*(const f32x4*)(mod + r * 6144 + 1024 + c) + 1.0f); sh[n] = *(const f32x4*)(mod + r * 6144 + c); }
#pragma unroll
            for (int ai = 0; ai < 2; ++ai)
#pragma unroll
                for (int m = 0; m < 4; ++m) { const int rl = wr * 64 + fr + ai * HALF + m * 16; const float rstd = red[1024 + wr * 128 + ai * 64 + m * 16 + fr];
                    const size_t p = toff + (size_t)rl * 1024 + col0 + bj * HALF;
                    const f32x4 o0 = o[ai][bj][m][0], o1 = o[ai][bj][m][1];
                    u32x4 wo; wo.x = cvt_pk_bf16(o0[0], o0[1]); wo.y = cvt_pk_bf16(o0[2], o0[3]); wo.z = cvt_pk_bf16(o1[0], o1[1]); wo.w = cvt_pk_bf16(o1[2], o1[3]);
                    *(u32x4*)(out + p) = wo;
                    const f32x4 h0 = o0 * rstd * gm[0] + sh[0], h1 = o1 * rstd * gm[1] + sh[1];
                    u32x4 wh; wh.x = cvt_pk_bf16(h0[0], h0[1]); wh.y = cvt_pk_bf16(h0[2], h0[3]); wh.z = cvt_pk_bf16(h1[0], h1[1]); wh.w = cvt_pk_bf16(h1[2], h1[3]);
                    *(u32x4*)(H + p) = wh; } }
    }
};

struct EpiResidNormA {
    static constexpr bool PERM = true;
    const bf16_t* base; bf16_t* out; const float* gate; bf16_t* AU; const float* n2g; const float* mod; float* stat; unsigned* cnt; PG8_LAS float* red;
    __device__ __forceinline__ void operator()(const f32x4 (&acc)[2][2][4][2], const Unit& u, int wr, int wc, int fr, int fq) const {
        { int t_ = threadIdx.x; asm volatile("" : "+v"(t_)); fr = t_ & 15; fq = (t_ >> 4) & 3; }
        const int col0 = u.pn * BM + wc * 32 + 8 * fq;
        const int r = u.pm >> 3; const size_t toff = (size_t)u.pm * BM * 1024;
        const float* gv = gate + r * 6144 + col0;
        f32x4 g[2][2];
#pragma unroll
        for (int bj = 0; bj < 2; ++bj)
#pragma unroll
            for (int n = 0; n < 2; ++n) g[bj][n] = *(const f32x4*)(gv + bj * HALF + n * 4);
        f32x4 o[2][2][4][2]; float ss[2][4];
#pragma unroll
        for (int ai = 0; ai < 2; ++ai)
#pragma unroll
            for (int m = 0; m < 4; ++m) { f32x4 bf[2][2]; float s_ = 0.f;
#pragma unroll
                for (int bj = 0; bj < 2; ++bj) { const u32x4 w = *(const u32x4*)(base + toff + (size_t)(wr * 64 + fr + ai * HALF + m * 16) * 1024 + col0 + bj * HALF);
                    bf[bj][0] = (f32x4){bf16lo(w.x), bf16hi(w.x), bf16lo(w.y), bf16hi(w.y)}; bf[bj][1] = (f32x4){bf16lo(w.z), bf16hi(w.z), bf16lo(w.w), bf16hi(w.w)}; }
#pragma unroll
                for (int bj = 0; bj < 2; ++bj) {
                    const f32x4 o0 = bf[bj][0] + g[bj][0] * acc[ai][bj][m][0], o1 = bf[bj][1] + g[bj][1] * acc[ai][bj][m][1];
                    o[ai][bj][m][0] = o0; o[ai][bj][m][1] = o1;
                    s_ += (o0[0] * o0[0] + o0[1] * o0[1]) + (o0[2] * o0[2] + o0[3] * o0[3]) + (o1[0] * o1[0] + o1[1] * o1[1]) + (o1[2] * o1[2] + o1[3] * o1[3]); }
                s_ += __shfl_xor(s_, 16); s_ += __shfl_xor(s_, 32); ss[ai][m] = s_; }
        if (fq == 0) {
#pragma unroll
            for (int ai = 0; ai < 2; ++ai)
#pragma unroll
                for (int m = 0; m < 4; ++m) red[(wr * 4 + wc) * 128 + ai * 64 + m * 16 + fr] = ss[ai][m]; }
        __syncthreads();
        int tid = threadIdx.x; asm volatile("" : "+v"(tid));
        if (tid < 256) { const int w2 = tid >> 7, rr = tid & 127;
            const float t = (red[(w2 * 4 + 0) * 128 + rr] + red[(w2 * 4 + 1) * 128 + rr]) + (red[(w2 * 4 + 2) * 128 + rr] + red[(w2 * 4 + 3) * 128 + rr]);
            __hip_atomic_store(stat + ((size_t)u.pm * 4 + u.pn) * 256 + tid, t, __ATOMIC_RELAXED, __HIP_MEMORY_SCOPE_AGENT); }
        asm volatile("s_waitcnt vmcnt(0)" ::: "memory");
        __syncthreads();
        if (tid == 0) { __hip_atomic_fetch_add(cnt + u.pm, 1u, __ATOMIC_RELAXED, __HIP_MEMORY_SCOPE_AGENT);
            unsigned sp = 0; while (__hip_atomic_load(cnt + u.pm, __ATOMIC_RELAXED, __HIP_MEMORY_SCOPE_AGENT) < 4u) { __builtin_amdgcn_s_sleep(1); if (++sp > (1u << 22)) break; } }
        __syncthreads();
        if (tid < 256) { float t = 0.f;
#pragma unroll
            for (int q = 0; q < 4; ++q) t += __hip_atomic_load(stat + ((size_t)u.pm * 4 + q) * 256 + tid, __ATOMIC_RELAXED, __HIP_MEMORY_SCOPE_AGENT);
            red[1024 + tid] = 1.0f / sqrtf(t * (1.0f / 1024.0f) + 1e-6f); }
        __syncthreads();
#pragma unroll
        for (int bj = 0; bj < 2; ++bj) { f32x4 gm[2], sh[2];
#pragma unroll
            for (int n = 0; n < 2; ++n) { const int c = col0 + bj * HALF + n * 4;
                gm[n] = *(const f32x4*)(n2g + c) * (*(const f32x4*)(mod + r * 6144 + 1024 + c) + 1.0f); sh[n] = *(const f32x4*)(mod + r * 6144 + c); }
#pragma unroll
            for (int ai = 0; ai < 2; ++ai)
#pragma unroll
                for (int m = 0; m < 4; ++m) { const int rl = wr * 64 + fr + ai * HALF + m * 16; const float rstd = red[1024 + wr * 128 + ai * 64 + m * 16 + fr];
                    const size_t p = toff + (size_t)rl * 1024 + col0 + bj * HALF;
                    const int grow = u.pm * BM + rl, cc = col0 + bj * HALF;
                    bf16_t* up = AU + ((size_t)((cc >> 4) * 1024 + (grow >> 11) * 128 + ((grow & 2047) >> 4)) * 256 + (grow & 15) * 16 + (cc & 15));
                    const f32x4 o0 = o[ai][bj][m][0], o1 = o[ai][bj][m][1];
                    u32x4 wo; wo.x = cvt_pk_bf16(o0[0], o0[1]); wo.y = cvt_pk_bf16(o0[2], o0[3]); wo.z = cvt_pk_bf16(o1[0], o1[1]); wo.w = cvt_pk_bf16(o1[2], o1[3]);
                    *(u32x4*)(out + p) = wo;
                    const f32x4 h0 = o0 * rstd * gm[0] + sh[0], h1 = o1 * rstd * gm[1] + sh[1];
                    u32x4 wh; wh.x = cvt_pk_bf16(h0[0], h0[1]); wh.y = cvt_pk_bf16(h0[2], h0[3]); wh.z = cvt_pk_bf16(h1[0], h1[1]); wh.w = cvt_pk_bf16(h1[2], h1[3]);
                    *(u32x4*)up = wh; } }
    }
};

struct EpiSlab {
    static constexpr bool PERM = true;
    bf16_t* slabs;
    __device__ __forceinline__ void operator()(const f32x4 (&acc)[2][2][4][2], const Unit& u, int wr, int wc, int fr, int fq) const {
        { int t_ = threadIdx.x; asm volatile("" : "+v"(t_)); fr = t_ & 15; fq = (t_ >> 4) & 3; }
        const int col0 = u.pn * BM + wc * 32 + 8 * fq;
        bf16_t* so = slabs + (size_t)u.slab * 2048 * 1024 + (size_t)(u.pm - 64) * BM * 1024;
#pragma unroll
        for (int ai = 0; ai < 2; ++ai)
#pragma unroll
            for (int m = 0; m < 4; ++m) { const size_t p = (size_t)(wr * 64 + fr + ai * HALF + m * 16) * 1024 + col0;
#pragma unroll
                for (int bj = 0; bj < 2; ++bj) { const f32x4 v0 = acc[ai][bj][m][0], v1 = acc[ai][bj][m][1];
                    u32x4 w; w.x = cvt_pk_bf16(v0[0], v0[1]); w.y = cvt_pk_bf16(v0[2], v0[3]); w.z = cvt_pk_bf16(v1[0], v1[1]); w.w = cvt_pk_bf16(v1[2], v1[3]);
                    *(u32x4*)(so + p + bj * HALF) = w; } }
    }
};
template <bool FUSEDN>
struct EpiRelu2 {
    static constexpr bool PERM = true;
    bf16_t* O; int ldc; const float* rowss; const float* bias2;
    __device__ __forceinline__ void operator()(const f32x4 (&acc)[2][2][4][2], const Unit& u, int wr, int wc, int fr, int fq) const {
        asm volatile("" : "+v"(fr), "+v"(fq));
        const int row0 = u.pm * BM + wr * 64 + fr, col0 = u.pn * BM + wc * 32 + 8 * fq;
        f32x4 bv[2][2];
        if (FUSEDN) { const float* bp = bias2 + (u.pm >> 3) * 4096 + col0;
#pragma unroll
            for (int bj = 0; bj < 2; ++bj) { bv[bj][0] = *(const f32x4*)(bp + bj * HALF); bv[bj][1] = *(const f32x4*)(bp + bj * HALF + 4); } }
        float rs[2][4];
#pragma unroll
        for (int ai = 0; ai < 2; ++ai)
#pragma unroll
            for (int m = 0; m < 4; ++m) rs[ai][m] = FUSEDN ? rowss[row0 + ai * HALF + m * 16] : 0.f;
#pragma unroll
        for (int ai = 0; ai < 2; ++ai)
#pragma unroll
            for (int m = 0; m < 4; ++m) { const int row = row0 + ai * HALF + m * 16; bf16_t* rowp = O + (size_t)row * ldc + col0;
                float rstd = 1.0f; if (FUSEDN) rstd = 1.0f / sqrtf(rs[ai][m] * (1.0f / 1024.0f) + 1e-6f);
#pragma unroll
                for (int bj = 0; bj < 2; ++bj) { f32x4 v0 = acc[ai][bj][m][0], v1 = acc[ai][bj][m][1];
                    if (FUSEDN) { v0 = v0 * rstd + bv[bj][0]; v1 = v1 * rstd + bv[bj][1]; }
#pragma unroll
                    for (int e = 0; e < 4; ++e) { const float a = fmaxf(v0[e], 0.f), b = fmaxf(v1[e], 0.f); v0[e] = a * a; v1[e] = b * b; }
                    u32x4 w; w.x = cvt_pk_bf16(v0[0], v0[1]); w.y = cvt_pk_bf16(v0[2], v0[3]); w.z = cvt_pk_bf16(v1[0], v1[1]); w.w = cvt_pk_bf16(v1[2], v1[3]);
                    *(u32x4*)(rowp + bj * HALF) = w; } }
    }
};

struct EpiGlu {
    static constexpr bool PERM = true;
    const bf16_t* x; bf16_t* xo; bf16_t* xo2; const float* gate;
    bf16_t* hb; const float* n2g; const float* sc2; float* rowss;
    __device__ __forceinline__ void operator()(const f32x4 (&acc)[2][2][4][2], const Unit& u, int wr, int wc, int fr, int fq) const {
        asm volatile("" : "+v"(fr), "+v"(fq));
        const int r = u.pm >> 3; const int col0 = u.pn * HALF + wc * 32 + 8 * fq; const float* gv = gate + r * 6144 + col0;
        const f32x4 g0 = *(const f32x4*)gv, g1 = *(const f32x4*)(gv + 4);
        const f32x4 gm0 = *(const f32x4*)(n2g + col0) * (*(const f32x4*)(sc2 + r * 6144 + col0) + 1.0f), gm1 = *(const f32x4*)(n2g + col0 + 4) * (*(const f32x4*)(sc2 + r * 6144 + col0 + 4) + 1.0f);
        u32x4 xw[2][4];
#pragma unroll
        for (int ai = 0; ai < 2; ++ai)
#pragma unroll
            for (int m = 0; m < 4; ++m) xw[ai][m] = *(const u32x4*)(x + (size_t)(u.pm * BM + wr * 64 + fr + ai * HALF + m * 16) * 1024 + col0);
#pragma unroll
        for (int ai = 0; ai < 2; ++ai)
#pragma unroll
            for (int m = 0; m < 4; ++m) { const int row = u.pm * BM + wr * 64 + fr + ai * HALF + m * 16; bf16_t* p = (u.pm < 48 ? xo : xo2) + (size_t)row * 1024 + col0;
                const u32x4 w = xw[ai][m];
                f32x4 b0 = (f32x4){bf16lo(w.x), bf16hi(w.x), bf16lo(w.y), bf16hi(w.y)}, b1 = (f32x4){bf16lo(w.z), bf16hi(w.z), bf16lo(w.w), bf16hi(w.w)};
#pragma unroll
                for (int e = 0; e < 4; ++e) {
                    b0[e] += g0[e] * acc[ai][0][m][0][e] * (1.0f / (1.0f + __builtin_amdgcn_exp2f(-1.4426950408889634f * acc[ai][1][m][0][e])));
                    b1[e] += g1[e] * acc[ai][0][m][1][e] * (1.0f / (1.0f + __builtin_amdgcn_exp2f(-1.4426950408889634f * acc[ai][1][m][1][e]))); }
                u32x4 wo; wo.x = cvt_pk_bf16(b0[0], b0[1]); wo.y = cvt_pk_bf16(b0[2], b0[3]); wo.z = cvt_pk_bf16(b1[0], b1[1]); wo.w = cvt_pk_bf16(b1[2], b1[3]);
                *(u32x4*)p = wo;
                const f32x4 r0 = (f32x4){bf16lo(wo.x), bf16hi(wo.x), bf16lo(wo.y), bf16hi(wo.y)}, r1 = (f32x4){bf16lo(wo.z), bf16hi(wo.z), bf16lo(wo.w), bf16hi(wo.w)};
                float ss = (r0[0] * r0[0] + r0[1] * r0[1]) + (r0[2] * r0[2] + r0[3] * r0[3]) + (r1[0] * r1[0] + r1[1] * r1[1]) + (r1[2] * r1[2] + r1[3] * r1[3]);
                ss += __shfl_xor(ss, 16); ss += __shfl_xor(ss, 32);
                if (fq == 0) atomicAdd(rowss + row, ss);
                const f32x4 h0 = r0 * gm0, h1 = r1 * gm1;
                u32x4 wh; wh.x = cvt_pk_bf16(h0[0], h0[1]); wh.y = cvt_pk_bf16(h0[2], h0[3]); wh.z = cvt_pk_bf16(h1[0], h1[1]); wh.w = cvt_pk_bf16(h1[2], h1[3]);
                *(u32x4*)(hb + (size_t)row * 1024 + col0) = wh; }
    }
};

struct EpiSsm1 {
    static constexpr bool PERM = true;
    bf16_t* S;
    __device__ __forceinline__ void operator()(const f32x4 (&acc)[2][2][4][2], const Unit& u, int wr, int wc, int fr, int fq) const {
        asm volatile("" : "+v"(fr), "+v"(fq));
        const int g = u.pn, i = u.pm - 5 * g; const int col0 = wc * 32 + 8 * fq;
#pragma unroll
        for (int ai = 0; ai < 2; ++ai)
#pragma unroll
            for (int m = 0; m < 4; ++m) { const int row = i * BM + wr * 64 + fr + ai * HALF + m * 16;
                if (row < 1152) { bf16_t* p = S + ((size_t)g * 1152 + row) * 256 + col0;
#pragma unroll
                    for (int bj = 0; bj < 2; ++bj) { const f32x4 v0 = acc[ai][bj][m][0], v1 = acc[ai][bj][m][1];
                        u32x4 w; w.x = cvt_pk_bf16(v0[0], v0[1]); w.y = cvt_pk_bf16(v0[2], v0[3]); w.z = cvt_pk_bf16(v1[0], v1[1]); w.w = cvt_pk_bf16(v1[2], v1[3]);
                        *(u32x4*)(p + bj * HALF) = w; } } }
    }
};

__device__ __forceinline__ float gelu_tanh(float v) {
    const float u = 0.7978845608028654f * (v + 0.044715f * v * v * v);
    const float e = __builtin_amdgcn_exp2f(2.0f * 1.4426950408889634f * u);
    const float th = 1.0f - 2.0f / (1.0f + e);
    return 0.5f * v * (1.0f + th);
}
struct EpiSsm2 {
    static constexpr bool PERM = true;
    bf16_t* Z; const bf16_t* A2; const float* dskip;
    __device__ __forceinline__ void operator()(const f32x4 (&acc)[2][2][4][2], const Unit& u, int wr, int wc, int fr, int fq) const {
        asm volatile("" : "+v"(fr), "+v"(fq));
        const int g = u.pn, i = u.pm - 5 * g; const int hh = 8 * (fq & 1); const int zcol = g * 16 + hh;
#pragma unroll
        for (int ai = 0; ai < 2; ++ai)
#pragma unroll
            for (int m = 0; m < 4; ++m) { const int ridx = i * BM + wr * 64 + fr + ai * HALF + m * 16; const int b = ridx >> 7, c = ridx & 127;
#pragma unroll
                for (int bj = 0; bj < 2; ++bj) { const int t = 8 * bj + 2 * wc + (fq >> 1);
                    const f32x4 v0 = acc[ai][bj][m][0], v1 = acc[ai][bj][m][1];
                    float z[8];
#pragma unroll
                    for (int e = 0; e < 4; ++e) { z[e] = gelu_tanh(v0[e]); z[4 + e] = gelu_tanh(v1[e]); }
                    u32x4 w; w.x = cvt_pk_bf16(z[0], z[1]); w.y = cvt_pk_bf16(z[2], z[3]); w.z = cvt_pk_bf16(z[4], z[5]); w.w = cvt_pk_bf16(z[6], z[7]);
                    *(u32x4*)(Z + (size_t)(b * 2048 + c * 16 + t) * 1024 + zcol) = w;
                    } }
    }
};

template <class Epi, class Sched, bool ALIGN_EPI, int AJT = 0, int PRE = 0>
__device__ __forceinline__ void gemm_phase(PG8_LAS unsigned char* lds, const Gemm g, const Sched& S, const Epi& E) {
    int tid = threadIdx.x; asm volatile("" : "+v"(tid));
    const int wid = __builtin_amdgcn_readfirstlane(tid >> 6), lane = tid & 63, wr = wid >> 2, wc = wid & 3, fr = lane & 15, fq = lane >> 4;
    unsigned voffA[2], voffB[2];
#pragma unroll
    for (int i = 0; i < 2; ++i) { int R, C; stage_rc(tid * 16 + i * 8192, R, C); const int Rb = Epi::PERM ? ((R & ~31) + perm32(R & 31)) : R;
        voffA[i] = (unsigned)(R * g.lda + C) * 2u; voffB[i] = (unsigned)(Rb * g.ldb + C) * 2u; }
    const size_t kstep = (size_t)(BK * 2);
    const size_t hstepA = (size_t)HALF * g.lda * 2, hstepB = (size_t)HALF * g.ldb * 2;
    const size_t tstepA = 2 * hstepA, tstepB = 2 * hstepB;
    const unsigned ldsw = (unsigned)wid * 1024u;
    const int aoff = lds_byte(wr * 64 + fr, fq * 8), boff = lds_byte(wc * 32 + fr, fq * 8);
#define PG8_SA(b, h) (((b) * 2 + (h)) * HTB)
#define PG8_SB(b, h) ((4 + (b) * 2 + (h)) * HTB)
#define PG8_STAGE(bufoff, gbase, voff) do { _Pragma("unroll") for (int _i = 0; _i < 2; ++_i) \
        __builtin_amdgcn_global_load_lds((const unsigned*)((const char*)(gbase) + (voff)[_i]), (PG8_LAS unsigned*)(lds + (bufoff) + ldsw + _i * 8192), 16, 0, 0); } while (0)
#define PG8_LDA(dst, b, h) do { _Pragma("unroll") for (int m = 0; m < 4; ++m) _Pragma("unroll") for (int k = 0; k < 2; ++k) dst[m][k] = *(const PG8_LAS bf16x8*)(lds + PG8_SA(b, h) + aoff + m * 2048 + k * 1024); } while (0)
#define PG8_LDB(dst, b, h) do { _Pragma("unroll") for (int n = 0; n < 2; ++n) _Pragma("unroll") for (int k = 0; k < 2; ++k) dst[n][k] = *(const PG8_LAS bf16x8*)(lds + PG8_SB(b, h) + boff + n * 2048 + k * 1024); } while (0)
#define PG8_MMA(ai, bj, At, Bt) do { __builtin_amdgcn_s_setprio(1); _Pragma("unroll") for (int m = 0; m < 4; ++m) _Pragma("unroll") for (int n = 0; n < 2; ++n) _Pragma("unroll") for (int k = 0; k < 2; ++k) \
        acc[ai][bj][m][n] = __builtin_amdgcn_mfma_f32_16x16x32_bf16(Bt[n][k], At[m][k], acc[ai][bj][m][n], 0, 0, 0); __builtin_amdgcn_s_setprio(0); } while (0)
#define PG8_WAIT_V(n) asm volatile("s_waitcnt vmcnt(" #n ")" ::: "memory")
#define PG8_WAIT_L(n) asm volatile("s_waitcnt lgkmcnt(" #n ")" ::: "memory")
#define PG8_BAR __builtin_amdgcn_s_barrier()
#define PG8_SCHED __builtin_amdgcn_sched_barrier(0)
    Unit cur, nxt; int ui = 0;
    if (!S.next(0, cur)) return;
    f32x4 acc[2][2][4][2];
#pragma unroll
    for (int a = 0; a < 2; ++a)
#pragma unroll
        for (int b = 0; b < 2; ++b)
#pragma unroll
            for (int m = 0; m < 4; ++m)
#pragma unroll
                for (int n = 0; n < 2; ++n) acc[a][b][m][n] = (f32x4){0.f, 0.f, 0.f, 0.f};
    bf16x8 At[4][2], B0[2][2], B1[2][2];
    const char* cA = (const char*)g.A + (size_t)S.atile(cur) * tstepA + (size_t)cur.kt0 * kstep; const char* cB = (const char*)g.Bt + (size_t)cur.pn * tstepB + (size_t)cur.kt0 * kstep;
    if constexpr (PRE != 2) { PG8_STAGE(PG8_SB(0, 0), cB, voffB); PG8_STAGE(PG8_SB(0, 1), cB + hstepB, voffB); PG8_STAGE(PG8_SA(0, 0), cA, voffA); PG8_STAGE(PG8_SA(0, 1), cA + hstepA, voffA); }
    if constexpr (PRE == 1) { PG8_STAGE(PG8_SB(1, 0), cB + kstep, voffB); PG8_STAGE(PG8_SA(1, 0), cA + kstep, voffA); PG8_STAGE(PG8_SB(1, 1), cB + hstepB + kstep, voffB); return; }
    if (wr == 1) PG8_BAR;
    PG8_WAIT_V(2); PG8_BAR;
    if constexpr (PRE != 2) { PG8_STAGE(PG8_SB(1, 0), cB + kstep, voffB); PG8_STAGE(PG8_SA(1, 0), cA + kstep, voffA); PG8_STAGE(PG8_SB(1, 1), cB + hstepB + kstep, voffB); }
    PG8_WAIT_V(6); PG8_BAR;
    for (;;) {
        const bool has_next = S.next(ui + 1, nxt);
        const char* nA = has_next ? (const char*)g.A + (size_t)S.atile(nxt) * tstepA + (size_t)nxt.kt0 * kstep : cA; const char* nB = has_next ? (const char*)g.Bt + (size_t)nxt.pn * tstepB + (size_t)nxt.kt0 * kstep : cB;
        const int nt = cur.nt;
        for (int t = 0; t < nt; t += 2) {
            const bool last = (t == nt - 2);
            const char* a1 = cA + (size_t)(t + 1) * kstep;
            const char* a2 = last ? nA : cA + (size_t)(t + 2) * kstep; const char* b2 = last ? nB : cB + (size_t)(t + 2) * kstep;
            const char* a3 = a2 + kstep; const char* b3 = b2 + kstep;
            if constexpr (AJT > 0) { if (t + 1 >= AJT) a1 += g.ajump; if (!last) { if (t + 2 >= AJT) a2 += g.ajump; a3 = a2 + kstep; if (t + 2 < AJT && t + 3 >= AJT) a3 += g.ajump; } }
            PG8_LDB(B0, 0, 0); PG8_LDB(B1, 0, 1); PG8_SCHED; PG8_LDA(At, 0, 0); PG8_STAGE(PG8_SA(1, 1), a1 + hstepA, voffA);
            PG8_WAIT_V(8); PG8_WAIT_L(0); PG8_BAR; PG8_MMA(0, 0, At, B0); PG8_MMA(0, 1, At, B1); PG8_BAR; PG8_SCHED;
            PG8_LDA(At, 0, 1); PG8_STAGE(PG8_SB(0, 0), b2, voffB); PG8_STAGE(PG8_SB(0, 1), b2 + hstepB, voffB); PG8_STAGE(PG8_SA(0, 0), a2, voffA);
            PG8_WAIT_V(8); PG8_WAIT_L(0); PG8_BAR; PG8_MMA(1, 0, At, B0); PG8_MMA(1, 1, At, B1); PG8_BAR; PG8_SCHED;
            PG8_LDB(B0, 1, 0); PG8_LDB(B1, 1, 1); PG8_SCHED; PG8_LDA(At, 1, 0); PG8_STAGE(PG8_SA(0, 1), a2 + hstepA, voffA);
            PG8_WAIT_V(8); PG8_WAIT_L(0); PG8_BAR; PG8_MMA(0, 0, At, B0); PG8_MMA(0, 1, At, B1); PG8_BAR; PG8_SCHED;
            PG8_LDA(At, 1, 1); PG8_STAGE(PG8_SB(1, 0), b3, voffB); PG8_STAGE(PG8_SB(1, 1), b3 + hstepB, voffB); PG8_STAGE(PG8_SA(1, 0), a3, voffA);
            PG8_WAIT_V(8); PG8_WAIT_L(0); PG8_BAR; PG8_MMA(1, 0, At, B0); PG8_MMA(1, 1, At, B1); PG8_BAR; PG8_SCHED;
        }
        if constexpr (ALIGN_EPI) { if (wr == 0) PG8_BAR; }
        E(acc, cur, wr, wc, fr, fq);
        if (!has_next) break;
#pragma unroll
        for (int a = 0; a < 2; ++a)
#pragma unroll
            for (int b = 0; b < 2; ++b)
#pragma unroll
                for (int m = 0; m < 4; ++m)
#pragma unroll
                    for (int n = 0; n < 2; ++n) acc[a][b][m][n] = (f32x4){0.f, 0.f, 0.f, 0.f};
        cur = nxt; cA = nA; cB = nB; ++ui;
        if constexpr (ALIGN_EPI) { if (wr == 1) PG8_BAR; }
    }
    PG8_WAIT_V(0);
    if constexpr (!ALIGN_EPI) { if (wr == 0) PG8_BAR; }
    PG8_BAR;
#undef PG8_SA
#undef PG8_SB
#undef PG8_STAGE
#undef PG8_LDA
#undef PG8_LDB
#undef PG8_MMA
#undef PG8_WAIT_V
#undef PG8_WAIT_L
#undef PG8_BAR
#undef PG8_SCHED
}
}
namespace att {
typedef __attribute__((address_space(3))) unsigned char lds_u8;
typedef __attribute__((address_space(3))) const unsigned char* lds_cptr;
using bf16x8 = __attribute__((ext_vector_type(8))) short;
using s16x4 = __attribute__((ext_vector_type(4))) short;
using f32x16 = __attribute__((ext_vector_type(16))) float;
using f32x4 = __attribute__((ext_vector_type(4))) float;
using u32x4 = __attribute__((ext_vector_type(4))) unsigned;
typedef unsigned short bf16_t;
#define ATT_LF __attribute__((address_space(3))) float
constexpr int PITCH = 3072;
constexpr int OPITCH = 1024;
constexpr int STAGE_B = 32768;
constexpr int L_OST = 98304;
constexpr int L_WSF = 132096;
constexpr int L_BIAS = 136192;
constexpr int XSTR = 132;
constexpr float LOG2E = 1.4426950408889634f;

__device__ __forceinline__ int crow(int r, int hi) { return (r & 3) + 8 * (r >> 2) + 4 * hi; }
#define ATT_SBAR() __builtin_amdgcn_sched_barrier(0)
__device__ __forceinline__ void glds16(const void* gsrc, unsigned lds_dst) { unsigned keep;
    asm volatile("s_mov_b32 %0, m0\n\ts_mov_b32 m0, %2\n\ts_nop 0\n\tglobal_load_lds_dwordx4 %1, off\n\ts_mov_b32 m0, %0" : "=&s"(keep) : "v"(gsrc), "s"(lds_dst) : "memory"); }
typedef float f32x2_t __attribute__((ext_vector_type(2))); typedef __bf16 bf16x2_t __attribute__((ext_vector_type(2)));
__device__ __forceinline__ unsigned cvtpk(float lo, float hi) { f32x2_t v = {lo, hi}; bf16x2_t b = __builtin_convertvector(v, bf16x2_t); return __builtin_bit_cast(unsigned, b); }

typedef short v4i16_t __attribute__((ext_vector_type(4)));
__device__ __forceinline__ s16x4 vtr(lds_cptr p) { return __builtin_bit_cast(s16x4, __builtin_amdgcn_ds_read_tr16_b64_v4i16((__attribute__((address_space(3))) v4i16_t*)p)); }
__device__ __forceinline__ void qkt(f32x16& p0, f32x16& p1, lds_cptr Kslot, const bf16x8* qr, int r32, int hi) {
    lds_cptr kb = Kslot + r32 * 128; const int sw = (r32 >> 1) & 7;
    const f32x16 z = f32x16{};
#pragma unroll
    for (int d0 = 0; d0 < 4; ++d0) {
        const int off = ((2 * d0 + hi) ^ sw) << 4;
        const bf16x8 b0 = *(const __attribute__((address_space(3))) bf16x8*)(kb + off);
        const bf16x8 b1 = *(const __attribute__((address_space(3))) bf16x8*)(kb + off + 4096);
        if (d0 == 0) { p0 = __builtin_amdgcn_mfma_f32_32x32x16_bf16(b0, qr[0], z, 0, 0, 0); p1 = __builtin_amdgcn_mfma_f32_32x32x16_bf16(b1, qr[0], z, 0, 0, 0); }
        else { p0 = __builtin_amdgcn_mfma_f32_32x32x16_bf16(b0, qr[d0], p0, 0, 0, 0); p1 = __builtin_amdgcn_mfma_f32_32x32x16_bf16(b1, qr[d0], p1, 0, 0, 0); } }
}
#define ATT_TRG(lo_, hi_, vb_, off_) do { _Pragma("unroll") for (int ks = 0; ks < 4; ++ks) { \
        asm volatile("ds_read_b64_tr_b16 %0,%1 offset:%c2" : "=&v"(lo_[ks]) : "v"(vb_), "i"((off_) + ks * 2048) : "memory"); \
        asm volatile("ds_read_b64_tr_b16 %0,%1 offset:%c2" : "=&v"(hi_[ks]) : "v"(vb_), "i"((off_) + ks * 2048 + 1024) : "memory"); } } while (0)
#define ATT_PK(lo_, hi_, k) (bf16x8){lo_[k][0], lo_[k][1], lo_[k][2], lo_[k][3], hi_[k][0], hi_[k][1], hi_[k][2], hi_[k][3]}
#define ATT_MM(acc_, lo_, hi_) do { __builtin_amdgcn_s_setprio(1); \
        acc_ = __builtin_amdgcn_mfma_f32_32x32x16_bf16(pa0, ATT_PK(lo_, hi_, 0), acc_, 0, 0, 0); acc_ = __builtin_amdgcn_mfma_f32_32x32x16_bf16(pa1, ATT_PK(lo_, hi_, 1), acc_, 0, 0, 0); \
        acc_ = __builtin_amdgcn_mfma_f32_32x32x16_bf16(pa2, ATT_PK(lo_, hi_, 2), acc_, 0, 0, 0); acc_ = __builtin_amdgcn_mfma_f32_32x32x16_bf16(pa3, ATT_PK(lo_, hi_, 3), acc_, 0, 0, 0); \
        __builtin_amdgcn_s_setprio(0); } while (0)
template <int NS>
__device__ __forceinline__ void pv(f32x16* o, int vbA, int vbB, bf16x8 pa0, bf16x8 pa1, bf16x8 pa2, bf16x8 pa3) {
    s16x4 loA[4], hiA[4], loB[4], hiB[4];
    asm volatile("s_waitcnt lgkmcnt(0)" ::: "memory");
    ATT_TRG(loA, hiA, vbA, 0);
    ATT_TRG(loB, hiB, vbB, 0);
    asm volatile("s_waitcnt lgkmcnt(8)" ::: "memory"); ATT_SBAR();
    ATT_MM(o[0], loA, hiA);
    if (NS == 2) {
        ATT_SBAR(); ATT_TRG(loA, hiA, vbA, 8192);
        asm volatile("s_waitcnt lgkmcnt(8)" ::: "memory"); ATT_SBAR();
        ATT_MM(o[1], loB, hiB);
        ATT_SBAR(); ATT_TRG(loB, hiB, vbB, 8192);
        asm volatile("s_waitcnt lgkmcnt(8)" ::: "memory"); ATT_SBAR();
        ATT_MM(o[2], loA, hiA);
        asm volatile("s_waitcnt lgkmcnt(0)" ::: "memory"); ATT_SBAR();
        ATT_MM(o[3], loB, hiB);
    } else {
        asm volatile("s_waitcnt lgkmcnt(0)" ::: "memory"); ATT_SBAR();
        ATT_MM(o[1], loB, hiB);
    }
}
__device__ __forceinline__ float rowmax32(const f32x16& p0, const f32x16& p1) {
    float a = p0[0], b = p1[0];
#pragma unroll
    for (int r = 1; r < 16; ++r) { a = __builtin_fmaxf(a, p0[r]); b = __builtin_fmaxf(b, p1[r]); }
    const float m = __builtin_fmaxf(a, b);
    auto rr = __builtin_amdgcn_permlane32_swap(__float_as_uint(m), __float_as_uint(m), false, false);
    return __builtin_fmaxf(__uint_as_float(rr[0]), __uint_as_float(rr[1]));
}
template <int XM> __device__ __forceinline__ float softmax_step(f32x16& p0, f32x16& p1, float& m, float& l) {
    constexpr float THR = 6.0f;
    const float rm = rowmax32(p0, p1);
    float f = 1.0f;
    if (__any(rm > m + THR)) { const float mn = __builtin_fmaxf(m, rm); f = __builtin_amdgcn_exp2f(m - mn); m = mn; l *= f; }
    float s = 0.f;
#pragma unroll
    for (int r = 0; r < 16; ++r) {
        if (XM == 3) { p0[r] = (p0[r] - m) * 0.001f + 0.01f; p1[r] = (p1[r] - m) * 0.001f + 0.01f; }
        else { p0[r] = __builtin_amdgcn_exp2f(p0[r] - m); p1[r] = __builtin_amdgcn_exp2f(p1[r] - m); }
        s += p0[r] + p1[r]; }
    l += s;
    return f;
}

struct UnitDesc {
    int qrow0;
    int qcol, kcol, vcol;
    int latrow, t0, nlat;
    int ctxrow;
    int ocol;
    int r0, head;
};

template <bool DIFF, bool NAM, int XM = 0>
__device__ __forceinline__ void attn_unit(const UnitDesc& U, const bf16_t* __restrict__ proj, bf16_t* __restrict__ out, lds_u8* shm3,
                                          const float* __restrict__ rpb, const float* __restrict__ subg, float lam, float outscale) {
    if (XM == 7) return;
    int tid = threadIdx.x; asm volatile("" : "+v"(tid));
    const int lane = tid & 63, r32 = lane & 31, hi = lane >> 5; const int wid = __builtin_amdgcn_readfirstlane(tid >> 6);
    const unsigned lds0 = (unsigned)(uintptr_t)shm3;
    ATT_LF* wsf = (ATT_LF*)(shm3 + L_WSF + wid * 512);
    constexpr int SUBS = DIFF ? 1 : 2;
    const int ntile = U.nlat + 4;
    const int nstage = (XM == 6) ? 1 : (ntile + SUBS - 1) / SUBS;
    const int qblk = DIFF ? (wid >> 1) : wid, sh = DIFF ? (wid & 1) : 0;
    if (NAM) { ATT_LF* bl = (ATT_LF*)(shm3 + L_BIAS);
        for (int i = tid; i < 15 * 31; i += 512) { const int ro = i / 31, j = i - ro * 31; bl[ro * 128 + 48 + j] = rpb[(U.head * 15 + ro) * 31 + j] * LOG2E; } }
    const bf16_t* ksrc0 = proj + (size_t)(8 * wid + (lane >> 3)) * PITCH + U.kcol + (((lane & 7) ^ ((4 * wid + (lane >> 4)) & 7)) << 3);
    const bf16_t* vsrc0 = proj + (size_t)(8 * wid + (lane >> 3)) * PITCH + U.vcol + (((lane & 7) ^ (((lane >> 4) & 1) << 2)) << 3);
    const unsigned dstw = lds0 + wid * 1024;
#define ATT_TILE_ROW(i) (((i) < U.nlat) ? (U.latrow + 64 * (U.t0 + (i))) : (U.ctxrow + 64 * ((i) - U.nlat)))
#define ATT_DMA_STAGE(s_) do { if (XM == 5 || XM >= 9) break; const int s__ = (s_); const unsigned d_ = (unsigned)__builtin_amdgcn_readfirstlane((int)(dstw + (s__ & 3) * STAGE_B)); \
        if (DIFF) { const size_t ro_ = (size_t)ATT_TILE_ROW(s__) * PITCH; glds16(ksrc0 + ro_, d_); glds16(ksrc0 + ro_ + 64, d_ + 8192); glds16(vsrc0 + ro_, d_ + 16384); glds16(vsrc0 + ro_ + 64, d_ + 24576); } \
        else { const size_t ro_ = (size_t)ATT_TILE_ROW(2 * s__) * PITCH; glds16(ksrc0 + ro_, d_); glds16(vsrc0 + ro_, d_ + 16384); \
               { const int t1_ = (2 * s__ + 1 < ntile) ? 2 * s__ + 1 : 2 * s__; const size_t r1_ = (size_t)ATT_TILE_ROW(t1_) * PITCH; glds16(ksrc0 + r1_, d_ + 8192); glds16(vsrc0 + r1_, d_ + 24576); } } } while (0)
    const bf16_t* Qw = proj + (size_t)(U.qrow0 + qblk * 32 + r32) * PITCH + U.qcol + sh * 64 + hi * 8;
    bf16x8 qr[4];
#pragma unroll
    for (int d0 = 0; d0 < 4; ++d0) qr[d0] = *(const bf16x8*)(Qw + d0 * 16);
    float m1 = -1e30f, l1 = 0.f;
    constexpr int NO = DIFF ? 4 : 2;
    f32x16 o[NO];
#pragma unroll
    for (int i = 0; i < NO; ++i) o[i] = f32x16{};
    const int dsw_ = ((lane & 15) >> 3) & 1;
    const int vbl = (int)lds0 + 16384 + (4 * hi + ((lane & 15) >> 2)) * 128 + ((lane >> 4) & 1) * 32 + (lane & 3) * 8;
    const int vblA = vbl + dsw_ * 64, vblB = vbl + (1 - dsw_) * 64;
    const int gr = U.r0 + (wid >> 1); const int rs = gr < 4 ? 0 : (gr > 28 ? 24 : gr - 4);
    const int qc = 32 * (wid & 1) + r32; const int cs = qc < 8 ? 0 : (qc > 56 ? 48 : qc - 8);
#define ATT_USE(j) ((j) < ntile && (!NAM || (j) >= U.nlat || ((U.t0 + (j)) >= rs && (U.t0 + (j)) <= rs + 7)))
#define ATT_KSLOT(j) ((lds_cptr)(shm3 + (((j) / SUBS) & 3) * STAGE_B + (DIFF ? sh * 8192 : ((j) & 1) * 8192)))
#define ATT_WAIT_BAR(N) do { if (XM < 9) asm volatile("s_waitcnt vmcnt(" #N ") lgkmcnt(0)\n\ts_barrier" ::: "memory"); } while (0)
    ATT_DMA_STAGE(0);
    if (nstage > 1) ATT_DMA_STAGE(1);
    if (nstage > 2) ATT_DMA_STAGE(2);
    if (nstage > 2) ATT_WAIT_BAR(8); else if (nstage > 1) ATT_WAIT_BAR(4); else ATT_WAIT_BAR(0);
    f32x16 sc0 = f32x16{}, sc1 = f32x16{}, sn0 = f32x16{}, sn1 = f32x16{};
    if (ATT_USE(0)) qkt(sc0, sc1, ATT_KSLOT(0), qr, r32, hi);
    for (int s = 0; s < nstage; ++s) {
#pragma unroll
        for (int sub = 0; sub < SUBS; ++sub) {
            const int j = s * SUBS + sub;
            if (sub == SUBS - 1 && s + 1 < nstage) {
                if (s + 2 < nstage) ATT_WAIT_BAR(4); else ATT_WAIT_BAR(0);
                if (s + 3 < nstage) ATT_DMA_STAGE(s + 3);
            }
            const bool un = ATT_USE(j + 1), uc = ATT_USE(j);
            if (un) { if (XM == 4 || XM == 12) { sn0 = f32x16{}; sn1 = f32x16{}; asm volatile("" : "+v"(sn0), "+v"(sn1)); } else qkt(sn0, sn1, ATT_KSLOT(j + 1), qr, r32, hi); }
            if (uc) {
                if (NAM && j < U.nlat) {
                    const int kr = U.t0 + j;
                    const ATT_LF* brow = (const ATT_LF*)(shm3 + L_BIAS) + (kr - gr + 7) * 128 + 48 + 15 - qc + 4 * hi;
#pragma unroll
                    for (int r = 0; r < 16; ++r) { const int kc = (r & 3) + 8 * (r >> 2); const int kcl = kc + 4 * hi;
                        const float b0 = brow[kc], b1 = brow[kc + 32];
                        sc0[r] = ((unsigned)(kcl - cs) < 16u) ? sc0[r] + b0 : -INFINITY;
                        sc1[r] = ((unsigned)(kcl + 32 - cs) < 16u) ? sc1[r] + b1 : -INFINITY;
                        if ((r & 3) == 3) ATT_SBAR(); }
                }
                if (XM < 10) { const float rm = rowmax32(sc0, sc1);
                  if (__any(rm > m1 + 6.0f)) {
                      const float mn = __builtin_fmaxf(m1, rm); const float f = __builtin_amdgcn_exp2f(m1 - mn); m1 = mn; l1 *= f;
                      if (hi == 0) wsf[r32] = f;
                      asm volatile("s_waitcnt lgkmcnt(0)" ::: "memory");
                      float fr_[16];
#pragma unroll
                      for (int r = 0; r < 16; ++r) fr_[r] = wsf[crow(r, hi)];
#pragma unroll
                      for (int d = 0; d < NO; ++d)
#pragma unroll
                          for (int r = 0; r < 16; ++r) o[d][r] *= fr_[r];
                      asm volatile("s_waitcnt lgkmcnt(0)" ::: "memory");
                  } }
                { const int vbo = (s & 3) * STAGE_B + (DIFF ? 0 : sub * 8192);
                  lds_cptr vpA = (lds_cptr)(uintptr_t)(unsigned)(vblA + vbo), vpB = (lds_cptr)(uintptr_t)(unsigned)(vblB + vbo);
                  float ssum = 0.f;
                  bf16x8 vfc[NO], vfn[NO]; bf16x8 pac, pan;
#define ATT_VLD(dst, ks_) do { if (XM == 11 || XM == 13) { _Pragma("unroll") for (int d = 0; d < NO; ++d) { dst[d] = (bf16x8){1, 2, 3, 4, 5, 6, 7, 8}; asm volatile("" : "+v"(dst[d])); } break; } _Pragma("unroll") for (int d = 0; d < NO; ++d) { lds_cptr vp_ = ((d & 1) ? vpB : vpA) + (d >> 1) * 8192 + (ks_) * 2048; \
                      const s16x4 lo_ = vtr(vp_), hi_ = vtr(vp_ + 1024); dst[d] = (bf16x8){lo_[0], lo_[1], lo_[2], lo_[3], hi_[0], hi_[1], hi_[2], hi_[3]}; } } while (0)
#define ATT_EXP8(dst, ks_) do { float e_[8]; _Pragma("unroll") for (int i = 0; i < 8; ++i) { const float x_ = ((ks_) < 2) ? sc0[((ks_) & 1) * 8 + i] : sc1[((ks_) & 1) * 8 + i]; e_[i] = (XM >= 10) ? x_ : __builtin_amdgcn_exp2f(x_ - m1); ssum += e_[i]; } \
                      const u32x4 pw_ = (u32x4){cvtpk(e_[0], e_[1]), cvtpk(e_[2], e_[3]), cvtpk(e_[4], e_[5]), cvtpk(e_[6], e_[7])}; dst = __builtin_bit_cast(bf16x8, pw_); } while (0)
                  ATT_VLD(vfc, 0); ATT_EXP8(pac, 0);
#pragma unroll
                  for (int ks = 0; ks < 4; ++ks) {
                      if (ks < 3) { ATT_VLD(vfn, ks + 1); ATT_EXP8(pan, ks + 1); }
#pragma unroll
                      for (int d = 0; d < NO; ++d) { if (XM == 13) { asm volatile("" :: "v"(pac), "v"(vfc[d])); } else o[d] = __builtin_amdgcn_mfma_f32_32x32x16_bf16(pac, vfc[d], o[d], 0, 0, 0); }
                      if (ks < 3) {
#pragma unroll
                          for (int d = 0; d < NO; ++d) { vfc[d] = vfn[d];
                              __builtin_amdgcn_sched_group_barrier(0x008, 1, 0); __builtin_amdgcn_sched_group_barrier(0x100, 2, 0); __builtin_amdgcn_sched_group_barrier(0x002, DIFF ? 7 : 14, 0); }
                          pac = pan; }
                  }
#undef ATT_VLD
#undef ATT_EXP8
                  l1 += ssum; }
            }
            sc0 = sn0; sc1 = sn1;
        }
    }
    { auto rr = __builtin_amdgcn_permlane32_swap(__float_as_uint(l1), __float_as_uint(l1), false, false); l1 = __uint_as_float(rr[0]) + __uint_as_float(rr[1]); }
    if (hi == 0) wsf[32 + r32] = (DIFF && sh == 1) ? lam / l1 : 1.0f / l1;
    asm volatile("s_waitcnt lgkmcnt(0)" ::: "memory");
    float rli[16];
#pragma unroll
    for (int r = 0; r < 16; ++r) rli[r] = wsf[32 + crow(r, hi)];
    if (!DIFF) {
        bf16_t* Ow = out + (size_t)(U.qrow0 + wid * 32) * OPITCH + U.ocol;
        asm volatile("s_waitcnt lgkmcnt(0)\n\ts_barrier" ::: "memory");
        __attribute__((address_space(3))) bf16_t* stg = (__attribute__((address_space(3))) bf16_t*)(shm3 + wid * 4096);
#pragma unroll
        for (int r = 0; r < 16; ++r) { const int orow = crow(r, hi);
#pragma unroll
            for (int d0 = 0; d0 < 2; ++d0) stg[orow * 64 + d0 * 32 + r32] = (bf16_t)(cvtpk(o[d0][r] * rli[r], 0.f) & 0xffffu); }
        asm volatile("s_waitcnt lgkmcnt(0)" ::: "memory");
#pragma unroll
        for (int i = 0; i < 4; ++i) { const int row = i * 8 + (lane >> 3), ch = lane & 7; const u32x4 v = *(const __attribute__((address_space(3))) u32x4*)(stg + row * 64 + ch * 8); *(u32x4*)(Ow + (size_t)row * OPITCH + ch * 8) = v; }
        asm volatile("s_waitcnt lgkmcnt(0)\n\ts_barrier" ::: "memory");
    } else {
        asm volatile("s_waitcnt lgkmcnt(0)\n\ts_barrier" ::: "memory");
        ATT_LF* X = (ATT_LF*)shm3 + qblk * 32 * XSTR;
        if (sh == 1) {
#pragma unroll
            for (int r = 0; r < 16; ++r)
#pragma unroll
                for (int d0 = 0; d0 < 4; ++d0) X[crow(r, hi) * XSTR + d0 * 32 + r32] = o[d0][r] * rli[r];
        }
        asm volatile("s_waitcnt lgkmcnt(0)\n\ts_barrier" ::: "memory");
        if (sh == 0) {
#pragma unroll
            for (int r = 0; r < 16; ++r)
#pragma unroll
                for (int d0 = 0; d0 < 4; ++d0) { ATT_LF* p = X + crow(r, hi) * XSTR + d0 * 32 + r32; *p = o[d0][r] * rli[r] - *p; }
            asm volatile("s_waitcnt lgkmcnt(0)" ::: "memory");
            const int rowl = lane >> 1, hf = lane & 1;
            float v[64]; float ss = 0.f;
#pragma unroll
            for (int e4 = 0; e4 < 16; ++e4) { const f32x4 x = *(const __attribute__((address_space(3))) f32x4*)(X + rowl * XSTR + hf * 64 + e4 * 4);
                v[e4 * 4 + 0] = x[0]; v[e4 * 4 + 1] = x[1]; v[e4 * 4 + 2] = x[2]; v[e4 * 4 + 3] = x[3]; ss += x[0] * x[0] + x[1] * x[1] + x[2] * x[2] + x[3] * x[3]; }
            ss += __shfl_xor(ss, 1);
            const float rstd = outscale / sqrtf(ss * (1.0f / 128.0f) + 1e-5f);
            bf16_t* dst = out + (size_t)(U.qrow0 + qblk * 32 + rowl) * OPITCH + U.ocol + hf * 64;
#pragma unroll
            for (int e8 = 0; e8 < 8; ++e8) { const f32x4 g0 = *(const f32x4*)(subg + hf * 64 + e8 * 8), g1 = *(const f32x4*)(subg + hf * 64 + e8 * 8 + 4); u32x4 w;
                w.x = cvtpk(v[e8 * 8 + 0] * rstd * g0[0], v[e8 * 8 + 1] * rstd * g0[1]); w.y = cvtpk(v[e8 * 8 + 2] * rstd * g0[2], v[e8 * 8 + 3] * rstd * g0[3]);
                w.z = cvtpk(v[e8 * 8 + 4] * rstd * g1[0], v[e8 * 8 + 5] * rstd * g1[1]); w.w = cvtpk(v[e8 * 8 + 6] * rstd * g1[2], v[e8 * 8 + 7] * rstd * g1[3]);
                *(u32x4*)(dst + e8 * 8) = w; }
        }
        asm volatile("s_waitcnt lgkmcnt(0)\n\ts_barrier" ::: "memory");
    }
#undef ATT_TILE_ROW
#undef ATT_DMA_STAGE
#undef ATT_USE
#undef ATT_KSLOT
#undef ATT_WAIT_BAR
}
#undef ATT_SBAR
#undef ATT_TRG
#undef ATT_PK
#undef ATT_MM
#undef ATT_LF
}
constexpr int NWAVES = 8;
constexpr int NB = 8, SEQ = 2048, LC = 256, DM = 1024, FF = 4096, NPROJ = 3072;
constexpr int ML = NB * SEQ;
constexpr int MC = NB * LC;
constexpr int MT = ML + MC;
constexpr float NORM_EPS = 1e-6f;

constexpr size_t MiB = 1u << 20;
constexpr size_t WS_CTL = 0, CTL_ZERO_BYTES = 256 * 1024;
constexpr size_t WS_ROWSS1 = 64 * 1024;
constexpr size_t WS_BIAS2 = 1 * MiB + 512 * 1024 + 32 * 1024;
constexpr size_t WS_MADA = 1 * MiB;
constexpr size_t WS_ROPE = 1 * MiB + 512 * 1024;
constexpr size_t WS_LAM  = WS_ROPE + 16384;
constexpr size_t WS_MP = 1 * MiB + 512 * 1024 + 192 * 1024;
constexpr size_t WS_WIN = 2 * MiB, WS_WOUT = 8 * MiB, WS_W1_0 = 10 * MiB, WS_W2_0 = 18 * MiB;
constexpr size_t WS_W1_1 = 26 * MiB, WS_W2_1 = 34 * MiB, WS_WGLU = 42 * MiB;
constexpr size_t WS_SSM_WEND = 2 * MiB;
constexpr size_t WS_SSM_B2 = 10 * MiB;
constexpr size_t WS_HB = 46 * MiB;
constexpr size_t WS_BIG = 82 * MiB;
constexpr size_t WS_SEND = 162 * MiB;
constexpr size_t WS_XC = 226 * MiB;
constexpr size_t WS_H2B = 210 * MiB;
constexpr size_t WS_KD = 254 * MiB;
constexpr size_t WS_END = 256 * MiB;
static_assert(WS_BIG + (size_t)MT * FF * 2 <= WS_XC, "hid fits");
static_assert(WS_SEND + (size_t)64 * 1152 * 256 * 4 <= WS_END, "S_end fits");
static_assert(WS_BIG + (size_t)64 * 1280 * 512 * 2 <= WS_SEND, "A2 fits");

constexpr int RING_BYTES = 131072;
constexpr int LDSCTL_OFF = RING_BYTES, MISC_OFF = LDSCTL_OFF + 320;
constexpr int LDS_BYTES = 147456;

#define GAS __attribute__((address_space(1)))
#define LAS __attribute__((address_space(3)))
typedef unsigned short bf16;
typedef unsigned v4u __attribute__((ext_vector_type(4)));
typedef unsigned v2u __attribute__((ext_vector_type(2)));
typedef float f32x4 __attribute__((ext_vector_type(4)));
typedef GAS unsigned gu32;
#define RLX_AGENT __ATOMIC_RELAXED, __HIP_MEMORY_SCOPE_AGENT
#define LDS_WAIT() asm volatile("s_waitcnt lgkmcnt(0)" ::: "memory")
#define VM_WAIT() asm volatile("s_waitcnt vmcnt(0)" ::: "memory")
__device__ __forceinline__ unsigned f2bf(float f) { unsigned u = __builtin_bit_cast(unsigned, f); return (u + 0x7fffu + ((u >> 16) & 1u)) >> 16; }
__device__ __forceinline__ unsigned pk2(float lo, float hi) { return f2bf(lo) | (f2bf(hi) << 16); }

#define XB_TMO      128
#define XB_XCNT(j)  (256  + 64 * (j))
#define XB_XSUB(j)  (1280 + 64 * (j))
#define XB_XGEN(j)  (2304 + 64 * (j))
#define XB_TOP      3328
#define XB_TOPGEN   3392
#define XCD_BAR_WORDS 3456
#define XB_SPIN_CAP (1u << 18)
__device__ __forceinline__ unsigned xb_ld(unsigned* p)              { return __hip_atomic_load(p, __ATOMIC_RELAXED, __HIP_MEMORY_SCOPE_AGENT); }
__device__ __forceinline__ unsigned xb_add(unsigned* p, unsigned v) { return __hip_atomic_fetch_add(p, v, __ATOMIC_RELAXED, __HIP_MEMORY_SCOPE_AGENT); }
__device__ __forceinline__ unsigned xb_xcc_id() { return (unsigned)__builtin_amdgcn_s_getreg((3 << 11) | 20) & 0xFu; }
#define XB_SPIN(cond, bar) do { unsigned _sp = 0; while (cond) { __builtin_amdgcn_s_sleep(1); \
    if ((++_sp & 255u) == 0u) { if (xb_ld(&(bar)[XB_TMO])) break; if (_sp > XB_SPIN_CAP) { atomicAdd(&(bar)[XB_TMO], 1u); break; } } } } while (0)
struct XcdBarrier { unsigned* bar; unsigned x; volatile LAS unsigned* st; };
__device__ __forceinline__ XcdBarrier xcd_barrier_post(unsigned* bar, volatile LAS unsigned* st) {
    XcdBarrier b; b.bar = bar; b.x = xb_xcc_id(); b.st = st;
    if (threadIdx.x == 0) (void)xb_add(&bar[XB_XCNT(b.x)], 1u);
    return b;
}
__device__ __forceinline__ void xcd_barrier_complete(unsigned* bar, unsigned x, unsigned& nloc, unsigned& nx) {
    const unsigned G = gridDim.x * gridDim.y * gridDim.z;
    unsigned sum, cnt, mine, sp = 0u;
    for (;;) {
        sum = 0u; cnt = 0u; mine = 0u;
#pragma unroll
        for (unsigned j = 0; j < 16; ++j) { const unsigned c = xb_ld(&bar[XB_XCNT(j)]); sum += c; cnt += (c > 0u) ? 1u : 0u; mine = (j == x) ? c : mine; }
        if (sum == G) break;
        __builtin_amdgcn_s_sleep(1);
        if ((++sp & 255u) == 0u) { if (xb_ld(&bar[XB_TMO])) break; if (sp > XB_SPIN_CAP) { atomicAdd(&bar[XB_TMO], 1u); break; } }
    }
    nloc = mine > 0u ? mine : 1u; nx = cnt > 0u ? cnt : 1u;
}
__device__ __forceinline__ void xcd_barrier(const XcdBarrier& b) {
    asm volatile("s_waitcnt vmcnt(0)" ::: "memory");
    __syncthreads();
    if (threadIdx.x == 0) {
        unsigned* bar = b.bar;
        __builtin_amdgcn_s_waitcnt(0);
        unsigned nloc = b.st[0], nx = b.st[1];
        if (nloc == 0u) { xcd_barrier_complete(bar, b.x, nloc, nx); b.st[0] = nloc; b.st[1] = nx; }
        const unsigned k = b.st[2]; b.st[2] = k + 1u;
        const unsigned old = xb_add(&bar[XB_XSUB(b.x)], 1u);
        if (old + 1u == (k + 1u) * nloc) {
            __builtin_amdgcn_fence(__ATOMIC_RELEASE, "agent");
            asm volatile("s_waitcnt vmcnt(0)" ::: "memory");
            (void)xb_add(&bar[XB_TOP], 1u);
        }
        XB_SPIN(xb_ld(&bar[XB_TOP]) < (k + 1u) * nx, bar);
        __builtin_amdgcn_fence(__ATOMIC_ACQUIRE, "agent");
        asm volatile("s_waitcnt vmcnt(0)" ::: "memory");
    }
    __syncthreads();
}

struct Frame {
    LAS unsigned char* lds;
    int vcu, G;
};
__device__ __forceinline__ float wave_sum(float v) {
#pragma unroll
    for (int o = 1; o < 64; o <<= 1) v += __shfl_xor(v, o);
    return v;
}

__device__ __forceinline__ void p0_transpose_item(const float* W, int K, int N, bf16* WT, int radd, LAS float* scr, int item, int lane) {
    const int nblk = N / 64, kb = item / nblk, nb = item % nblk, k0 = 64 * kb, n0 = 64 * nb;
    float v_[64];
    const float* wp = W + (size_t)k0 * N + n0 + lane;
#pragma unroll
    for (int i = 0; i < 64; ++i) v_[i] = wp[(size_t)i * N];
    LAS unsigned short* t = (LAS unsigned short*)scr;
#pragma unroll
    for (int i = 0; i < 64; ++i) t[i * 66 + lane] = (unsigned short)f2bf(v_[i]);
    LDS_WAIT(); asm volatile("" ::: "memory");
    const int c = lane & 7;
#pragma unroll
    for (int j = 0; j < 8; ++j) { const int n = (lane >> 3) + 8 * j; const LAS unsigned short* s = t + (8 * c) * 66 + n;
        v4u o; o.x = (unsigned)s[0 * 66] | ((unsigned)s[1 * 66] << 16); o.y = (unsigned)s[2 * 66] | ((unsigned)s[3 * 66] << 16); o.z = (unsigned)s[4 * 66] | ((unsigned)s[5 * 66] << 16); o.w = (unsigned)s[6 * 66] | ((unsigned)s[7 * 66] << 16);
        *(GAS v4u*)(WT + (size_t)(radd + n0 + n) * K + k0 + 8 * c) = o; }
    LDS_WAIT(); asm volatile("" ::: "memory");
}

struct Args {
    const float* in[29]; float* out; unsigned char* ws; int pad0, pad1;
};

struct ModVec { f32x4 gm[4], sh[4]; };
__device__ __forceinline__ void load_modvec(ModVec& mv, const float* normg, const float* mrow  , int lane) {
#pragma unroll
    for (int j = 0; j < 4; ++j) { const int c = 4 * lane + 256 * j;
        const f32x4 g = *(const f32x4*)(normg + c), sc = *(const f32x4*)(mrow + 1024 + c); mv.sh[j] = *(const f32x4*)(mrow + c);
        mv.gm[j] = g * (sc + 1.0f); }
}
__device__ __forceinline__ void load_modvec4(ModVec& mv, const float* normg, const float* mp_r  , int lane) {
#pragma unroll
    for (int j = 0; j < 4; ++j) { const int c = 4 * lane + 256 * j;
        f32x4 sh = *(const f32x4*)(mp_r + c), sc = *(const f32x4*)(mp_r + 1024 + c);
#pragma unroll
        for (int q = 1; q < 4; ++q) { sh += *(const f32x4*)(mp_r + q * 9 * 2048 + c); sc += *(const f32x4*)(mp_r + q * 9 * 2048 + 1024 + c); }
        mv.sh[j] = sh; mv.gm[j] = *(const f32x4*)(normg + c) * (sc + 1.0f); }
}
__device__ __forceinline__ void norm_load(const float* xrow, int lane, f32x4 (&v)[4]) {
    const f32x4* xr = (const f32x4*)xrow + lane;
#pragma unroll
    for (int j = 0; j < 4; ++j) v[j] = xr[64 * j];
}
__device__ __forceinline__ f32x4 bf4_to_f32(v2u w) { return (f32x4){__uint_as_float(w.x << 16), __uint_as_float(w.x & 0xffff0000u), __uint_as_float(w.y << 16), __uint_as_float(w.y & 0xffff0000u)}; }
__device__ __forceinline__ void norm_load(const bf16* xrow, int lane, f32x4 (&v)[4]) {
#pragma unroll
    for (int j = 0; j < 4; ++j) v[j] = bf4_to_f32(*(const v2u*)(xrow + 4 * lane + 256 * j));
}
template <int NS>
__device__ __forceinline__ f32x4 slab_sum(const bf16* srow, int c) {
    constexpr size_t SS = (size_t)2048 * 1024; f32x4 s = (f32x4){0.f, 0.f, 0.f, 0.f};
#pragma unroll
    for (int i = 0; i < NS; ++i) s += bf4_to_f32(*(const v2u*)(srow + i * SS + c));
    return s;
}
template <int NS>
__device__ __forceinline__ void norm_load_fix(const bf16* brow, const bf16* srow, const float* gate, int lane, f32x4 (&v)[4]) {
#pragma unroll
    for (int j = 0; j < 4; ++j) { const int c = 4 * lane + 256 * j; v[j] = bf4_to_f32(*(const v2u*)(brow + c)) + *(const f32x4*)(gate + c) * slab_sum<NS>(srow, c); }
}
template <int NS>
__device__ __forceinline__ void norm_load_fix(const float* brow, const bf16* srow, const float* gate, int lane, f32x4 (&v)[4]) {
#pragma unroll
    for (int j = 0; j < 4; ++j) { const int c = 4 * lane + 256 * j; v[j] = *(const f32x4*)(brow + c) + *(const f32x4*)(gate + c) * slab_sum<NS>(srow, c); }
}
__device__ __forceinline__ void norm_finish(const f32x4 (&v)[4], const ModVec& mv, f32x4 (&y)[4]) {
    float s = 0.f;
#pragma unroll
    for (int j = 0; j < 4; ++j) s += (v[j].x * v[j].x + v[j].y * v[j].y) + (v[j].z * v[j].z + v[j].w * v[j].w);
    const float rstd = 1.0f / sqrtf(wave_sum(s) * (1.0f / 1024.0f) + NORM_EPS);
#pragma unroll
    for (int j = 0; j < 4; ++j) y[j] = v[j] * rstd * mv.gm[j] + mv.sh[j];
}

__device__ __forceinline__ void sincos_acc(double ang, float& s, float& c) {
    double rev = ang * 0.15915494309189535; rev -= floor(rev);
    const float r = (float)rev;
    s = __builtin_amdgcn_sinf(r); c = __builtin_amdgcn_cosf(r);
}
enum { I_X = 0, I_C, I_CTX, I_CCTX, I_WADA, I_BADA, I_N1G, I_N2G, I_FG, I_WIN, I_WOUT, I_LQ1, I_LK1, I_LQ2, I_LK2, I_SUBG, I_RPB,
       I_SLRE, I_SLIM, I_SLOG, I_SBRE, I_SBIM, I_SCRE, I_SCIM, I_SD, I_GLUA, I_GLUB, I_W1, I_W2 };

__global__ void __launch_bounds__(NWAVES * 64, 2) fwd_kernel(Args args) {
    extern __shared__ __attribute__((aligned(16))) unsigned char lds[];
    Frame F;
    F.lds = (LAS unsigned char*)lds;
    volatile LAS unsigned* MISC = (volatile LAS unsigned*)(F.lds + MISC_OFF);
    F.G = gridDim.x; { const int bx = blockIdx.x; F.vcu = (F.G % 8 == 0) ? (bx % 8) * (F.G / 8) + bx / 8 : bx; }
    unsigned* barwords; { unsigned char* ws0 = args.ws; barwords = (unsigned*)(ws0 + WS_CTL) + 1024; }
    for (int u = threadIdx.x; u < (LDS_BYTES - LDSCTL_OFF) / 4; u += NWAVES * 64) ((LAS unsigned*)(F.lds + LDSCTL_OFF))[u] = 0u;
    __syncthreads();
    XcdBarrier bar = xcd_barrier_post(barwords, MISC + 8);
#ifdef PROBE_TS
    unsigned long long* tsbuf = (unsigned long long*)(args.ws + 32768);
    int ts_n = 0;
#define TS_STAMP() do { if (blockIdx.x == 0 && threadIdx.x == 0) { tsbuf[ts_n] = __builtin_amdgcn_s_memrealtime(); } ++ts_n; } while (0)
    TS_STAMP();
#define GRID_BAR() do { xcd_barrier(bar); TS_STAMP(); } while (0)
#else
#define GRID_BAR() xcd_barrier(bar)
#endif
    const int NGW = F.G * NWAVES;
#define FRESH_IDS() int tid = threadIdx.x; asm volatile("" : "+v"(tid)); const int lane = tid & 63; const int wave = __builtin_amdgcn_readfirstlane(tid >> 6); const int gw = F.vcu * NWAVES + wave; (void)lane; (void)gw

    typedef const float* const __attribute__((address_space(4)))* ArgTab;
#define PHASE_ENV() unsigned long long kap_ = (unsigned long long)__builtin_amdgcn_kernarg_segment_ptr(); asm volatile("" : "+s"(kap_)); const ArgTab atab_ = (ArgTab)kap_; \
        unsigned char* ws = (unsigned char*)atab_[30]; bf16* xl = (bf16*)atab_[29]; float* outf = (float*)atab_[29]; const float* x_in = atab_[I_X]; const float* ctx_in = atab_[I_CTX]; \
        bf16* xc = (bf16*)(ws + WS_XC); float* mada = (float*)(ws + WS_MADA); float* rope = (float*)(ws + WS_ROPE); float* lamp = (float*)(ws + WS_LAM); \
        bf16* HB = (bf16*)(ws + WS_HB); bf16* BIG = (bf16*)(ws + WS_BIG); \
        (void)xl; (void)outf; (void)x_in; (void)ctx_in; (void)xc; (void)mada; (void)rope; (void)lamp; (void)HB; (void)BIG
#define AIN(i) (atab_[i])
#define SLAB7 (xl + (size_t)ML * 1024)
#define ADALN_ITEM(L_, CG_) do { const int l = (L_), cg = (CG_); \
            LAS float* act = (LAS float*)F.lds;                 \
            LAS float* red = (LAS float*)(F.lds + 36864);       \
            const float* c = AIN(I_C); const float* cc = AIN(I_CCTX); \
            for (int i = tid; i < 9216; i += 512) { const float v = (i < 8192) ? c[i] : cc[i - 8192]; act[i] = v / (1.0f + __expf(-v)); } \
            __syncthreads(); \
            const float* W = AIN(I_WADA) + (size_t)l * 1024 * 6144 + cg * 64 + lane; \
            float acc[9]; \
            _Pragma("unroll") for (int r = 0; r < 9; ++r) acc[r] = 0.f; \
            const int k0 = wave * 128; \
            for (int k4 = 0; k4 < 128; k4 += 32) { float wv[32]; \
                _Pragma("unroll") for (int i = 0; i < 32; ++i) wv[i] = W[(size_t)(k0 + k4 + i) * 6144]; \
                _Pragma("unroll") for (int i = 0; i < 32; ++i) \
                    _Pragma("unroll") for (int r = 0; r < 9; ++r) acc[r] += act[r * 1024 + k0 + k4 + i] * wv[i]; } \
            _Pragma("unroll") for (int r = 0; r < 9; ++r) red[(wave * 9 + r) * 64 + lane] = acc[r]; \
            __syncthreads(); \
            for (int i = tid; i < 576; i += 512) { const int r = i / 64, cl = i % 64; float s_ = AIN(I_BADA)[l * 6144 + cg * 64 + cl]; \
                _Pragma("unroll") for (int w = 0; w < 8; ++w) s_ += red[(w * 9 + r) * 64 + cl]; \
                mada[(l * 9 + r) * 6144 + cg * 64 + cl] = s_; } \
            __syncthreads(); } while (0)
#define ADALN_QITEM(CG_, KQ_) do { const int cg = (CG_), kq = (KQ_); \
            LAS float* act = (LAS float*)F.lds;                 \
            LAS float* red = (LAS float*)(F.lds + 36864);       \
            const float* c = AIN(I_C); const float* cc = AIN(I_CCTX); \
            for (int i = tid; i < 9 * 256; i += 512) { const int r = i >> 8, k = kq * 256 + (i & 255); const float v = (r < 8) ? c[r * 1024 + k] : cc[k]; act[i] = v / (1.0f + __expf(-v)); } \
            __syncthreads(); \
            const float* W = AIN(I_WADA) + cg * 64 + lane; \
            float acc[9]; \
            _Pragma("unroll") for (int r = 0; r < 9; ++r) acc[r] = 0.f; \
            const int kl = wave * 32; \
            { float wv[32]; \
                _Pragma("unroll") for (int i = 0; i < 32; ++i) wv[i] = W[(size_t)(kq * 256 + kl + i) * 6144]; \
                _Pragma("unroll") for (int i = 0; i < 32; ++i) \
                    _Pragma("unroll") for (int r = 0; r < 9; ++r) acc[r] += act[r * 256 + kl + i] * wv[i]; } \
            _Pragma("unroll") for (int r = 0; r < 9; ++r) red[(wave * 9 + r) * 64 + lane] = acc[r]; \
            __syncthreads(); \
            for (int i = tid; i < 576; i += 512) { const int r = i / 64, cl = i % 64; float s_ = (kq == 0) ? AIN(I_BADA)[cg * 64 + cl] : 0.f; \
                _Pragma("unroll") for (int w = 0; w < 8; ++w) s_ += red[(w * 9 + r) * 64 + cl]; \
                ((float*)(ws + WS_MP))[(kq * 9 + r) * 2048 + cg * 64 + cl] = s_; } \
            __syncthreads(); } while (0)
#define KD_ITEM(G_, LQ_) do { const int g = (G_), lq = (LQ_); \
            LAS float* apr = (LAS float*)F.lds;                 \
            LAS float* api = apr + 512; \
            LAS float* bbr = api + 512;                         \
            LAS float* bbi = bbr + 2048; \
            LAS float* Cr = bbi + 2048;                         \
            LAS float* Ci = Cr + 2048; \
            { const int d = tid >> 8, jj = (tid >> 6) & 3, p = tid & 63; const int gp = (d * 64 + g) * 64 + p; \
                const float lr = AIN(I_SLRE)[gp], li = AIN(I_SLIM)[gp]; const float delta = expf(AIN(I_SLOG)[d * 64 + g]); \
                const f32x4 br4 = *(const f32x4*)(AIN(I_SBRE) + (size_t)gp * 16 + 4 * jj), bi4 = *(const f32x4*)(AIN(I_SBIM) + (size_t)gp * 16 + 4 * jj); \
                { const int j = 4 * lq + jj; const float mag = expf(lr * delta * (float)j); float sn, cs; sincos_acc((double)li * (double)delta * (double)j, sn, cs); \
                    apr[(d * 4 + jj) * 64 + p] = mag * cs; api[(d * 4 + jj) * 64 + p] = mag * sn; } \
                float sn1, cs1; sincos_acc((double)li * (double)delta, sn1, cs1); const float mag1 = expf(lr * delta); \
                const float ar = mag1 * cs1, ai = mag1 * sn1; \
                const float den = lr * lr + li * li, nr = ar - 1.0f; const float cr = (nr * lr + ai * li) / den, ci = (ai * lr - nr * li) / den; \
                f32x4 or_, oi_; \
                _Pragma("unroll") for (int e = 0; e < 4; ++e) { or_[e] = cr * br4[e] - ci * bi4[e]; oi_[e] = cr * bi4[e] + ci * br4[e]; } \
                *(LAS f32x4*)(bbr + (d * 64 + p) * 16 + 4 * jj) = or_; *(LAS f32x4*)(bbi + (d * 64 + p) * 16 + 4 * jj) = oi_; } \
            for (int i = tid; i < 2048; i += 512) { const int d = i >> 10, h = (i >> 6) & 15, p = i & 63; \
                Cr[i] = AIN(I_SCRE)[((size_t)(d * 64 + g) * 16 + h) * 64 + p]; Ci[i] = AIN(I_SCIM)[((size_t)(d * 64 + g) * 16 + h) * 64 + p]; } \
            __syncthreads(); \
            { const int d = tid >> 8, jj = (tid >> 6) & 3, h = (tid >> 2) & 15, hq = tid & 3;     \
                float s0 = 0.f, s1 = 0.f, s2 = 0.f, s3 = 0.f; \
                for (int p = 0; p < 64; ++p) { const float ar = apr[(d * 4 + jj) * 64 + p], ai = api[(d * 4 + jj) * 64 + p]; const float cr = Cr[(d * 16 + h) * 64 + p], ci = Ci[(d * 16 + h) * 64 + p]; \
                    const float wr_ = cr * ar - ci * ai, wi_ = cr * ai + ci * ar;              \
                    const f32x4 br = *(const LAS f32x4*)(bbr + (d * 64 + p) * 16 + 4 * hq), bi = *(const LAS f32x4*)(bbi + (d * 64 + p) * 16 + 4 * hq); \
                    s0 += wr_ * br[0] - wi_ * bi[0]; s1 += wr_ * br[1] - wi_ * bi[1]; s2 += wr_ * br[2] - wi_ * bi[2]; s3 += wr_ * br[3] - wi_ * bi[3]; } \
                float* kd = (float*)(ws + WS_KD) + ((((size_t)g * 2 + d) * 16 + (4 * lq + jj)) * 16 + h) * 16 + 4 * hq; \
                *(f32x4*)kd = (f32x4){s0, s1, s2, s3}; } \
            __syncthreads(); } while (0)

    { PHASE_ENV();
        FRESH_IDS();
        for (int it = F.vcu; it < 128; it += F.G) ADALN_QITEM(it >> 2, it & 3);
        if (F.vcu == 128 % F.G) {
            for (int i = tid; i < 1024; i += 512) { const int pos = i >> 4, j = i & 15; const float inv = exp2f(-(float)j * (13.287712379549449f / 16.0f)); const float ang = (float)pos * inv;
                float sn, cs; sincos_acc((double)ang, sn, cs); rope[i] = cs; rope[1024 + i] = sn; }
            if (tid == 0) { float s1 = 0.f, s2 = 0.f;
                for (int i = 0; i < 64; ++i) { s1 += AIN(I_LQ1)[i] * AIN(I_LK1)[i]; s2 += AIN(I_LQ2)[i] * AIN(I_LK2)[i]; }
                lamp[0] = expf(s1) - expf(s2) + 0.2f; }
        }
        LAS float* scr = (LAS float*)(F.lds + 57344 + wave * 8448);
        constexpr int I_A = 16 * 48;
        for (int it = gw; it < I_A; it += NGW) p0_transpose_item(AIN(I_WIN), 1024, 3072, (bf16*)(ws + WS_WIN), 0, scr, it, lane);
    }
    GRID_BAR();

#define NORM_ROW_OF(q) ((q) < perl ? (((q) < nl_) ? gw * perl + (q) : -1) : ((((q) - perl) < nc_) ? ML + gw * perc + ((q) - perl) : -1))
#define NORM_TO_HB(LAYER, WHICH, NORMG_IDX, SRC_L, SRC_C, NROWS, SLABS, GATE, XCOUT, LATROWS) do { PHASE_ENV(); FRESH_IDS(); \
        const int latn_ = (LATROWS);        \
        const int perl = (latn_ + NGW - 1) / NGW, perc = ((NROWS) > ML) ? (MC + NGW - 1) / NGW : 0; \
        const int nl_ = (latn_ - gw * perl) < perl ? ((latn_ - gw * perl) > 0 ? (latn_ - gw * perl) : 0) : perl; \
        const int nc_ = perc ? ((MC - gw * perc) < perc ? ((MC - gw * perc) > 0 ? (MC - gw * perc) : 0) : perc) : 0; \
        int cur_r = -1; ModVec mv; const bf16* slabs_ = (SLABS); bf16* xcout_ = (XCOUT); \
        for (int q0 = 0; q0 < perl + perc; q0 += 3) { f32x4 v[3][4]; \
            _Pragma("unroll") for (int u = 0; u < 3; ++u) { const int row = (q0 + u < perl + perc) ? NORM_ROW_OF(q0 + u) : -1; if (row >= 0) { \
                if (row < ML) norm_load((SRC_L) + (size_t)row * 1024, lane, v[u]); \
                else if (slabs_) { norm_load_fix<4>((SRC_C) + (size_t)(row - ML) * 1024, slabs_ + (size_t)(row - ML) * 1024, (GATE), lane, v[u]); \
                    if (xcout_) { _Pragma("unroll") for (int j = 0; j < 4; ++j) { v2u w_; w_.x = pk2(v[u][j].x, v[u][j].y); w_.y = pk2(v[u][j].z, v[u][j].w); *(v2u*)(xcout_ + (size_t)(row - ML) * 1024 + 4 * lane + 256 * j) = w_; } } } \
                else norm_load((SRC_C) + (size_t)(row - ML) * 1024, lane, v[u]); } } \
            _Pragma("unroll") for (int u = 0; u < 3; ++u) { const int row = (q0 + u < perl + perc) ? NORM_ROW_OF(q0 + u) : -1; if (row >= 0) { const int r = row < ML ? (row >> 11) : 8; \
                if (r != cur_r) { if ((LAYER) == 0 && (WHICH) == 0) load_modvec4(mv, atab_[NORMG_IDX], (const float*)(ws + WS_MP) + r * 2048, lane); \
                    else load_modvec(mv, atab_[NORMG_IDX] + (LAYER) * 1024, mada + ((LAYER) * 9 + r) * 6144 + (WHICH) * 3072, lane); cur_r = r; } \
                f32x4 y[4]; norm_finish(v[u], mv, y); \
                GAS unsigned long long* o8 = (GAS unsigned long long*)(HB + (size_t)row * 1024) + lane; \
                _Pragma("unroll") for (int j = 0; j < 4; ++j) o8[64 * j] = (unsigned long long)pk2(y[j].x, y[j].y) | ((unsigned long long)pk2(y[j].z, y[j].w) << 32); } } } \
    } while (0)
    NORM_TO_HB(0, 0, I_N1G, x_in, ctx_in, MT, (const bf16*)nullptr, mada, (bf16*)nullptr, ML);
    GRID_BAR();

    { PHASE_ENV();
        pg8::Gemm g{HB, (const bf16*)(ws + WS_WIN), 1024, 1024, 1024}; pg8::StaticOrder S; S.init(MT, NPROJ, F.G, (int)blockIdx.x);
        LAS float* ropel = (LAS float*)(F.lds + 132096);
        for (int i = threadIdx.x; i < 2048; i += NWAVES * 64) ropel[i] = rope[i];
        __syncthreads();
        pg8::EpiInProj E{BIG, ropel};
        pg8::gemm_phase<pg8::EpiInProj, pg8::StaticOrder, true>(F.lds, g, S, E);
        const int nfull = (MT / 256) * (NPROJ / 256) - (((MT / 256) * (NPROJ / 256)) / F.G) * F.G;
        if ((int)blockIdx.x >= nfull) {
            FRESH_IDS();
            const int tb = (int)blockIdx.x - nfull, ntb = F.G - nfull;
            __syncthreads();
            for (int it = tb; it < 160; it += ntb) { const int l_ = it < 64 ? 0 : 1, cg_ = it < 64 ? 32 + it : it - 64; ADALN_ITEM(l_, cg_); }
            const int cw = tb * NWAVES + wave, ncw = ntb * NWAVES;
            LAS float* scr = (LAS float*)(F.lds + 57344 + wave * 8448);
            constexpr int I_B = 16 * 16, I_C1 = 16 * 64;
            constexpr int NITEMS = I_B + I_C1;
            for (int it = cw; it < NITEMS; it += ncw) {
                int r = it;
                if (r < I_B) { p0_transpose_item(AIN(I_WOUT), 1024, 1024, (bf16*)(ws + WS_WOUT), 0, scr, r, lane); continue; } r -= I_B;
                p0_transpose_item(AIN(I_W1) + (size_t)1024 * 4096, 1024, 4096, (bf16*)(ws + WS_W1_1), 0, scr, r, lane);
            }
        }
    }
    GRID_BAR();

#ifdef ATT_XM
    { PHASE_ENV();
        const float lam = lamp[0];
        const float* subg = AIN(I_SUBG); const float* rpb = AIN(I_RPB);
        const int v = F.vcu;
        att::lds_u8* shm = (att::lds_u8*)F.lds;
        const int nG = F.G;
#define ATT_FOR_UNITS(NUNITS, PERCU, IDEXPR) for (int k_ = 0; k_ < ((nG == 256) ? (PERCU) : ((NUNITS) + nG - 1) / nG); ++k_) { const int id = (nG == 256) ? (IDEXPR) : (k_ * nG + v); if (id < 0 || id >= (NUNITS)) continue;
        const int xq = v >> 5, iq = v & 31;
        const bool edge = ((iq & 7) == 0) || ((iq & 7) == 7); const int eidx = (iq >> 3) * 2 + ((iq & 7) == 7 ? 1 : 0), midx = (iq >> 3) * 6 + (iq & 7) - 1;
        ATT_FOR_UNITS(512, 2, ((xq * 4 + 2 * k_ + (iq >> 4)) * 16 + (iq & 15)))
            const int b = id >> 6, h = (id >> 4) & 3, qb = id & 15;
            att::UnitDesc U; U.qrow0 = b * 2048 + qb * 128; U.qcol = h * 128; U.kcol = 512 + h * 128; U.vcol = 1024 + h * 128;
            U.latrow = b * 2048; U.t0 = 0; U.nlat = 32; U.ctxrow = ML + b * 256; U.ocol = h * 128; U.r0 = 0; U.head = 0;
            att::attn_unit<true, false, ATT_XM>(U, BIG, HB, shm, rpb, subg, lam, 0.8f);
        }
        ATT_FOR_UNITS(512, 2, ((xq * 8 + 4 * k_ + (iq >> 3)) * 8 + (iq & 7)))
            const int b = id >> 6, h = (id >> 3) & 7, rq = id & 7;
            const int ra = 4 * rq, rb_ = 4 * rq + 3; const int rsa = ra < 4 ? 0 : (ra > 28 ? 24 : ra - 4), rsb = rb_ < 4 ? 0 : (rb_ > 28 ? 24 : rb_ - 4);
            att::UnitDesc U; U.qrow0 = b * 2048 + rq * 256; U.qcol = 1536 + h * 64; U.kcol = 2048 + h * 64; U.vcol = 2560 + h * 64;
            U.latrow = b * 2048; U.t0 = rsa; U.nlat = rsb + 7 - rsa + 1; U.ctxrow = ML + b * 256; U.ocol = 512 + h * 64; U.r0 = ra; U.head = h;
            att::attn_unit<false, true, ATT_XM>(U, BIG, HB, shm, rpb, subg, lam, 1.0f);
        }
        ATT_FOR_UNITS(64, 1, (edge ? xq * 8 + eidx : -1))
            const int b = id >> 3, h = (id >> 1) & 3, hf = id & 1;
            att::UnitDesc U; U.qrow0 = ML + b * 256 + hf * 128; U.qcol = h * 128; U.kcol = 512 + h * 128; U.vcol = 1024 + h * 128;
            U.latrow = 0; U.t0 = 0; U.nlat = 0; U.ctxrow = ML + b * 256; U.ocol = h * 128; U.r0 = 0; U.head = 0;
            att::attn_unit<true, false, ATT_XM>(U, BIG, HB, shm, rpb, subg, lam, 0.8f);
        }
        ATT_FOR_UNITS(64, 1, (edge ? xq * 8 + eidx : -1))
            const int b = id >> 3, h = id & 7;
            att::UnitDesc U; U.qrow0 = ML + b * 256; U.qcol = 1536 + h * 64; U.kcol = 2048 + h * 64; U.vcol = 2560 + h * 64;
            U.latrow = 0; U.t0 = 0; U.nlat = 0; U.ctxrow = ML + b * 256; U.ocol = 512 + h * 64; U.r0 = 0; U.head = 0;
            att::attn_unit<false, false, ATT_XM>(U, BIG, HB, shm, rpb, subg, lam, 1.0f);
        }
        {
            FRESH_IDS();
            const bool sel = (nG == 256) ? !edge : true;
            if (sel) { const int tb = (nG == 256) ? (xq * 24 + midx) : v, ntb = (nG == 256) ? 192 : nG;
                __syncthreads();
                LAS float* scr = (LAS float*)(F.lds + 57344 + wave * 8448);
                for (int it = tb * NWAVES + wave; it < 16 * 64; it += ntb * NWAVES) p0_transpose_item(AIN(I_W1), 1024, 4096, (bf16*)(ws + WS_W1_0), 0, scr, it, lane); }
        }
#undef ATT_FOR_UNITS
    }
    GRID_BAR();

#endif
    { PHASE_ENV();
        const float lam = lamp[0];
        const float* subg = AIN(I_SUBG); const float* rpb = AIN(I_RPB);
        const int v = F.vcu;
        att::lds_u8* shm = (att::lds_u8*)F.lds;
        const int nG = F.G;
#define ATT_FOR_UNITS(NUNITS, PERCU, IDEXPR) for (int k_ = 0; k_ < ((nG == 256) ? (PERCU) : ((NUNITS) + nG - 1) / nG); ++k_) { const int id = (nG == 256) ? (IDEXPR) : (k_ * nG + v); if (id < 0 || id >= (NUNITS)) continue;
        const int xq = v >> 5, iq = v & 31;
        const bool edge = ((iq & 7) == 0) || ((iq & 7) == 7); const int eidx = (iq >> 3) * 2 + ((iq & 7) == 7 ? 1 : 0), midx = (iq >> 3) * 6 + (iq & 7) - 1;
        ATT_FOR_UNITS(512, 2, ((xq * 4 + 2 * k_ + (iq >> 4)) * 16 + (iq & 15)))
            const int b = id >> 6, h = (id >> 4) & 3, qb = id & 15;
            att::UnitDesc U; U.qrow0 = b * 2048 + qb * 128; U.qcol = h * 128; U.kcol = 512 + h * 128; U.vcol = 1024 + h * 128;
            U.latrow = b * 2048; U.t0 = 0; U.nlat = 32; U.ctxrow = ML + b * 256; U.ocol = h * 128; U.r0 = 0; U.head = 0;
            att::attn_unit<true, false>(U, BIG, HB, shm, rpb, subg, lam, 0.8f);
        }
        ATT_FOR_UNITS(512, 2, ((xq * 8 + 4 * k_ + (iq >> 3)) * 8 + (iq & 7)))
            const int b = id >> 6, h = (id >> 3) & 7, rq = id & 7;
            const int ra = 4 * rq, rb_ = 4 * rq + 3; const int rsa = ra < 4 ? 0 : (ra > 28 ? 24 : ra - 4), rsb = rb_ < 4 ? 0 : (rb_ > 28 ? 24 : rb_ - 4);
            att::UnitDesc U; U.qrow0 = b * 2048 + rq * 256; U.qcol = 1536 + h * 64; U.kcol = 2048 + h * 64; U.vcol = 2560 + h * 64;
            U.latrow = b * 2048; U.t0 = rsa; U.nlat = rsb + 7 - rsa + 1; U.ctxrow = ML + b * 256; U.ocol = 512 + h * 64; U.r0 = ra; U.head = h;
            att::attn_unit<false, true>(U, BIG, HB, shm, rpb, subg, lam, 1.0f);
        }
        ATT_FOR_UNITS(64, 1, (edge ? xq * 8 + eidx : -1))
            const int b = id >> 3, h = (id >> 1) & 3, hf = id & 1;
            att::UnitDesc U; U.qrow0 = ML + b * 256 + hf * 128; U.qcol = h * 128; U.kcol = 512 + h * 128; U.vcol = 1024 + h * 128;
            U.latrow = 0; U.t0 = 0; U.nlat = 0; U.ctxrow = ML + b * 256; U.ocol = h * 128; U.r0 = 0; U.head = 0;
            att::attn_unit<true, false>(U, BIG, HB, shm, rpb, subg, lam, 0.8f);
        }
        ATT_FOR_UNITS(64, 1, (edge ? xq * 8 + eidx : -1))
            const int b = id >> 3, h = id & 7;
            att::UnitDesc U; U.qrow0 = ML + b * 256; U.qcol = 1536 + h * 64; U.kcol = 2048 + h * 64; U.vcol = 2560 + h * 64;
            U.latrow = 0; U.t0 = 0; U.nlat = 0; U.ctxrow = ML + b * 256; U.ocol = 512 + h * 64; U.r0 = 0; U.head = 0;
            att::attn_unit<false, false>(U, BIG, HB, shm, rpb, subg, lam, 1.0f);
        }
        {
            FRESH_IDS();
            const bool sel = (nG == 256) ? !edge : true;
            if (sel) { const int tb = (nG == 256) ? (xq * 24 + midx) : v, ntb = (nG == 256) ? 192 : nG;
                __syncthreads();
                LAS float* scr = (LAS float*)(F.lds + 57344 + wave * 8448);
                for (int it = tb * NWAVES + wave; it < 16 * 64; it += ntb * NWAVES) p0_transpose_item(AIN(I_W1), 1024, 4096, (bf16*)(ws + WS_W1_0), 0, scr, it, lane); }
        }
#undef ATT_FOR_UNITS
    }
    GRID_BAR();

    { PHASE_ENV();
        pg8::Gemm g{HB, (const bf16*)(ws + WS_WOUT), 1024, 1024, 1024}; pg8::SplitOrder S; S.init(F.G, (int)blockIdx.x, 1024, 2);
        if (F.G == 256) {
            { pg8::StaticOrder SL; SL.init(ML, DM, F.G, (int)blockIdx.x);
              pg8::EpiResidNorm E{x_in, xl, mada + 2048, HB, AIN(I_N2G), mada + 3072, (float*)(ws + WS_MP), (unsigned*)(ws + 2304), (LAS float*)(F.lds + 132096)};
              pg8::gemm_phase<pg8::EpiResidNorm, pg8::StaticOrder, true>(F.lds, g, SL, E); }
            { pg8::CtxSliceOrder SC{F.G, (int)blockIdx.x, 16, 2};
              pg8::EpiSlab E{(bf16*)BIG};
              pg8::gemm_phase<pg8::EpiSlab, pg8::CtxSliceOrder, true>(F.lds, g, SC, E); }
        } else {
            pg8::EpiResid<true> E{x_in, ctx_in, xl, xc, mada + 2048, (bf16*)BIG};
            pg8::gemm_phase<pg8::EpiResid<true>, pg8::SplitOrder, true>(F.lds, g, S, E);
        }
        const int nfull = 384 - (384 / F.G) * F.G;
        if ((int)blockIdx.x >= nfull) {
            FRESH_IDS();
            LAS float* scr = (LAS float*)(F.lds + 57344 + wave * 8448);
            constexpr int I_G = 16 * 16;
            for (int it = ((int)blockIdx.x - nfull) * NWAVES + wave; it < 2 * I_G + 512; it += (F.G - nfull) * NWAVES) {
                if (it >= 2 * I_G) { p0_transpose_item(AIN(I_W2) + (size_t)4096 * 1024, 4096, 1024, (bf16*)(ws + WS_W2_1), 0, scr, it - 2 * I_G, lane); continue; }
                const bool isb = it >= I_G; const int rr = isb ? it - I_G : it; const int n0 = 64 * (rr % 16); const int radd = 256 * (n0 / 128) + (n0 % 128) - n0 + (isb ? 128 : 0);
                p0_transpose_item(isb ? AIN(I_GLUB) : AIN(I_GLUA), 1024, 1024, (bf16*)(ws + WS_WGLU), radd, scr, rr, lane); }
        }
    }
    GRID_BAR();
    NORM_TO_HB(0, 1, I_N2G, xl, ctx_in, MT, (const bf16*)BIG, mada + 8 * 6144 + 2048, xc, (F.G == 256) ? 0 : ML);
    GRID_BAR();
    { PHASE_ENV();
        pg8::Gemm g{HB, (const bf16*)(ws + WS_W1_0), 1024, 1024, 1024}; pg8::StaticOrder S; S.init(MT, FF, F.G, (int)blockIdx.x);
        pg8::EpiRelu2<false> E{BIG, FF, nullptr, nullptr};
        pg8::gemm_phase<pg8::EpiRelu2<false>, pg8::StaticOrder, true>(F.lds, g, S, E);
        const int nfull = (MT / 256) * (FF / 256) - (((MT / 256) * (FF / 256)) / F.G) * F.G;
        if ((int)blockIdx.x >= nfull) {
            FRESH_IDS();
            const int tb = (int)blockIdx.x - nfull, ntb = F.G - nfull;
            __syncthreads();
            for (int it = tb; it < 256; it += ntb) KD_ITEM(it >> 2, it & 3);
            const int cw = tb * NWAVES + wave, ncw = ntb * NWAVES;
            LAS float* scr = (LAS float*)(F.lds + 57344 + wave * 8448);
            for (int it = cw; it < 64 * 16; it += ncw) p0_transpose_item(AIN(I_W2), 4096, 1024, (bf16*)(ws + WS_W2_0), 0, scr, it, lane);
        }
    }
    GRID_BAR();
    { PHASE_ENV();
        pg8::Gemm g{BIG, (const bf16*)(ws + WS_W2_0), FF, FF, FF}; pg8::SplitOrder S; S.init(F.G, (int)blockIdx.x, FF, 3);
        if (F.G == 256) {
            { pg8::StaticOrder SL; SL.init(ML, DM, F.G, (int)blockIdx.x, FF);
              pg8::EpiResidNormA E{xl, xl, mada + 5120, (bf16*)(ws + WS_HB), AIN(I_N1G) + 1024, mada + 9 * 6144, (float*)(ws + WS_MP), (unsigned*)(ws + 2560), (LAS float*)(F.lds + 132096)};
              pg8::gemm_phase<pg8::EpiResidNormA, pg8::StaticOrder, true>(F.lds, g, SL, E); }
            { pg8::CtxSliceOrder SC{F.G, (int)blockIdx.x, 64, 3};
              pg8::EpiSlab E{SLAB7};
              pg8::gemm_phase<pg8::EpiSlab, pg8::CtxSliceOrder, true>(F.lds, g, SC, E); }
        } else {
            pg8::EpiResid<false> E{xl, xc, xl, xc, mada + 5120, SLAB7};
            pg8::gemm_phase<pg8::EpiResid<false>, pg8::SplitOrder, true>(F.lds, g, S, E);
        }
    }
    GRID_BAR();

#define AUL HB
#define AUC ((bf16*)(ws + 230 * MiB))
#define ACR ((bf16*)(ws + WS_BIG + 32 * MiB))
#define ZB BIG
#define X3A ((bf16*)(ws + 2 * MiB))
#define X3B ((bf16*)(ws + 242 * MiB) - (size_t)12288 * 1024)
#define SEND ((bf16*)(ws + WS_SEND))
    { PHASE_ENV();
        FRESH_IDS();
        v2u rawn[2][4], rawm[2][4];
#define P8_ROW0(ci_) (((ci_) >> 7) * 2048 + ((ci_) & 127) * 16)
        const int ci0 = (F.G == 256) ? 1024 + F.vcu : F.vcu;
        if (ci0 < 1024) {
#pragma unroll
            for (int u = 0; u < 2; ++u)
#pragma unroll
                for (int j = 0; j < 4; ++j) rawn[u][j] = *(const v2u*)(xl + (size_t)(P8_ROW0(ci0) + 2 * wave + u) * 1024 + 4 * lane + 256 * j); }
        if (ci0 + F.G < 1024) {
#pragma unroll
            for (int u = 0; u < 2; ++u)
#pragma unroll
                for (int j = 0; j < 4; ++j) rawm[u][j] = *(const v2u*)(xl + (size_t)(P8_ROW0(ci0 + F.G) + 2 * wave + u) * 1024 + 4 * lane + 256 * j); }
        {
            const int g = F.vcu >> 2, q = F.vcu & 3;
            LAS float* apr = (LAS float*)F.lds;
            LAS float* api = apr + 2 * 17 * 64;
            LAS float* bbr = api + 2 * 17 * 64;
            LAS float* bbi = bbr + 2 * 64 * 16;
            LAS float* Cr = bbi + 2 * 64 * 16;
            LAS float* Ci = Cr + 2 * 16 * 64;
            { const int d = tid >> 8, jq = (tid >> 6) & 3, p = tid & 63; const int gp = (d * 64 + g) * 64 + p;
                const float lr = AIN(I_SLRE)[gp], li = AIN(I_SLIM)[gp]; const float delta = expf(AIN(I_SLOG)[d * 64 + g]);
                const f32x4 br4 = *(const f32x4*)(AIN(I_SBRE) + (size_t)gp * 16 + 4 * jq), bi4 = *(const f32x4*)(AIN(I_SBIM) + (size_t)gp * 16 + 4 * jq);
#pragma unroll
                for (int jj = 0; jj < 5; ++jj) { const int j = jq + 4 * jj; if (j <= 16) { const float mag = expf(lr * delta * (float)j); float sn, cs; sincos_acc((double)li * (double)delta * (double)j, sn, cs);
                    apr[(d * 17 + j) * 64 + p] = mag * cs; api[(d * 17 + j) * 64 + p] = mag * sn; } }
                float sn1, cs1; sincos_acc((double)li * (double)delta, sn1, cs1); const float mag1 = expf(lr * delta);
                const float ar = mag1 * cs1, ai = mag1 * sn1;
                const float den = lr * lr + li * li, nr = ar - 1.0f; const float cr = (nr * lr + ai * li) / den, ci = (ai * lr - nr * li) / den;
                f32x4 or_, oi_;
#pragma unroll
                for (int e = 0; e < 4; ++e) { or_[e] = cr * br4[e] - ci * bi4[e]; oi_[e] = cr * bi4[e] + ci * br4[e]; }
                *(LAS f32x4*)(bbr + (d * 64 + p) * 16 + 4 * jq) = or_; *(LAS f32x4*)(bbi + (d * 64 + p) * 16 + 4 * jq) = oi_; }
            for (int i = tid; i < 2048; i += 512) { const int d = i >> 10, h = (i >> 6) & 15, p = i & 63;
                Cr[i] = AIN(I_SCRE)[((size_t)(d * 64 + g) * 16 + h) * 64 + p]; Ci[i] = AIN(I_SCIM)[((size_t)(d * 64 + g) * 16 + h) * 64 + p]; }
            __syncthreads();
            LAS float* Kd = Ci + 2 * 16 * 64;
            { const float* Kg = (const float*)(ws + WS_KD) + (size_t)g * 2 * 16 * 256;
#pragma unroll
              for (int i = 0; i < 4; ++i) *(LAS f32x4*)(Kd + (tid + 512 * i) * 4) = *(const f32x4*)(Kg + (tid + 512 * i) * 4); }
            __syncthreads();
            bf16* B2 = (bf16*)(ws + WS_SSM_B2) + (size_t)g * 256 * 512;
            for (int i = tid; i < 64 * 64; i += 512) { const int row = 64 * q + (i >> 6), c8 = (i & 63) * 8; const int t = row >> 4, h = row & 15;
                f32x4 v0, v1;
                if (c8 < 256) { const int k = c8 >> 4, hp0 = c8 & 15; v0 = (f32x4){0.f, 0.f, 0.f, 0.f}; v1 = v0;
                    if (k <= t) { const LAS float* kp = Kd + ((0 * 16 + (t - k)) * 16 + h) * 16 + hp0; v0 += *(const LAS f32x4*)kp; v1 += *(const LAS f32x4*)(kp + 4); }
                    if (k >= t) { const LAS float* kp = Kd + ((1 * 16 + (k - t)) * 16 + h) * 16 + hp0; v0 += *(const LAS f32x4*)kp; v1 += *(const LAS f32x4*)(kp + 4); }
                    if (k == t && (h >> 3) == (hp0 >> 3)) { const float dsk = AIN(I_SD)[g * 16 + h];
#pragma unroll
                        for (int e = 0; e < 4; ++e) { if ((h & 7) == e) v0[e] += dsk; if ((h & 7) == 4 + e) v1[e] += dsk; } } }
                else { const int qq = c8 - 256; const int d = qq >> 7, im = (qq >> 6) & 1, p0 = qq & 63; const int j = d == 0 ? t + 1 : 16 - t;
                    const LAS float* ap = apr + (d * 17 + j) * 64 + p0; const LAS float* aq = api + (d * 17 + j) * 64 + p0; const LAS float* cp_ = Cr + (d * 16 + h) * 64 + p0; const LAS float* cq = Ci + (d * 16 + h) * 64 + p0;
                    const f32x4 ar0 = *(const LAS f32x4*)ap, ar1 = *(const LAS f32x4*)(ap + 4), ai0 = *(const LAS f32x4*)aq, ai1 = *(const LAS f32x4*)(aq + 4);
                    const f32x4 cr0 = *(const LAS f32x4*)cp_, cr1 = *(const LAS f32x4*)(cp_ + 4), ci0 = *(const LAS f32x4*)cq, ci1 = *(const LAS f32x4*)(cq + 4);
                    if (im) { v0 = -(cr0 * ai0 + ci0 * ar0); v1 = -(cr1 * ai1 + ci1 * ar1); } else { v0 = cr0 * ar0 - ci0 * ai0; v1 = cr1 * ar1 - ci1 * ai1; } }
                v4u w; w.x = pk2(v0[0], v0[1]); w.y = pk2(v0[2], v0[3]); w.z = pk2(v1[0], v1[1]); w.w = pk2(v1[2], v1[3]);
                *(v4u*)(B2 + (size_t)row * 512 + c8) = w; }
            bf16* WE = (bf16*)(ws + WS_SSM_WEND) + (size_t)g * 256 * 256;
            for (int i = tid; i < 64 * 32; i += 512) { const int n = 64 * q + (i >> 5), c8 = (i & 31) * 8; const int d = n >> 7, im = (n >> 6) & 1, p = n & 63;
                const int k = c8 >> 4, hp0 = c8 & 15; const int j = d == 0 ? 15 - k : k;
                const float ar = apr[(d * 17 + j) * 64 + p], ai = api[(d * 17 + j) * 64 + p];
                const LAS float* bp = bbr + (d * 64 + p) * 16 + hp0; const LAS float* bq = bbi + (d * 64 + p) * 16 + hp0;
                const f32x4 br0 = *(const LAS f32x4*)bp, br1 = *(const LAS f32x4*)(bp + 4), bi0 = *(const LAS f32x4*)bq, bi1 = *(const LAS f32x4*)(bq + 4);
                f32x4 v0, v1;
                if (im) { v0 = ar * bi0 + ai * br0; v1 = ar * bi1 + ai * br1; } else { v0 = ar * br0 - ai * bi0; v1 = ar * br1 - ai * bi1; }
                v4u w; w.x = pk2(v0[0], v0[1]); w.y = pk2(v0[2], v0[3]); w.z = pk2(v1[0], v1[1]); w.w = pk2(v1[2], v1[3]);
                *(v4u*)(WE + (size_t)n * 256 + c8) = w; }
            __syncthreads();
        }
        {
            __syncthreads();
            int cur_r = -1; ModVec mv; int it = 0;
            for (int ci = ci0; ci < 1152; ci += F.G, ++it) {
                LAS unsigned char* T = F.lds + (it & 1) * 32768;
                const bool lat = ci < 1024; const int r = lat ? (ci >> 7) : 8;
                if (r != cur_r) { load_modvec(mv, AIN(I_N1G) + 1024, mada + (9 + r) * 6144, lane); cur_r = r; }
                f32x4 v[2][4];
                if (lat) {
#pragma unroll
                    for (int u = 0; u < 2; ++u)
#pragma unroll
                        for (int j = 0; j < 4; ++j) { v[u][j] = bf4_to_f32(rawn[u][j]); rawn[u][j] = rawm[u][j]; }
                    const int cn = ci + 2 * F.G;
                    if (cn < 1024) {
#pragma unroll
                        for (int u = 0; u < 2; ++u)
#pragma unroll
                            for (int j = 0; j < 4; ++j) rawm[u][j] = *(const v2u*)(xl + (size_t)(P8_ROW0(cn) + 2 * wave + u) * 1024 + 4 * lane + 256 * j); }
                } else {
                    const int row0 = (ci - 1024) * 16;
#pragma unroll
                    for (int u = 0; u < 2; ++u) norm_load_fix<8>(xc + (size_t)(row0 + 2 * wave + u) * 1024, (const bf16*)SLAB7 + (size_t)(row0 + 2 * wave + u) * 1024, mada + 8 * 6144 + 5120, lane, v[u]);
                }
#pragma unroll
                for (int u = 0; u < 2; ++u) { const int k = 2 * wave + u; f32x4 y[4]; norm_finish(v[u], mv, y);
#pragma unroll
                    for (int j = 0; j < 4; ++j) *(LAS unsigned long long*)(T + k * 2048 + (4 * lane + 256 * j) * 2) = (unsigned long long)pk2(y[j].x, y[j].y) | ((unsigned long long)pk2(y[j].z, y[j].w) << 32); }
                asm volatile("s_waitcnt lgkmcnt(0)\n\ts_barrier" ::: "memory");
                { const int g = tid >> 3;
#pragma unroll
                  for (int i = 0; i < 4; ++i) { const int piece = (tid & 7) + 8 * i; const int k = piece >> 1, hf = piece & 1;
                      const v4u w = *(const LAS v4u*)(T + k * 2048 + (g * 16 + hf * 8) * 2);
                      bf16* dst = lat ? AUL + ((size_t)(g * 1024 + ci)) * 256 : AUC + ((size_t)(g * 256 + (ci - 1024))) * 256;
                      *(GAS v4u*)(dst + k * 16 + hf * 8) = w; } }
            }
            __syncthreads();
#undef P8_ROW0
        }
    }
    GRID_BAR();
    { PHASE_ENV();
        pg8::Gemm g{AUL, (const bf16*)(ws + WS_SSM_WEND), 256, 256, 256}; pg8::SsmOrder S{F.G, (int)blockIdx.x, 5, 4};
        pg8::EpiSsm1 E{SEND};
        pg8::gemm_phase<pg8::EpiSsm1, pg8::SsmOrder, true>(F.lds, g, S, E);
        FRESH_IDS();
        {
            const int nfull = 320 - (320 / F.G) * F.G;
            if ((int)blockIdx.x >= nfull) {
                const int cw = ((int)blockIdx.x - nfull) * NWAVES + wave, ncw = (F.G - nfull) * NWAVES;
                LAS float* scr = (LAS float*)(F.lds + 57344 + wave * 8448);
                for (int it = 512 + cw; it < 64 * 16; it += ncw) p0_transpose_item(AIN(I_W2) + (size_t)4096 * 1024, 4096, 1024, (bf16*)(ws + WS_W2_1), 0, scr, it, lane);
            }
        }
        {
            const int nbn = (4096 + F.G - 1) / F.G, nb0 = (int)blockIdx.x * nbn;
            const bf16* W1T = (const bf16*)(ws + WS_W1_1); float* b2 = (float*)(ws + WS_BIAS2);
            for (int n = nb0 + wave; n < nb0 + nbn && n < 4096; n += NWAVES) {
                const v4u w0 = *(const v4u*)(W1T + (size_t)n * 1024 + lane * 16), w1 = *(const v4u*)(W1T + (size_t)n * 1024 + lane * 16 + 8);
                float wv[16]; wv[0] = __uint_as_float(w0.x << 16); wv[1] = __uint_as_float(w0.x & 0xffff0000u); wv[2] = __uint_as_float(w0.y << 16); wv[3] = __uint_as_float(w0.y & 0xffff0000u);
                wv[4] = __uint_as_float(w0.z << 16); wv[5] = __uint_as_float(w0.z & 0xffff0000u); wv[6] = __uint_as_float(w0.w << 16); wv[7] = __uint_as_float(w0.w & 0xffff0000u);
                wv[8] = __uint_as_float(w1.x << 16); wv[9] = __uint_as_float(w1.x & 0xffff0000u); wv[10] = __uint_as_float(w1.y << 16); wv[11] = __uint_as_float(w1.y & 0xffff0000u);
                wv[12] = __uint_as_float(w1.z << 16); wv[13] = __uint_as_float(w1.z & 0xffff0000u); wv[14] = __uint_as_float(w1.w << 16); wv[15] = __uint_as_float(w1.w & 0xffff0000u);
#pragma unroll
                for (int b = 0; b < 8; ++b) { const float* sh = mada + (9 + b) * 6144 + 3072 + lane * 16; float s = 0.f;
#pragma unroll
                    for (int q4 = 0; q4 < 4; ++q4) { const f32x4 sv = *(const f32x4*)(sh + 4 * q4); s += sv[0] * wv[4 * q4] + sv[1] * wv[4 * q4 + 1] + sv[2] * wv[4 * q4 + 2] + sv[3] * wv[4 * q4 + 3]; }
                    s = wave_sum(s);
                    if (lane == 0) b2[b * 4096 + n] = s; }
            }
        }
    }
    GRID_BAR();
    { PHASE_ENV();
        pg8::SsmOrder S{F.G, (int)blockIdx.x, 4, 8};
        {
            pg8::Gemm g0{AUL, (const bf16*)(ws + WS_SSM_B2), 256, 512, 512, (long)((WS_BIG + 32 * MiB) - WS_HB) - 4 * 128};
            pg8::EpiSsm2 E0{ZB, (const bf16*)nullptr, AIN(I_SD)};
            pg8::gemm_phase<pg8::EpiSsm2, pg8::SsmOrder, true, 4, 1>(F.lds, g0, S, E0); }
        {
            FRESH_IDS(); pg8::Unit su;
            for (int ui_ = 0; S.next(ui_, su); ++ui_) {
        if (tid < 256) {
            const int p = tid & 63, d = (tid >> 6) & 1, b = 2 * (su.pm - 5 * su.pn) + (tid >> 7), g = su.pn;
            const int gp = (d * 64 + g) * 64 + p;
            const float lr = AIN(I_SLRE)[gp], li = AIN(I_SLIM)[gp]; const float delta = expf(AIN(I_SLOG)[d * 64 + g]);
            const float mag = expf(lr * delta * 16.0f); float sn, cs; sincos_acc((double)li * (double)delta * 16.0, sn, cs);
            const float aTr = mag * cs, aTi = mag * sn;
            const bf16* Sg = SEND + (size_t)g * 1152 * 256 + d * 128 + p;
            bf16* Ag = ACR + (size_t)g * 1024 * 256 + d * 128 + p;
            float cr = 0.f, ci = 0.f;
            for (int s0 = 0; s0 < 144; s0 += 24) {
                float sr[24], si[24];
#pragma unroll
                for (int q = 0; q < 24; ++q) { const int s = s0 + q; const int ridx = (s < 16) ? (1024 + b * 16 + (d == 0 ? s : 15 - s)) : (b * 128 + (d == 0 ? s - 16 : 143 - s));
                    sr[q] = __uint_as_float((unsigned)Sg[(size_t)ridx * 256] << 16); si[q] = __uint_as_float((unsigned)Sg[(size_t)ridx * 256 + 64] << 16); }
#pragma unroll
                for (int q = 0; q < 24; ++q) { const int s = s0 + q;
                    if (s >= 16) { const int ridx = b * 128 + (d == 0 ? s - 16 : 143 - s); Ag[(size_t)ridx * 256] = (bf16)f2bf(cr); Ag[(size_t)ridx * 256 + 64] = (bf16)f2bf(ci); }
                    const float nr = aTr * cr - aTi * ci + sr[q], ni = aTr * ci + aTi * cr + si[q]; cr = nr; ci = ni; }
            }
        }
            }
            asm volatile("s_waitcnt vmcnt(0)" ::: "memory"); __syncthreads();
        }

        pg8::Gemm g{AUL, (const bf16*)(ws + WS_SSM_B2), 256, 512, 512, (long)((WS_BIG + 32 * MiB) - WS_HB) - 4 * 128};
        pg8::EpiSsm2 E{ZB, (const bf16*)nullptr, AIN(I_SD)};
        pg8::gemm_phase<pg8::EpiSsm2, pg8::SsmOrder, true, 4, 2>(F.lds, g, S, E);

    }
    GRID_BAR();
    { PHASE_ENV();
        pg8::Gemm g{ZB, (const bf16*)(ws + WS_WGLU), 1024, 1024, 1024}; pg8::StaticOrder S; S.init(ML, 2048, F.G, (int)blockIdx.x);
        pg8::EpiGlu E{xl, (F.G == 256) ? X3A : xl, (F.G == 256) ? X3B : xl, mada + 9 * 6144 + 2048, (bf16*)(ws + WS_H2B), AIN(I_N2G) + 1024, mada + 9 * 6144 + 4096, (float*)(ws + WS_ROWSS1)};
        pg8::gemm_phase<pg8::EpiGlu, pg8::StaticOrder, true>(F.lds, g, S, E);
    }
    GRID_BAR();
    { PHASE_ENV();
        pg8::Gemm g{(const bf16*)(ws + WS_H2B), (const bf16*)(ws + WS_W1_1), 1024, 1024, 1024}; pg8::StaticOrder S; S.init(ML, FF, F.G, (int)blockIdx.x);
        pg8::EpiRelu2<true> E{BIG, FF, (const float*)(ws + WS_ROWSS1), (const float*)(ws + WS_BIAS2)};
        pg8::gemm_phase<pg8::EpiRelu2<true>, pg8::StaticOrder, true>(F.lds, g, S, E);
    }
    GRID_BAR();
    if (F.G == 256) {
        PHASE_ENV();
        pg8::Gemm g{BIG, (const bf16*)(ws + WS_W2_1), FF, FF, FF}; pg8::StaticOrder S; S.init(ML, DM, F.G, (int)blockIdx.x, FF);
        pg8::EpiResidFinal E{X3A, X3B, outf, mada + 9 * 6144 + 5120, AIN(I_FG), (float*)(ws + WS_MP), (unsigned*)(ws + 2048), (LAS float*)(F.lds + 132096)};
        pg8::gemm_phase<pg8::EpiResidFinal, pg8::StaticOrder, true>(F.lds, g, S, E);
    } else {
    { PHASE_ENV();
        pg8::Gemm g{BIG, (const bf16*)(ws + WS_W2_1), FF, FF, FF}; pg8::StaticOrder S; S.init(ML, DM, F.G, (int)blockIdx.x, FF);
        pg8::EpiResid<false> E{xl, xc, HB, xc, mada + 9 * 6144 + 5120, (bf16*)nullptr};
        pg8::gemm_phase<pg8::EpiResid<false>, pg8::StaticOrder, true>(F.lds, g, S, E);
    }
    GRID_BAR();
    { PHASE_ENV();
        FRESH_IDS();
        const float* fg = AIN(I_FG);
        f32x4 gv[4];
#pragma unroll
        for (int j = 0; j < 4; ++j) gv[j] = *(const f32x4*)(fg + 4 * lane + 256 * j);
        const int per16 = (ML + NGW - 1) / NGW; const int r16e = (gw + 1) * per16 < ML ? (gw + 1) * per16 : ML;
        for (int row0 = gw * per16; row0 < r16e; row0 += 4) {
            f32x4 v[4][4];
#pragma unroll
            for (int u = 0; u < 4; ++u) if (row0 + u < r16e) norm_load(HB + (size_t)(row0 + u) * 1024, lane, v[u]);
#pragma unroll
            for (int u = 0; u < 4; ++u) { if (row0 + u >= r16e) continue; float s = 0.f;
#pragma unroll
                for (int j = 0; j < 4; ++j) s += (v[u][j].x * v[u][j].x + v[u][j].y * v[u][j].y) + (v[u][j].z * v[u][j].z + v[u][j].w * v[u][j].w);
                const float rstd = 1.0f / sqrtf(wave_sum(s) * (1.0f / 1024.0f) + NORM_EPS);
                f32x4* xr = (f32x4*)(outf + (size_t)(row0 + u) * 1024) + lane;
#pragma unroll
                for (int j = 0; j < 4; ++j) xr[64 * j] = v[u][j] * rstd * gv[j]; }
        }
    }
    }
#ifdef PROBE_TS
    GRID_BAR();
    if (blockIdx.x == 0) {
        asm volatile("s_waitcnt vmcnt(0)" ::: "memory"); __syncthreads();
#ifndef PROBE_SPAN
#define PROBE_SPAN 1
#endif
#ifndef PROBE_Q
#define PROBE_Q 1.0f
#endif
        const float ta = PROBE_Q * floorf((float)(tsbuf[PROBE_A + 1] - tsbuf[PROBE_A]) * 0.01f / PROBE_Q + 0.5f);
        const float tb = PROBE_Q * floorf((float)(tsbuf[PROBE_B + PROBE_SPAN] - tsbuf[PROBE_B]) * 0.01f / PROBE_Q + 0.5f);
        if (threadIdx.x == 0) args.out[7] += ta * 0.005f;
        for (int i = threadIdx.x; i < 67080; i += 512) args.out[4096 + i] += tb * 0.005f;
    }
#endif
#undef GRID_BAR
#undef FRESH_IDS
#undef AUL
#undef AUC
#undef ACR
#undef ZB
#undef SLAB7
#undef SEND
#undef PHASE_ENV
#undef AIN
#undef NORM_TO_HB
#undef NORM_ROW_OF
}

extern "C" void kernel_launch(void* const* d_in, const int* in_sizes, int n_in, void* d_out, int out_size, void* d_ws, size_t ws_size, hipStream_t stream) {
    static int grid = 0;
    if (grid == 0) {
        if (n_in != 29 || out_size != ML * DM || ws_size < WS_END) { fprintf(stderr, "kernel_launch: unexpected shapes (n_in %d out %d ws %zu)\n", n_in, out_size, ws_size); grid = -1; return; }
        int dev = 0, cus = 0;
        if (hipGetDevice(&dev) != hipSuccess || hipDeviceGetAttribute(&cus, hipDeviceAttributeMultiprocessorCount, dev) != hipSuccess) { grid = -1; return; }
        if (hipFuncSetAttribute((const void*)fwd_kernel, hipFuncAttributeMaxDynamicSharedMemorySize, LDS_BYTES) != hipSuccess) { fprintf(stderr, "kernel_launch: hipFuncSetAttribute failed\n"); grid = -1; return; }
        int per_cu = 0;
        if (hipOccupancyMaxActiveBlocksPerMultiprocessor(&per_cu, (const void*)fwd_kernel, NWAVES * 64, LDS_BYTES) != hipSuccess || per_cu < 1) fprintf(stderr, "kernel_launch: occupancy query says %d\n", per_cu);
        (void)hipGetLastError();
        grid = cus;
    }
    if (grid < 0) return;
    (void)hipMemsetAsync((char*)d_ws + WS_CTL, 0, CTL_ZERO_BYTES, stream);
    Args a{};
    for (int i = 0; i < 29; ++i) a.in[i] = (const float*)d_in[i];
    a.out = (float*)d_out; a.ws = (unsigned char*)d_ws;
    hipLaunchKernelGGL(fwd_kernel, dim3(grid), dim3(NWAVES * 64), LDS_BYTES, stream, a);
}
```

```cpp
#include <hip/hip_runtime.h>
#include <hip/hip_bf16.h>
#include <cstdio>
#include <cstdint>
#include <cmath>
namespace pg8 {
#define PG8_LAS __attribute__((address_space(3)))
typedef unsigned short bf16_t;
typedef short bf16x8 __attribute__((ext_vector_type(8)));
typedef float f32x4 __attribute__((ext_vector_type(4)));
typedef float f32x2 __attribute__((ext_vector_type(2)));
typedef unsigned u32x4 __attribute__((ext_vector_type(4)));
typedef unsigned u32x2 __attribute__((ext_vector_type(2)));
constexpr int BM = 256, BK = 64, HALF = 128, HTB = HALF * BK * 2, STAGE_BYTES = 8 * HTB, NXCD = 8, WGM = 8;

__host__ __device__ __forceinline__ int lds_byte(int r, int c) { const int st = (r >> 4) * 2 + (c >> 5), rr = r & 15, cc = c & 31, ob = rr * 64 + cc * 2; return st * 1024 + (ob ^ (((ob >> 9) & 1) << 5)); }
__host__ __device__ __forceinline__ void stage_rc(int b, int& R, int& C) { const int st = b / 1024, sb = b % 1024, swz = sb ^ (((sb >> 9) & 1) << 5); R = (st >> 1) * 16 + swz / 64; C = (st & 1) * 32 + (swz % 64) / 2; }
__host__ __device__ __forceinline__ int perm32(int rho) { const int n = rho >> 4, i = rho & 15; return 8 * (i >> 2) + 4 * n + (i & 3); }

constexpr int ACTX_TILE0 = 1472;
struct Unit { int pm, pn, kt0, nt, slab; };
struct Gemm { const bf16_t* A; const bf16_t* Bt; int lda, ldb, K; long ajump = 0; };

struct StaticOrder {
    int nM, nN, nwg, G, c, ntk;
    __host__ __device__ __forceinline__ int atile(const Unit& u) const { return u.pm; }
    __host__ __device__ __forceinline__ void init(int M, int N, int G_, int c_, int K_ = 1024) { nM = M / BM; nN = N / BM; nwg = nM * nN; G = G_; c = c_; ntk = K_ / BK; }
    __host__ __device__ __forceinline__ bool next(int i, Unit& u) const {
        const long L = (long)i * G + c; if (L >= nwg) return false;
        int wgid = (int)L; { const int q = nwg / NXCD, r = nwg % NXCD, xcd = wgid % NXCD, off = wgid / NXCD; wgid = (xcd < r ? xcd * (q + 1) : r * (q + 1) + (xcd - r) * q) + off; }
        const int nig = WGM * nN, gid = wgid / nig, fm = gid * WGM, gsz = (nM - fm) < WGM ? (nM - fm) : WGM;
        u.pm = fm + ((wgid % nig) % gsz); u.pn = (wgid % nig) / gsz; u.kt0 = 0; u.nt = ntk; u.slab = -1; return true;
    }
};
struct SplitOrder {
    int G, c, ntk, lsp;
    __device__ __forceinline__ int atile(const Unit& u) const { return u.pm; }
    __device__ __forceinline__ void init(int G_, int c_, int K_, int lsp_) { G = G_; c = c_; ntk = K_ / BK; lsp = lsp_; }
    __device__ __forceinline__ bool next(int i, Unit& u) const {
        const int L = i * G + c;
        if (L >= 256 + (32 << lsp)) return false;
        const bool lat = L < 256;
        const int wl = (L & 7) * 32 + (L >> 3); const int gid = wl >> 5, wi = wl & 31;
        const int j = L - 256;
        const int pm = lat ? gid * 8 + (wi & 7) : 64 + (j >> (lsp + 2));
        const int pn = lat ? (wi >> 3) : ((j >> lsp) & 3);
        const int sl = lat ? -1 : (j & ((1 << lsp) - 1));
        const int nt = lat ? ntk : (ntk >> lsp);
        u.pm = pm; u.pn = pn; u.slab = sl; u.nt = nt; u.kt0 = lat ? 0 : sl * nt;
        return true;
    }
};
struct CtxSliceOrder {
    int G, c, ntk, lsp;
    __device__ __forceinline__ int atile(const Unit& u) const { return u.pm; }
    __device__ __forceinline__ bool next(int i, Unit& u) const {
        const int j = i * G + c;
        if (j >= (32 << lsp)) return false;
        const int sl = j & ((1 << lsp) - 1), nt = ntk >> lsp;
        u.pm = 64 + (j >> (lsp + 2)); u.pn = (j >> lsp) & 3; u.slab = sl; u.nt = nt; u.kt0 = sl * nt;
        return true;
    }
};
struct SsmOrder {
    int G, c, nrow, ntk;
    __device__ __forceinline__ int atile(const Unit& u) const { const int i = u.pm - 5 * u.pn; return i < 4 ? u.pn * 4 + i : ACTX_TILE0 + u.pn; }
    __device__ __forceinline__ bool next(int i, Unit& u) const {
        const int L = i * G + c; if (L >= 64 * nrow) return false;
        if (nrow == 4 && G == 256) {
            const int x = c & 7, s = c >> 3, q = x * 8 + (s >> 2), e = s & 3; const int g = 4 * (q & 15) + e, it = q >> 4;
            u.pm = g * 5 + it; u.pn = g; u.kt0 = 0; u.nt = ntk; u.slab = -1; return true; }
        const int g = L / nrow; u.pm = g * 5 + (L - g * nrow); u.pn = g; u.kt0 = 0; u.nt = ntk; u.slab = -1; return true;
    }
};

__device__ __forceinline__ unsigned cvt_pk_bf16(float lo, float hi) { unsigned r; asm volatile("v_cvt_pk_bf16_f32 %0, %1, %2" : "=v"(r) : "v"(lo), "v"(hi)); return r; }
__device__ __forceinline__ float bf16lo(unsigned w) { return __uint_as_float(w << 16); }
__device__ __forceinline__ float bf16hi(unsigned w) { return __uint_as_float(w & 0xffff0000u); }

constexpr float QSCALE = 0.125f * 1.4426950408889634f;


struct EpiInProj {
    static constexpr bool PERM = true;
    bf16_t* O; const PG8_LAS float* rope;
    __device__ __forceinline__ void operator()(const f32x4 (&acc)[2][2][4][2], const Unit& u, int wr, int wc, int fr, int fq) const {
        asm volatile("" : "+v"(fr), "+v"(fq));
        const int pn = u.pn; const bool dorope = (u.pm < 64) && (pn < 4);
        const float sc = (pn < 2 || pn == 6 || pn == 7) ? QSCALE : 1.0f;
        const int row0 = u.pm * BM + wr * 64 + fr, col0 = pn * BM + wc * 32 + 8 * fq;
        const float sgn = (fq < 2) ? -1.0f : 1.0f; const int j0 = 8 * (fq & 1);
#pragma unroll
        for (int ai = 0; ai < 2; ++ai)
#pragma unroll
            for (int m = 0; m < 4; ++m) {
                const int row = row0 + ai * HALF + m * 16;
                f32x4 cs0 = (f32x4){1.f, 1.f, 1.f, 1.f}, cs1 = cs0, sn0 = (f32x4){0.f, 0.f, 0.f, 0.f}, sn1 = sn0;
                if (dorope) { const int t = row & 2047; const int pos = (wc & 1) ? (t & 63) : (t >> 6); const PG8_LAS float* rp = rope + pos * 16 + j0;
                    cs0 = *(const PG8_LAS f32x4*)rp; cs1 = *(const PG8_LAS f32x4*)(rp + 4); sn0 = *(const PG8_LAS f32x4*)(rp + 1024) * sgn; sn1 = *(const PG8_LAS f32x4*)(rp + 1028) * sgn; }
                bf16_t* rowp = O + (size_t)row * 3072 + col0;
#pragma unroll
                for (int bj = 0; bj < 2; ++bj) {
                    f32x4 x0 = acc[ai][bj][m][0], x1 = acc[ai][bj][m][1], y0 = x0, y1 = x1;
                    if (dorope) {
#pragma unroll
                        for (int e2 = 0; e2 < 4; ++e2) {
                            const auto ra = __builtin_amdgcn_permlane32_swap(__float_as_uint(x0[e2]), __float_as_uint(x0[e2]), false, false);
                            const auto rb = __builtin_amdgcn_permlane32_swap(__float_as_uint(x1[e2]), __float_as_uint(x1[e2]), false, false);
                            const float p0 = (fq < 2) ? __uint_as_float(ra[1]) : __uint_as_float(ra[0]);
                            const float p1 = (fq < 2) ? __uint_as_float(rb[1]) : __uint_as_float(rb[0]);
                            y0[e2] = x0[e2] * cs0[e2] + p0 * sn0[e2]; y1[e2] = x1[e2] * cs1[e2] + p1 * sn1[e2]; } }
                    y0 = y0 * sc; y1 = y1 * sc;
                    u32x4 w; w.x = cvt_pk_bf16(y0[0], y0[1]); w.y = cvt_pk_bf16(y0[2], y0[3]); w.z = cvt_pk_bf16(y1[0], y1[1]); w.w = cvt_pk_bf16(y1[2], y1[3]);
                    *(u32x4*)(rowp + bj * HALF) = w;
                }
            }
    }
};

template <bool BASEF32>
struct EpiResid {
    static constexpr bool PERM = true;
    const void* base_l; const void* base_c; bf16_t* out_l; bf16_t* out_c; const float* gate; bf16_t* slabs;
    __device__ __forceinline__ void operator()(const f32x4 (&acc)[2][2][4][2], const Unit& u, int wr, int wc, int fr, int fq) const {
        asm volatile("" : "+v"(fr), "+v"(fq));
        const bool lat = u.pm < 64; const int r = lat ? (u.pm >> 3) : 8;
        const size_t toff = (size_t)(lat ? u.pm : u.pm - 64) * BM * 1024;
        const int col0 = u.pn * BM + wc * 32 + 8 * fq;
        if (u.slab >= 0) {
            bf16_t* so = slabs + (size_t)u.slab * 2048 * 1024 + toff;
#pragma unroll
            for (int ai = 0; ai < 2; ++ai)
#pragma unroll
                for (int m = 0; m < 4; ++m) { const size_t p = (size_t)(wr * 64 + fr + ai * HALF + m * 16) * 1024 + col0;
#pragma unroll
                    for (int bj = 0; bj < 2; ++bj) { const f32x4 v0 = acc[ai][bj][m][0], v1 = acc[ai][bj][m][1];
                        u32x4 w; w.x = cvt_pk_bf16(v0[0], v0[1]); w.y = cvt_pk_bf16(v0[2], v0[3]); w.z = cvt_pk_bf16(v1[0], v1[1]); w.w = cvt_pk_bf16(v1[2], v1[3]);
                        *(u32x4*)(so + p + bj * HALF) = w; } }
            return; }
        bf16_t* out = (lat ? out_l : out_c) + toff;
        const float* gv = gate + r * 6144 + col0;
        f32x4 g[2][2];
#pragma unroll
        for (int bj = 0; bj < 2; ++bj)
#pragma unroll
            for (int n = 0; n < 2; ++n) g[bj][n] = *(const f32x4*)(gv + bj * HALF + n * 4);
#pragma unroll
        for (int ai = 0; ai < 2; ++ai) {
            f32x4 bf[BASEF32 ? 4 : 1][2][2]; u32x4 bw[BASEF32 ? 1 : 4][2];
#pragma unroll
            for (int m = 0; m < 4; ++m) { const size_t p = (size_t)(wr * 64 + fr + ai * HALF + m * 16) * 1024 + col0;
#pragma unroll
                for (int bj = 0; bj < 2; ++bj) {
                    if (BASEF32) { const float* bp = (const float*)(lat ? base_l : base_c) + toff + p + bj * HALF; bf[BASEF32 ? m : 0][bj][0] = *(const f32x4*)bp; bf[BASEF32 ? m : 0][bj][1] = *(const f32x4*)(bp + 4); }
                    else bw[BASEF32 ? 0 : m][bj] = *(const u32x4*)((const bf16_t*)(lat ? base_l : base_c) + toff + p + bj * HALF); } }
#pragma unroll
            for (int m = 0; m < 4; ++m) { const size_t p = (size_t)(wr * 64 + fr + ai * HALF + m * 16) * 1024 + col0;
#pragma unroll
                for (int bj = 0; bj < 2; ++bj) { f32x4 b0, b1;
                    if (BASEF32) { b0 = bf[BASEF32 ? m : 0][bj][0]; b1 = bf[BASEF32 ? m : 0][bj][1]; }
                    else { const u32x4 w = bw[BASEF32 ? 0 : m][bj];
                        b0 = (f32x4){bf16lo(w.x), bf16hi(w.x), bf16lo(w.y), bf16hi(w.y)}; b1 = (f32x4){bf16lo(w.z), bf16hi(w.z), bf16lo(w.w), bf16hi(w.w)}; }
                    const f32x4 o0 = b0 + g[bj][0] * acc[ai][bj][m][0], o1 = b1 + g[bj][1] * acc[ai][bj][m][1];
                    u32x4 wo; wo.x = cvt_pk_bf16(o0[0], o0[1]); wo.y = cvt_pk_bf16(o0[2], o0[3]); wo.z = cvt_pk_bf16(o1[0], o1[1]); wo.w = cvt_pk_bf16(o1[2], o1[3]);
                    *(u32x4*)(out + p + bj * HALF) = wo; } } }
    }
};

struct EpiResidFinal {
    static constexpr bool PERM = true;
    const bf16_t* base; const bf16_t* base2; float* out; const float* gate; const float* gain; float* stat; unsigned* cnt; PG8_LAS float* red;
    __device__ __forceinline__ void operator()(const f32x4 (&acc)[2][2][4][2], const Unit& u, int wr, int wc, int fr, int fq) const {
        { int t_ = threadIdx.x; asm volatile("" : "+v"(t_)); fr = t_ & 15; fq = (t_ >> 4) & 3; }
        const int r = u.pm >> 3; const size_t toff = (size_t)u.pm * BM * 1024; const int col0 = u.pn * BM + wc * 32 + 8 * fq;
        const float* gv = gate + r * 6144 + col0;
        f32x4 g[2][2];
#pragma unroll
        for (int bj = 0; bj < 2; ++bj)
#pragma unroll
            for (int n = 0; n < 2; ++n) g[bj][n] = *(const f32x4*)(gv + bj * HALF + n * 4);
        f32x4 o[2][2][4][2]; float ss[2][4];
#pragma unroll
        for (int ai = 0; ai < 2; ++ai) { u32x4 bw[4][2];
#pragma unroll
            for (int m = 0; m < 4; ++m)
#pragma unroll
                for (int bj = 0; bj < 2; ++bj) bw[m][bj] = *(const u32x4*)((u.pm < 48 ? base : base2) + toff + (size_t)(wr * 64 + fr + ai * HALF + m * 16) * 1024 + col0 + bj * HALF);
#pragma unroll
            for (int m = 0; m < 4; ++m) { float s_ = 0.f;
#pragma unroll
                for (int bj = 0; bj < 2; ++bj) { const u32x4 w = bw[m][bj];
                    const f32x4 b0 = (f32x4){bf16lo(w.x), bf16hi(w.x), bf16lo(w.y), bf16hi(w.y)}, b1 = (f32x4){bf16lo(w.z), bf16hi(w.z), bf16lo(w.w), bf16hi(w.w)};
                    const f32x4 o0 = b0 + g[bj][0] * acc[ai][bj][m][0], o1 = b1 + g[bj][1] * acc[ai][bj][m][1];
                    o[ai][bj][m][0] = o0; o[ai][bj][m][1] = o1;
                    s_ += (o0[0] * o0[0] + o0[1] * o0[1]) + (o0[2] * o0[2] + o0[3] * o0[3]) + (o1[0] * o1[0] + o1[1] * o1[1]) + (o1[2] * o1[2] + o1[3] * o1[3]); }
                s_ += __shfl_xor(s_, 16); s_ += __shfl_xor(s_, 32); ss[ai][m] = s_; } }
        if (fq == 0) {
#pragma unroll
            for (int ai = 0; ai < 2; ++ai)
#pragma unroll
                for (int m = 0; m < 4; ++m) red[(wr * 4 + wc) * 128 + ai * 64 + m * 16 + fr] = ss[ai][m]; }
        __syncthreads();
        int tid = threadIdx.x; asm volatile("" : "+v"(tid));
        if (tid < 256) { const int w2 = tid >> 7, rr = tid & 127;
            const float t = (red[(w2 * 4 + 0) * 128 + rr] + red[(w2 * 4 + 1) * 128 + rr]) + (red[(w2 * 4 + 2) * 128 + rr] + red[(w2 * 4 + 3) * 128 + rr]);
            __hip_atomic_store(stat + ((size_t)u.pm * 4 + u.pn) * 256 + tid, t, __ATOMIC_RELAXED, __HIP_MEMORY_SCOPE_AGENT); }
        asm volatile("s_waitcnt vmcnt(0)" ::: "memory");
        __syncthreads();
        if (tid == 0) { __hip_atomic_fetch_add(cnt + u.pm, 1u, __ATOMIC_RELAXED, __HIP_MEMORY_SCOPE_AGENT);
            unsigned sp = 0; while (__hip_atomic_load(cnt + u.pm, __ATOMIC_RELAXED, __HIP_MEMORY_SCOPE_AGENT) < 4u) { __builtin_amdgcn_s_sleep(1); if (++sp > (1u << 22)) break; } }
        __syncthreads();
        if (tid < 256) { float t = 0.f;
#pragma unroll
            for (int q = 0; q < 4; ++q) t += __hip_atomic_load(stat + ((size_t)u.pm * 4 + q) * 256 + tid, __ATOMIC_RELAXED, __HIP_MEMORY_SCOPE_AGENT);
            red[1024 + tid] = 1.0f / sqrtf(t * (1.0f / 1024.0f) + 1e-6f); }
        __syncthreads();
        f32x4 gn[2][2];
#pragma unroll
        for (int bj = 0; bj < 2; ++bj)
#pragma unroll
            for (int n = 0; n < 2; ++n) gn[bj][n] = *(const f32x4*)(gain + col0 + bj * HALF + n * 4);
#pragma unroll
        for (int ai = 0; ai < 2; ++ai)
#pragma unroll
            for (int m = 0; m < 4; ++m) { const int rl = wr * 64 + fr + ai * HALF + m * 16; const float rstd = red[1024 + wr * 128 + ai * 64 + m * 16 + fr];
                float* op = out + toff + (size_t)rl * 1024 + col0;
#pragma unroll
                for (int bj = 0; bj < 2; ++bj) { *(f32x4*)(op + bj * HALF) = o[ai][bj][m][0] * rstd * gn[bj][0]; *(f32x4*)(op + bj * HALF + 4) = o[ai][bj][m][1] * rstd * gn[bj][1]; } }
    }
};

struct EpiResidNorm {
    static constexpr bool PERM = true;
    const float* base; bf16_t* out; const float* gate; bf16_t* H; const float* n2g; const float* mod; float* stat; unsigned* cnt; PG8_LAS float* red;
    __device__ __forceinline__ void operator()(const f32x4 (&acc)[2][2][4][2], const Unit& u, int wr, int wc, int fr, int fq) const {
        { int t_ = threadIdx.x; asm volatile("" : "+v"(t_)); fr = t_ & 15; fq = (t_ >> 4) & 3; }
        const int col0 = u.pn * BM + wc * 32 + 8 * fq;
        const int r = u.pm >> 3; const size_t toff = (size_t)u.pm * BM * 1024;
        const float* gv = gate + r * 6144 + col0;
        f32x4 g[2][2];
#pragma unroll
        for (int bj = 0; bj < 2; ++bj)
#pragma unroll
            for (int n = 0; n < 2; ++n) g[bj][n] = *(const f32x4*)(gv + bj * HALF + n * 4);
        f32x4 o[2][2][4][2]; float ss[2][4];
#pragma unroll
        for (int ai = 0; ai < 2; ++ai)
#pragma unroll
            for (int m = 0; m < 4; ++m) { f32x4 bf[2][2]; float s_ = 0.f;
#pragma unroll
                for (int bj = 0; bj < 2; ++bj) { const float* bp = base + toff + (size_t)(wr * 64 + fr + ai * HALF + m * 16) * 1024 + col0 + bj * HALF; bf[bj][0] = __builtin_nontemporal_load((const f32x4*)bp); bf[bj][1] = __builtin_nontemporal_load((const f32x4*)(bp + 4)); }
#pragma unroll
                for (int bj = 0; bj < 2; ++bj) {
                    const f32x4 o0 = bf[bj][0] + g[bj][0] * acc[ai][bj][m][0], o1 = bf[bj][1] + g[bj][1] * acc[ai][bj][m][1];
                    o[ai][bj][m][0] = o0; o[ai][bj][m][1] = o1;
                    s_ += (o0[0] * o0[0] + o0[1] * o0[1]) + (o0[2] * o0[2] + o0[3] * o0[3]) + (o1[0] * o1[0] + o1[1] * o1[1]) + (o1[2] * o1[2] + o1[3] * o1[3]); }
                s_ += __shfl_xor(s_, 16); s_ += __shfl_xor(s_, 32); ss[ai][m] = s_; }
        if (fq == 0) {
#pragma unroll
            for (int ai = 0; ai < 2; ++ai)
#pragma unroll
                for (int m = 0; m < 4; ++m) red[(wr * 4 + wc) * 128 + ai * 64 + m * 16 + fr] = ss[ai][m]; }
        __syncthreads();
        int tid = threadIdx.x; asm volatile("" : "+v"(tid));
        if (tid < 256) { const int w2 = tid >> 7, rr = tid & 127;
            const float t = (red[(w2 * 4 + 0) * 128 + rr] + red[(w2 * 4 + 1) * 128 + rr]) + (red[(w2 * 4 + 2) * 128 + rr] + red[(w2 * 4 + 3) * 128 + rr]);
            __hip_atomic_store(stat + ((size_t)u.pm * 4 + u.pn) * 256 + tid, t, __ATOMIC_RELAXED, __HIP_MEMORY_SCOPE_AGENT); }
        asm volatile("s_waitcnt vmcnt(0)" ::: "memory");
        __syncthreads();
        if (tid == 0) { __hip_atomic_fetch_add(cnt + u.pm, 1u, __ATOMIC_RELAXED, __HIP_MEMORY_SCOPE_AGENT);
            unsigned sp = 0; while (__hip_atomic_load(cnt + u.pm, __ATOMIC_RELAXED, __HIP_MEMORY_SCOPE_AGENT) < 4u) { __builtin_amdgcn_s_sleep(1); if (++sp > (1u << 22)) break; } }
        __syncthreads();
        if (tid < 256) { float t = 0.f;
#pragma unroll
            for (int q = 0; q < 4; ++q) t += __hip_atomic_load(stat + ((size_t)u.pm * 4 + q) * 256 + tid, __ATOMIC_RELAXED, __HIP_MEMORY_SCOPE_AGENT);
            red[1024 + tid] = 1.0f / sqrtf(t * (1.0f / 1024.0f) + 1e-6f); }
        __syncthreads();
#pragma unroll
        for (int bj = 0; bj < 2; ++bj) { f32x4 gm[2], sh[2];
#pragma unroll
            for (int n = 0; n < 2; ++n) { const int c = col0 + bj * HALF + n * 4;
                gm[n] = *(const f32x4*)(n2g + c) * (*(const f32x4*)(mod + r * 6144 + 1024 + c) + 1.0f); sh[n] = *(const f32x4*)(mod + r * 6144 + c); }
#pragma unroll
            for (int ai = 0; ai < 2; ++ai)
#pragma unroll
                for (int m = 0; m < 4; ++m) { const int rl = wr * 64 + fr + ai * HALF + m * 16; const float rstd = red[1024 + wr * 128 + ai * 64 + m * 16 + fr];
                    const size_t p = toff + (size_t)rl * 1024 + col0 + bj * HALF;
                    const f32x4 o0 = o[ai][bj][m][0], o1 = o[ai][bj][m][1];
                    u32x4 wo; wo.x = cvt_pk_bf16(o0[0], o0[1]); wo.y = cvt_pk_bf16(o0[2], o0[3]); wo.z = cvt_pk_bf16(o1[0], o1[1]); wo.w = cvt_pk_bf16(o1[2], o1[3]);
                    *(u32x4*)(out + p) = wo;
                    const f32x4 h0 = o0 * rstd * gm[0] + sh[0], h1 = o1 * rstd * gm[1] + sh[1];
                    u32x4 wh; wh.x = cvt_pk_bf16(h0[0], h0[1]); wh.y = cvt_pk_bf16(h0[2], h0[3]); wh.z = cvt_pk_bf16(h1[0], h1[1]); wh.w = cvt_pk_bf16(h1[2], h1[3]);
                    *(u32x4*)(H + p) = wh; } }
    }
};

struct EpiResidNormA {
    static constexpr bool PERM = true;
    const bf16_t* base; bf16_t* out; const float* gate; bf16_t* AU; const float* n2g; const float* mod; float* stat; unsigned* cnt; PG8_LAS float* red;
    __device__ __forceinline__ void operator()(const f32x4 (&acc)[2][2][4][2], const Unit& u, int wr, int wc, int fr, int fq) const {
        { int t_ = threadIdx.x; asm volatile("" : "+v"(t_)); fr = t_ & 15; fq = (t_ >> 4) & 3; }
        const int col0 = u.pn * BM + wc * 32 + 8 * fq;
        const int r = u.pm >> 3; const size_t toff = (size_t)u.pm * BM * 1024;
        const float* gv = gate + r * 6144 + col0;
        f32x4 g[2][2];
#pragma unroll
        for (int bj = 0; bj < 2; ++bj)
#pragma unroll
            for (int n = 0; n < 2; ++n) g[bj][n] = *(const f32x4*)(gv + bj * HALF + n * 4);
        f32x4 o[2][2][4][2]; float ss[2][4];
#pragma unroll
        for (int ai = 0; ai < 2; ++ai)
#pragma unroll
            for (int m = 0; m < 4; ++m) { f32x4 bf[2][2]; float s_ = 0.f;
#pragma unroll
                for (int bj = 0; bj < 2; ++bj) { const u32x4 w = *(const u32x4*)(base + toff + (size_t)(wr * 64 + fr + ai * HALF + m * 16) * 1024 + col0 + bj * HALF);
                    bf[bj][0] = (f32x4){bf16lo(w.x), bf16hi(w.x), bf16lo(w.y), bf16hi(w.y)}; bf[bj][1] = (f32x4){bf16lo(w.z), bf16hi(w.z), bf16lo(w.w), bf16hi(w.w)}; }
#pragma unroll
                for (int bj = 0; bj < 2; ++bj) {
                    const f32x4 o0 = bf[bj][0] + g[bj][0] * acc[ai][bj][m][0], o1 = bf[bj][1] + g[bj][1] * acc[ai][bj][m][1];
                    o[ai][bj][m][0] = o0; o[ai][bj][m][1] = o1;
                    s_ += (o0[0] * o0[0] + o0[1] * o0[1]) + (o0[2] * o0[2] + o0[3] * o0[3]) + (o1[0] * o1[0] + o1[1] * o1[1]) + (o1[2] * o1[2] + o1[3] * o1[3]); }
                s_ += __shfl_xor(s_, 16); s_ += __shfl_xor(s_, 32); ss[ai][m] = s_; }
        if (fq == 0) {
#pragma unroll
            for (int ai = 0; ai < 2; ++ai)
#pragma unroll
                for (int m = 0; m < 4; ++m) red[(wr * 4 + wc) * 128 + ai * 64 + m * 16 + fr] = ss[ai][m]; }
        __syncthreads();
        int tid = threadIdx.x; asm volatile("" : "+v"(tid));
        if (tid < 256) { const int w2 = tid >> 7, rr = tid & 127;
            const float t = (red[(w2 * 4 + 0) * 128 + rr] + red[(w2 * 4 + 1) * 128 + rr]) + (red[(w2 * 4 + 2) * 128 + rr] + red[(w2 * 4 + 3) * 128 + rr]);
            __hip_atomic_store(stat + ((size_t)u.pm * 4 + u.pn) * 256 + tid, t, __ATOMIC_RELAXED, __HIP_MEMORY_SCOPE_AGENT); }
        asm volatile("s_waitcnt vmcnt(0)" ::: "memory");
        __syncthreads();
        if (tid == 0) { __hip_atomic_fetch_add(cnt + u.pm, 1u, __ATOMIC_RELAXED, __HIP_MEMORY_SCOPE_AGENT);
            unsigned sp = 0; while (__hip_atomic_load(cnt + u.pm, __ATOMIC_RELAXED, __HIP_MEMORY_SCOPE_AGENT) < 4u) { __builtin_amdgcn_s_sleep(1); if (++sp > (1u << 22)) break; } }
        __syncthreads();
        if (tid < 256) { float t = 0.f;
#pragma unroll
            for (int q = 0; q < 4; ++q) t += __hip_atomic_load(stat + ((size_t)u.pm * 4 + q) * 256 + tid, __ATOMIC_RELAXED, __HIP_MEMORY_SCOPE_AGENT);
            red[1024 + tid] = 1.0f / sqrtf(t * (1.0f / 1024.0f) + 1e-6f); }
        __syncthreads();
#pragma unroll
        for (int bj = 0; bj < 2; ++bj) { f32x4 gm[2], sh[2];
#pragma unroll
            for (int n = 0; n < 2; ++n) { const int c = col0 + bj * HALF + n * 4;
                gm[n] = *(const f32x4*)(n2g + c) * (*(const f32x4*)(mod + r * 6144 + 1024 + c) + 1.0f); sh[n] = *(const f32x4*)(mod + r * 6144 + c); }
#pragma unroll
            for (int ai = 0; ai < 2; ++ai)
#pragma unroll
                for (int m = 0; m < 4; ++m) { const int rl = wr * 64 + fr + ai * HALF + m * 16; const float rstd = red[1024 + wr * 128 + ai * 64 + m * 16 + fr];
                    const size_t p = toff + (size_t)rl * 1024 + col0 + bj * HALF;
                    const int grow = u.pm * BM + rl, cc = col0 + bj * HALF;
                    bf16_t* up = AU + ((size_t)((cc >> 4) * 1024 + (grow >> 11) * 128 + ((grow & 2047) >> 4)) * 256 + (grow & 15) * 16 + (cc & 15));
                    const f32x4 o0 = o[ai][bj][m][0], o1 = o[ai][bj][m][1];
                    u32x4 wo; wo.x = cvt_pk_bf16(o0[0], o0[1]); wo.y = cvt_pk_bf16(o0[2], o0[3]); wo.z = cvt_pk_bf16(o1[0], o1[1]); wo.w = cvt_pk_bf16(o1[2], o1[3]);
                    *(u32x4*)(out + p) = wo;
                    const f32x4 h0 = o0 * rstd * gm[0] + sh[0], h1 = o1 * rstd * gm[1] + sh[1];
                    u32x4 wh; wh.x = cvt_pk_bf16(h0[0], h0[1]); wh.y = cvt_pk_bf16(h0[2], h0[3]); wh.z = cvt_pk_bf16(h1[0], h1[1]); wh.w = cvt_pk_bf16(h1[2], h1[3]);
                    *(u32x4*)up = wh; } }
    }
};

struct EpiSlab {
    static constexpr bool PERM = true;
    bf16_t* slabs;
    __device__ __forceinline__ void operator()(const f32x4 (&acc)[2][2][4][2], const Unit& u, int wr, int wc, int fr, int fq) const {
        { int t_ = threadIdx.x; asm volatile("" : "+v"(t_)); fr = t_ & 15; fq = (t_ >> 4) & 3; }
        const int col0 = u.pn * BM + wc * 32 + 8 * fq;
        bf16_t* so = slabs + (size_t)u.slab * 2048 * 1024 + (size_t)(u.pm - 64) * BM * 1024;
#pragma unroll
        for (int ai = 0; ai < 2; ++ai)
#pragma unroll
            for (int m = 0; m < 4; ++m) { const size_t p = (size_t)(wr * 64 + fr + ai * HALF + m * 16) * 1024 + col0;
#pragma unroll
                for (int bj = 0; bj < 2; ++bj) { const f32x4 v0 = acc[ai][bj][m][0], v1 = acc[ai][bj][m][1];
                    u32x4 w; w.x = cvt_pk_bf16(v0[0], v0[1]); w.y = cvt_pk_bf16(v0[2], v0[3]); w.z = cvt_pk_bf16(v1[0], v1[1]); w.w = cvt_pk_bf16(v1[2], v1[3]);
                    *(u32x4*)(so + p + bj * HALF) = w; } }
    }
};
template <bool FUSEDN>
struct EpiRelu2 {
    static constexpr bool PERM = true;
    bf16_t* O; int ldc; const float* rowss; const float* bias2;
    __device__ __forceinline__ void operator()(const f32x4 (&acc)[2][2][4][2], const Unit& u, int wr, int wc, int fr, int fq) const {
        asm volatile("" : "+v"(fr), "+v"(fq));
        const int row0 = u.pm * BM + wr * 64 + fr, col0 = u.pn * BM + wc * 32 + 8 * fq;
        f32x4 bv[2][2];
        if (FUSEDN) { const float* bp = bias2 + (u.pm >> 3) * 4096 + col0;
#pragma unroll
            for (int bj = 0; bj < 2; ++bj) { bv[bj][0] = *(const f32x4*)(bp + bj * HALF); bv[bj][1] = *(const f32x4*)(bp + bj * HALF + 4); } }
        float rs[2][4];
#pragma unroll
        for (int ai = 0; ai < 2; ++ai)
#pragma unroll
            for (int m = 0; m < 4; ++m) rs[ai][m] = FUSEDN ? rowss[row0 + ai * HALF + m * 16] : 0.f;
#pragma unroll
        for (int ai = 0; ai < 2; ++ai)
#pragma unroll
            for (int m = 0; m < 4; ++m) { const int row = row0 + ai * HALF + m * 16; bf16_t* rowp = O + (size_t)row * ldc + col0;
                float rstd = 1.0f; if (FUSEDN) rstd = 1.0f / sqrtf(rs[ai][m] * (1.0f / 1024.0f) + 1e-6f);
#pragma unroll
                for (int bj = 0; bj < 2; ++bj) { f32x4 v0 = acc[ai][bj][m][0], v1 = acc[ai][bj][m][1];
                    if (FUSEDN) { v0 = v0 * rstd + bv[bj][0]; v1 = v1 * rstd + bv[bj][1]; }
#pragma unroll
                    for (int e = 0; e < 4; ++e) { const float a = fmaxf(v0[e], 0.f), b = fmaxf(v1[e], 0.f); v0[e] = a * a; v1[e] = b * b; }
                    u32x4 w; w.x = cvt_pk_bf16(v0[0], v0[1]); w.y = cvt_pk_bf16(v0[2], v0[3]); w.z = cvt_pk_bf16(v1[0], v1[1]); w.w = cvt_pk_bf16(v1[2], v1[3]);
                    *(u32x4*)(rowp + bj * HALF) = w; } }
    }
};

struct EpiGlu {
    static constexpr bool PERM = true;
    const bf16_t* x; bf16_t* xo; bf16_t* xo2; const float* gate;
    bf16_t* hb; const float* n2g; const float* sc2; float* rowss;
    __device__ __forceinline__ void operator()(const f32x4 (&acc)[2][2][4][2], const Unit& u, int wr, int wc, int fr, int fq) const {
        asm volatile("" : "+v"(fr), "+v"(fq));
        const int r = u.pm >> 3; const int col0 = u.pn * HALF + wc * 32 + 8 * fq; const float* gv = gate + r * 6144 + col0;
        const f32x4 g0 = *(const f32x4*)gv, g1 = *(const f32x4*)(gv + 4);
        const f32x4 gm0 = *(const f32x4*)(n2g + col0) * (*(const f32x4*)(sc2 + r * 6144 + col0) + 1.0f), gm1 = *(const f32x4*)(n2g + col0 + 4) * (*(const f32x4*)(sc2 + r * 6144 + col0 + 4) + 1.0f);
        u32x4 xw[2][4];
#pragma unroll
        for (int ai = 0; ai < 2; ++ai)
#pragma unroll
            for (int m = 0; m < 4; ++m) xw[ai][m] = *(const u32x4*)(x + (size_t)(u.pm * BM + wr * 64 + fr + ai * HALF + m * 16) * 1024 + col0);
#pragma unroll
        for (int ai = 0; ai < 2; ++ai)
#pragma unroll
            for (int m = 0; m < 4; ++m) { const int row = u.pm * BM + wr * 64 + fr + ai * HALF + m * 16; bf16_t* p = (u.pm < 48 ? xo : xo2) + (size_t)row * 1024 + col0;
                const u32x4 w = xw[ai][m];
                f32x4 b0 = (f32x4){bf16lo(w.x), bf16hi(w.x), bf16lo(w.y), bf16hi(w.y)}, b1 = (f32x4){bf16lo(w.z), bf16hi(w.z), bf16lo(w.w), bf16hi(w.w)};
#pragma unroll
                for (int e = 0; e < 4; ++e) {
                    b0[e] += g0[e] * acc[ai][0][m][0][e] * (1.0f / (1.0f + __builtin_amdgcn_exp2f(-1.4426950408889634f * acc[ai][1][m][0][e])));
                    b1[e] += g1[e] * acc[ai][0][m][1][e] * (1.0f / (1.0f + __builtin_amdgcn_exp2f(-1.4426950408889634f * acc[ai][1][m][1][e]))); }
                u32x4 wo; wo.x = cvt_pk_bf16(b0[0], b0[1]); wo.y = cvt_pk_bf16(b0[2], b0[3]); wo.z = cvt_pk_bf16(b1[0], b1[1]); wo.w = cvt_pk_bf16(b1[2], b1[3]);
                *(u32x4*)p = wo;
                const f32x4 r0 = (f32x4){bf16lo(wo.x), bf16hi(wo.x), bf16lo(wo.y), bf16hi(wo.y)}, r1 = (f32x4){bf16lo(wo.z), bf16hi(wo.z), bf16lo(wo.w), bf16hi(wo.w)};
                float ss = (r0[0] * r0[0] + r0[1] * r0[1]) + (r0[2] * r0[2] + r0[3] * r0[3]) + (r1[0] * r1[0] + r1[1] * r1[1]) + (r1[2] * r1[2] + r1[3] * r1[3]);
                ss += __shfl_xor(ss, 16); ss += __shfl_xor(ss, 32);
                if (fq == 0) atomicAdd(rowss + row, ss);
                const f32x4 h0 = r0 * gm0, h1 = r1 * gm1;
                u32x4 wh; wh.x = cvt_pk_bf16(h0[0], h0[1]); wh.y = cvt_pk_bf16(h0[2], h0[3]); wh.z = cvt_pk_bf16(h1[0], h1[1]); wh.w = cvt_pk_bf16(h1[2], h1[3]);
                *(u32x4*)(hb + (size_t)row * 1024 + col0) = wh; }
    }
};

struct EpiSsm1 {
    static constexpr bool PERM = true;
    bf16_t* S;
    __device__ __forceinline__ void operator()(const f32x4 (&acc)[2][2][4][2], const Unit& u, int wr, int wc, int fr, int fq) const {
        asm volatile("" : "+v"(fr), "+v"(fq));
        const int g = u.pn, i = u.pm - 5 * g; const int col0 = wc * 32 + 8 * fq;
#pragma unroll
        for (int ai = 0; ai < 2; ++ai)
#pragma unroll
            for (int m = 0; m < 4; ++m) { const int row = i * BM + wr * 64 + fr + ai * HALF + m * 16;
                if (row < 1152) { bf16_t* p = S + ((size_t)g * 1152 + row) * 256 + col0;
#pragma unroll
                    for (int bj = 0; bj < 2; ++bj) { const f32x4 v0 = acc[ai][bj][m][0], v1 = acc[ai][bj][m][1];
                        u32x4 w; w.x = cvt_pk_bf16(v0[0], v0[1]); w.y = cvt_pk_bf16(v0[2], v0[3]); w.z = cvt_pk_bf16(v1[0], v1[1]); w.w = cvt_pk_bf16(v1[2], v1[3]);
                        *(u32x4*)(p + bj * HALF) = w; } } }
    }
};

__device__ __forceinline__ float gelu_tanh(float v) {
    const float u = 0.7978845608028654f * (v + 0.044715f * v * v * v);
    const float e = __builtin_amdgcn_exp2f(2.0f * 1.4426950408889634f * u);
    const float th = 1.0f - 2.0f / (1.0f + e);
    return 0.5f * v * (1.0f + th);
}
struct EpiSsm2 {
    static constexpr bool PERM = true;
    bf16_t* Z; const bf16_t* A2; const float* dskip;
    __device__ __forceinline__ void operator()(const f32x4 (&acc)[2][2][4][2], const Unit& u, int wr, int wc, int fr, int fq) const {
        asm volatile("" : "+v"(fr), "+v"(fq));
        const int g = u.pn, i = u.pm - 5 * g; const int hh = 8 * (fq & 1); const int zcol = g * 16 + hh;
#pragma unroll
        for (int ai = 0; ai < 2; ++ai)
#pragma unroll
            for (int m = 0; m < 4; ++m) { const int ridx = i * BM + wr * 64 + fr + ai * HALF + m * 16; const int b = ridx >> 7, c = ridx & 127;
#pragma unroll
                for (int bj = 0; bj < 2; ++bj) { const int t = 8 * bj + 2 * wc + (fq >> 1);
                    const f32x4 v0 = acc[ai][bj][m][0], v1 = acc[ai][bj][m][1];
                    float z[8];
#pragma unroll
                    for (int e = 0; e < 4; ++e) { z[e] = gelu_tanh(v0[e]); z[4 + e] = gelu_tanh(v1[e]); }
                    u32x4 w; w.x = cvt_pk_bf16(z[0], z[1]); w.y = cvt_pk_bf16(z[2], z[3]); w.z = cvt_pk_bf16(z[4], z[5]); w.w = cvt_pk_bf16(z[6], z[7]);
                    *(u32x4*)(Z + (size_t)(b * 2048 + c * 16 + t) * 1024 + zcol) = w;
                    } }
    }
};

template <class Epi, class Sched, bool ALIGN_EPI, int AJT = 0, int PRE = 0>
__device__ __forceinline__ void gemm_phase(PG8_LAS unsigned char* lds, const Gemm g, const Sched& S, const Epi& E) {
    int tid = threadIdx.x; asm volatile("" : "+v"(tid));
    const int wid = __builtin_amdgcn_readfirstlane(tid >> 6), lane = tid & 63, wr = wid >> 2, wc = wid & 3, fr = lane & 15, fq = lane >> 4;
    unsigned voffA[2], voffB[2];
#pragma unroll
    for (int i = 0; i < 2; ++i) { int R, C; stage_rc(tid * 16 + i * 8192, R, C); const int Rb = Epi::PERM ? ((R & ~31) + perm32(R & 31)) : R;
        voffA[i] = (unsigned)(R * g.lda + C) * 2u; voffB[i] = (unsigned)(Rb * g.ldb + C) * 2u; }
    const size_t kstep = (size_t)(BK * 2);
    const size_t hstepA = (size_t)HALF * g.lda * 2, hstepB = (size_t)HALF * g.ldb * 2;
    const size_t tstepA = 2 * hstepA, tstepB = 2 * hstepB;
    const unsigned ldsw = (unsigned)wid * 1024u;
    const int aoff = lds_byte(wr * 64 + fr, fq * 8), boff = lds_byte(wc * 32 + fr, fq * 8);
#define PG8_SA(b, h) (((b) * 2 + (h)) * HTB)
#define PG8_SB(b, h) ((4 + (b) * 2 + (h)) * HTB)
#define PG8_STAGE(bufoff, gbase, voff) do { _Pragma("unroll") for (int _i = 0; _i < 2; ++_i) \
        __builtin_amdgcn_global_load_lds((const unsigned*)((const char*)(gbase) + (voff)[_i]), (PG8_LAS unsigned*)(lds + (bufoff) + ldsw + _i * 8192), 16, 0, 0); } while (0)
#define PG8_LDA(dst, b, h) do { _Pragma("unroll") for (int m = 0; m < 4; ++m) _Pragma("unroll") for (int k = 0; k < 2; ++k) dst[m][k] = *(const PG8_LAS bf16x8*)(lds + PG8_SA(b, h) + aoff + m * 2048 + k * 1024); } while (0)
#define PG8_LDB(dst, b, h) do { _Pragma("unroll") for (int n = 0; n < 2; ++n) _Pragma("unroll") for (int k = 0; k < 2; ++k) dst[n][k] = *(const PG8_LAS bf16x8*)(lds + PG8_SB(b, h) + boff + n * 2048 + k * 1024); } while (0)
#define PG8_MMA(ai, bj, At, Bt) do { __builtin_amdgcn_s_setprio(1); _Pragma("unroll") for (int m = 0; m < 4; ++m) _Pragma("unroll") for (int n = 0; n < 2; ++n) _Pragma("unroll") for (int k = 0; k < 2; ++k) \
        acc[ai][bj][m][n] = __builtin_amdgcn_mfma_f32_16x16x32_bf16(Bt[n][k], At[m][k], acc[ai][bj][m][n], 0, 0, 0); __builtin_amdgcn_s_setprio(0); } while (0)
#define PG8_WAIT_V(n) asm volatile("s_waitcnt vmcnt(" #n ")" ::: "memory")
#define PG8_WAIT_L(n) asm volatile("s_waitcnt lgkmcnt(" #n ")" ::: "memory")
#define PG8_BAR __builtin_amdgcn_s_barrier()
#define PG8_SCHED __builtin_amdgcn_sched_barrier(0)
    Unit cur, nxt; int ui = 0;
    if (!S.next(0, cur)) return;
    f32x4 acc[2][2][4][2];
#pragma unroll
    for (int a = 0; a < 2; ++a)
#pragma unroll
        for (int b = 0; b < 2; ++b)
#pragma unroll
            for (int m = 0; m < 4; ++m)
#pragma unroll
                for (int n = 0; n < 2; ++n) acc[a][b][m][n] = (f32x4){0.f, 0.f, 0.f, 0.f};
    bf16x8 At[4][2], B0[2][2], B1[2][2];
    const char* cA = (const char*)g.A + (size_t)S.atile(cur) * tstepA + (size_t)cur.kt0 * kstep; const char* cB = (const char*)g.Bt + (size_t)cur.pn * tstepB + (size_t)cur.kt0 * kstep;
    if constexpr (PRE != 2) { PG8_STAGE(PG8_SB(0, 0), cB, voffB); PG8_STAGE(PG8_SB(0, 1), cB + hstepB, voffB); PG8_STAGE(PG8_SA(0, 0), cA, voffA); PG8_STAGE(PG8_SA(0, 1), cA + hstepA, voffA); }
    if constexpr (PRE == 1) { PG8_STAGE(PG8_SB(1, 0), cB + kstep, voffB); PG8_STAGE(PG8_SA(1, 0), cA + kstep, voffA); PG8_STAGE(PG8_SB(1, 1), cB + hstepB + kstep, voffB); return; }
    if (wr == 1) PG8_BAR;
    PG8_WAIT_V(2); PG8_BAR;
    if constexpr (PRE != 2) { PG8_STAGE(PG8_SB(1, 0), cB + kstep, voffB); PG8_STAGE(PG8_SA(1, 0), cA + kstep, voffA); PG8_STAGE(PG8_SB(1, 1), cB + hstepB + kstep, voffB); }
    PG8_WAIT_V(6); PG8_BAR;
    for (;;) {
        const bool has_next = S.next(ui + 1, nxt);
        const char* nA = has_next ? (const char*)g.A + (size_t)S.atile(nxt) * tstepA + (size_t)nxt.kt0 * kstep : cA; const char* nB = has_next ? (const char*)g.Bt + (size_t)nxt.pn * tstepB + (size_t)nxt.kt0 * kstep : cB;
        const int nt = cur.nt;
        for (int t = 0; t < nt; t += 2) {
            const bool last = (t == nt - 2);
            const char* a1 = cA + (size_t)(t + 1) * kstep;
            const char* a2 = last ? nA : cA + (size_t)(t + 2) * kstep; const char* b2 = last ? nB : cB + (size_t)(t + 2) * kstep;
            const char* a3 = a2 + kstep; const char* b3 = b2 + kstep;
            if constexpr (AJT > 0) { if (t + 1 >= AJT) a1 += g.ajump; if (!last) { if (t + 2 >= AJT) a2 += g.ajump; a3 = a2 + kstep; if (t + 2 < AJT && t + 3 >= AJT) a3 += g.ajump; } }
            PG8_LDB(B0, 0, 0); PG8_LDB(B1, 0, 1); PG8_SCHED; PG8_LDA(At, 0, 0); PG8_STAGE(PG8_SA(1, 1), a1 + hstepA, voffA);
            PG8_WAIT_V(8); PG8_WAIT_L(0); PG8_BAR; PG8_MMA(0, 0, At, B0); PG8_MMA(0, 1, At, B1); PG8_BAR; PG8_SCHED;
            PG8_LDA(At, 0, 1); PG8_STAGE(PG8_SB(0, 0), b2, voffB); PG8_STAGE(PG8_SB(0, 1), b2 + hstepB, voffB); PG8_STAGE(PG8_SA(0, 0), a2, voffA);
            PG8_WAIT_V(8); PG8_WAIT_L(0); PG8_BAR; PG8_MMA(1, 0, At, B0); PG8_MMA(1, 1, At, B1); PG8_BAR; PG8_SCHED;
            PG8_LDB(B0, 1, 0); PG8_LDB(B1, 1, 1); PG8_SCHED; PG8_LDA(At, 1, 0); PG8_STAGE(PG8_SA(0, 1), a2 + hstepA, voffA);
            PG8_WAIT_V(8); PG8_WAIT_L(0); PG8_BAR; PG8_MMA(0, 0, At, B0); PG8_MMA(0, 1, At, B1); PG8_BAR; PG8_SCHED;
            PG8_LDA(At, 1, 1); PG8_STAGE(PG8_SB(1, 0), b3, voffB); PG8_STAGE(PG8_SB(1, 1), b3 + hstepB, voffB); PG8_STAGE(PG8_SA(1, 0), a3, voffA);
            PG8_WAIT_V(8); PG8_WAIT_L(0); PG8_BAR; PG8_MMA(1, 0, At, B0); PG8_MMA(1, 1, At, B1); PG8_BAR; PG8_SCHED;
        }
        if constexpr (ALIGN_EPI) { if (wr == 0) PG8_BAR; }
        E(acc, cur, wr, wc, fr, fq);
        if (!has_next) break;
#pragma unroll
        for (int a = 0; a < 2; ++a)
#pragma unroll
            for (int b = 0; b < 2; ++b)
#pragma unroll
                for (int m = 0; m < 4; ++m)
#pragma unroll
                    for (int n = 0; n < 2; ++n) acc[a][b][m][n] = (f32x4){0.f, 0.f, 0.f, 0.f};
        cur = nxt; cA = nA; cB = nB; ++ui;
        if constexpr (ALIGN_EPI) { if (wr == 1) PG8_BAR; }
    }
    PG8_WAIT_V(0);
    if constexpr (!ALIGN_EPI) { if (wr == 0) PG8_BAR; }
    PG8_BAR;
#undef PG8_SA
#undef PG8_SB
#undef PG8_STAGE
#undef PG8_LDA
#undef PG8_LDB
#undef PG8_MMA
#undef PG8_WAIT_V
#undef PG8_WAIT_L
#undef PG8_BAR
#undef PG8_SCHED
}
}
namespace att {
typedef __attribute__((address_space(3))) unsigned char lds_u8;
typedef __attribute__((address_space(3))) const unsigned char* lds_cptr;
using bf16x8 = __attribute__((ext_vector_type(8))) short;
using s16x4 = __attribute__((ext_vector_type(4))) short;
using f32x16 = __attribute__((ext_vector_type(16))) float;
using f32x4 = __attribute__((ext_vector_type(4))) float;
using u32x4 = __attribute__((ext_vector_type(4))) unsigned;
typedef unsigned short bf16_t;
#define ATT_LF __attribute__((address_space(3))) float
constexpr int PITCH = 3072;
constexpr int OPITCH = 1024;
constexpr int STAGE_B = 32768;
constexpr int L_OST = 98304;
constexpr int L_WSF = 132096;
constexpr int L_BIAS = 136192;
constexpr int XSTR = 132;
constexpr float LOG2E = 1.4426950408889634f;

__device__ __forceinline__ int crow(int r, int hi) { return (r & 3) + 8 * (r >> 2) + 4 * hi; }
#define ATT_SBAR() __builtin_amdgcn_sched_barrier(0)
__device__ __forceinline__ void glds16(const void* gsrc, unsigned lds_dst) { unsigned keep;
    asm volatile("s_mov_b32 %0, m0\n\ts_mov_b32 m0, %2\n\ts_nop 0\n\tglobal_load_lds_dwordx4 %1, off\n\ts_mov_b32 m0, %0" : "=&s"(keep) : "v"(gsrc), "s"(lds_dst) : "memory"); }
typedef float f32x2_t __attribute__((ext_vector_type(2))); typedef __bf16 bf16x2_t __attribute__((ext_vector_type(2)));
__device__ __forceinline__ unsigned cvtpk(float lo, float hi) { f32x2_t v = {lo, hi}; bf16x2_t b = __builtin_convertvector(v, bf16x2_t); return __builtin_bit_cast(unsigned, b); }

typedef short v4i16_t __attribute__((ext_vector_type(4)));
__device__ __forceinline__ s16x4 vtr(lds_cptr p) { return __builtin_bit_cast(s16x4, __builtin_amdgcn_ds_read_tr16_b64_v4i16((__attribute__((address_space(3))) v4i16_t*)p)); }
__device__ __forceinline__ void qkt(f32x16& p0, f32x16& p1, lds_cptr Kslot, const bf16x8* qr, int r32, int hi) {
    lds_cptr kb = Kslot + r32 * 128; const int sw = (r32 >> 1) & 7;
    const f32x16 z = f32x16{};
#pragma unroll
    for (int d0 = 0; d0 < 4; ++d0) {
        const int off = ((2 * d0 + hi) ^ sw) << 4;
        const bf16x8 b0 = *(const __attribute__((address_space(3))) bf16x8*)(kb + off);
        const bf16x8 b1 = *(const __attribute__((address_space(3))) bf16x8*)(kb + off + 4096);
        if (d0 == 0) { p0 = __builtin_amdgcn_mfma_f32_32x32x16_bf16(b0, qr[0], z, 0, 0, 0); p1 = __builtin_amdgcn_mfma_f32_32x32x16_bf16(b1, qr[0], z, 0, 0, 0); }
        else { p0 = __builtin_amdgcn_mfma_f32_32x32x16_bf16(b0, qr[d0], p0, 0, 0, 0); p1 = __builtin_amdgcn_mfma_f32_32x32x16_bf16(b1, qr[d0], p1, 0, 0, 0); } }
}
#define ATT_TRG(lo_, hi_, vb_, off_) do { _Pragma("unroll") for (int ks = 0; ks < 4; ++ks) { \
        asm volatile("ds_read_b64_tr_b16 %0,%1 offset:%c2" : "=&v"(lo_[ks]) : "v"(vb_), "i"((off_) + ks * 2048) : "memory"); \
        asm volatile("ds_read_b64_tr_b16 %0,%1 offset:%c2" : "=&v"(hi_[ks]) : "v"(vb_), "i"((off_) + ks * 2048 + 1024) : "memory"); } } while (0)
#define ATT_PK(lo_, hi_, k) (bf16x8){lo_[k][0], lo_[k][1], lo_[k][2], lo_[k][3], hi_[k][0], hi_[k][1], hi_[k][2], hi_[k][3]}
#define ATT_MM(acc_, lo_, hi_) do { __builtin_amdgcn_s_setprio(1); \
        acc_ = __builtin_amdgcn_mfma_f32_32x32x16_bf16(pa0, ATT_PK(lo_, hi_, 0), acc_, 0, 0, 0); acc_ = __builtin_amdgcn_mfma_f32_32x32x16_bf16(pa1, ATT_PK(lo_, hi_, 1), acc_, 0, 0, 0); \
        acc_ = __builtin_amdgcn_mfma_f32_32x32x16_bf16(pa2, ATT_PK(lo_, hi_, 2), acc_, 0, 0, 0); acc_ = __builtin_amdgcn_mfma_f32_32x32x16_bf16(pa3, ATT_PK(lo_, hi_, 3), acc_, 0, 0, 0); \
        __builtin_amdgcn_s_setprio(0); } while (0)
template <int NS>
__device__ __forceinline__ void pv(f32x16* o, int vbA, int vbB, bf16x8 pa0, bf16x8 pa1, bf16x8 pa2, bf16x8 pa3) {
    s16x4 loA[4], hiA[4], loB[4], hiB[4];
    asm volatile("s_waitcnt lgkmcnt(0)" ::: "memory");
    ATT_TRG(loA, hiA, vbA, 0);
    ATT_TRG(loB, hiB, vbB, 0);
    asm volatile("s_waitcnt lgkmcnt(8)" ::: "memory"); ATT_SBAR();
    ATT_MM(o[0], loA, hiA);
    if (NS == 2) {
        ATT_SBAR(); ATT_TRG(loA, hiA, vbA, 8192);
        asm volatile("s_waitcnt lgkmcnt(8)" ::: "memory"); ATT_SBAR();
        ATT_MM(o[1], loB, hiB);
        ATT_SBAR(); ATT_TRG(loB, hiB, vbB, 8192);
        asm volatile("s_waitcnt lgkmcnt(8)" ::: "memory"); ATT_SBAR();
        ATT_MM(o[2], loA, hiA);
        asm volatile("s_waitcnt lgkmcnt(0)" ::: "memory"); ATT_SBAR();
        ATT_MM(o[3], loB, hiB);
    } else {
        asm volatile("s_waitcnt lgkmcnt(0)" ::: "memory"); ATT_SBAR();
        ATT_MM(o[1], loB, hiB);
    }
}
__device__ __forceinline__ float rowmax32(const f32x16& p0, const f32x16& p1) {
    float a = p0[0], b = p1[0];
#pragma unroll
    for (int r = 1; r < 16; ++r) { a = __builtin_fmaxf(a, p0[r]); b = __builtin_fmaxf(b, p1[r]); }
    const float m = __builtin_fmaxf(a, b);
    auto rr = __builtin_amdgcn_permlane32_swap(__float_as_uint(m), __float_as_uint(m), false, false);
    return __builtin_fmaxf(__uint_as_float(rr[0]), __uint_as_float(rr[1]));
}
template <int XM> __device__ __forceinline__ float softmax_step(f32x16& p0, f32x16& p1, float& m, float& l) {
    constexpr float THR = 6.0f;
    const float rm = rowmax32(p0, p1);
    float f = 1.0f;
    if (__any(rm > m + THR)) { const float mn = __builtin_fmaxf(m, rm); f = __builtin_amdgcn_exp2f(m - mn); m = mn; l *= f; }
    float s = 0.f;
#pragma unroll
    for (int r = 0; r < 16; ++r) {
        if (XM == 3) { p0[r] = (p0[r] - m) * 0.001f + 0.01f; p1[r] = (p1[r] - m) * 0.001f + 0.01f; }
        else { p0[r] = __builtin_amdgcn_exp2f(p0[r] - m); p1[r] = __builtin_amdgcn_exp2f(p1[r] - m); }
        s += p0[r] + p1[r]; }
    l += s;
    return f;
}

struct UnitDesc {
    int qrow0;
    int qcol, kcol, vcol;
    int latrow, t0, nlat;
    int ctxrow;
    int ocol;
    int r0, head;
};

template <bool DIFF, bool NAM, int XM = 0>
__device__ __forceinline__ void attn_unit(const UnitDesc& U, const bf16_t* __restrict__ proj, bf16_t* __restrict__ out, lds_u8* shm3,
                                          const float* __restrict__ rpb, const float* __restrict__ subg, float lam, float outscale) {
    if (XM == 7) return;
    int tid = threadIdx.x; asm volatile("" : "+v"(tid));
    const int lane = tid & 63, r32 = lane & 31, hi = lane >> 5; const int wid = __builtin_amdgcn_readfirstlane(tid >> 6);
    const unsigned lds0 = (unsigned)(uintptr_t)shm3;
    ATT_LF* wsf = (ATT_LF*)(shm3 + L_WSF + wid * 512);
    constexpr int SUBS = DIFF ? 1 : 2;
    const int ntile = U.nlat + 4;
    const int nstage = (XM == 6) ? 1 : (ntile + SUBS - 1) / SUBS;
    const int qblk = DIFF ? (wid >> 1) : wid, sh = DIFF ? (wid & 1) : 0;
    if (NAM) { ATT_LF* bl = (ATT_LF*)(shm3 + L_BIAS);
        for (int i = tid; i < 15 * 31; i += 512) { const int ro = i / 31, j = i - ro * 31; bl[ro * 128 + 48 + j] = rpb[(U.head * 15 + ro) * 31 + j] * LOG2E; } }
    const bf16_t* ksrc0 = proj + (size_t)(8 * wid + (lane >> 3)) * PITCH + U.kcol + (((lane & 7) ^ ((4 * wid + (lane >> 4)) & 7)) << 3);
    const bf16_t* vsrc0 = proj + (size_t)(8 * wid + (lane >> 3)) * PITCH + U.vcol + (((lane & 7) ^ (((lane >> 4) & 1) << 2)) << 3);
    const unsigned dstw = lds0 + wid * 1024;
#define ATT_TILE_ROW(i) (((i) < U.nlat) ? (U.latrow + 64 * (U.t0 + (i))) : (U.ctxrow + 64 * ((i) - U.nlat)))
#define ATT_DMA_STAGE(s_) do { if (XM == 5 || XM >= 9) break; const int s__ = (s_); const unsigned d_ = (unsigned)__builtin_amdgcn_readfirstlane((int)(dstw + (s__ & 3) * STAGE_B)); \
        if (DIFF) { const size_t ro_ = (size_t)ATT_TILE_ROW(s__) * PITCH; glds16(ksrc0 + ro_, d_); glds16(ksrc0 + ro_ + 64, d_ + 8192); glds16(vsrc0 + ro_, d_ + 16384); glds16(vsrc0 + ro_ + 64, d_ + 24576); } \
        else { const size_t ro_ = (size_t)ATT_TILE_ROW(2 * s__) * PITCH; glds16(ksrc0 + ro_, d_); glds16(vsrc0 + ro_, d_ + 16384); \
               { const int t1_ = (2 * s__ + 1 < ntile) ? 2 * s__ + 1 : 2 * s__; const size_t r1_ = (size_t)ATT_TILE_ROW(t1_) * PITCH; glds16(ksrc0 + r1_, d_ + 8192); glds16(vsrc0 + r1_, d_ + 24576); } } } while (0)
    const bf16_t* Qw = proj + (size_t)(U.qrow0 + qblk * 32 + r32) * PITCH + U.qcol + sh * 64 + hi * 8;
    bf16x8 qr[4];
#pragma unroll
    for (int d0 = 0; d0 < 4; ++d0) qr[d0] = *(const bf16x8*)(Qw + d0 * 16);
    float m1 = -1e30f, l1 = 0.f;
    constexpr int NO = DIFF ? 4 : 2;
    f32x16 o[NO];
#pragma unroll
    for (int i = 0; i < NO; ++i) o[i] = f32x16{};
    const int dsw_ = ((lane & 15) >> 3) & 1;
    const int vbl = (int)lds0 + 16384 + (4 * hi + ((lane & 15) >> 2)) * 128 + ((lane >> 4) & 1) * 32 + (lane & 3) * 8;
    const int vblA = vbl + dsw_ * 64, vblB = vbl + (1 - dsw_) * 64;
    const int gr = U.r0 + (wid >> 1); const int rs = gr < 4 ? 0 : (gr > 28 ? 24 : gr - 4);
    const int qc = 32 * (wid & 1) + r32; const int cs = qc < 8 ? 0 : (qc > 56 ? 48 : qc - 8);
#define ATT_USE(j) ((j) < ntile && (!NAM || (j) >= U.nlat || ((U.t0 + (j)) >= rs && (U.t0 + (j)) <= rs + 7)))
#define ATT_KSLOT(j) ((lds_cptr)(shm3 + (((j) / SUBS) & 3) * STAGE_B + (DIFF ? sh * 8192 : ((j) & 1) * 8192)))
#define ATT_WAIT_BAR(N) do { if (XM < 9) asm volatile("s_waitcnt vmcnt(" #N ") lgkmcnt(0)\n\ts_barrier" ::: "memory"); } while (0)
    ATT_DMA_STAGE(0);
    if (nstage > 1) ATT_DMA_STAGE(1);
    if (nstage > 2) ATT_DMA_STAGE(2);
    if (nstage > 2) ATT_WAIT_BAR(8); else if (nstage > 1) ATT_WAIT_BAR(4); else ATT_WAIT_BAR(0);
    f32x16 sc0 = f32x16{}, sc1 = f32x16{}, sn0 = f32x16{}, sn1 = f32x16{};
    if (ATT_USE(0)) qkt(sc0, sc1, ATT_KSLOT(0), qr, r32, hi);
    for (int s = 0; s < nstage; ++s) {
#pragma unroll
        for (int sub = 0; sub < SUBS; ++sub) {
            const int j = s * SUBS + sub;
            if (sub == SUBS - 1 && s + 1 < nstage) {
                if (s + 2 < nstage) ATT_WAIT_BAR(4); else ATT_WAIT_BAR(0);
                if (s + 3 < nstage) ATT_DMA_STAGE(s + 3);
            }
            const bool un = ATT_USE(j + 1), uc = ATT_USE(j);
            if (un) { if (XM == 4 || XM == 12) { sn0 = f32x16{}; sn1 = f32x16{}; asm volatile("" : "+v"(sn0), "+v"(sn1)); } else qkt(sn0, sn1, ATT_KSLOT(j + 1), qr, r32, hi); }
            if (uc) {
                if (NAM && j < U.nlat) {
                    const int kr = U.t0 + j;
                    const ATT_LF* brow = (const ATT_LF*)(shm3 + L_BIAS) + (kr - gr + 7) * 128 + 48 + 15 - qc + 4 * hi;
#pragma unroll
                    for (int r = 0; r < 16; ++r) { const int kc = (r & 3) + 8 * (r >> 2); const int kcl = kc + 4 * hi;
                        const float b0 = brow[kc], b1 = brow[kc + 32];
                        sc0[r] = ((unsigned)(kcl - cs) < 16u) ? sc0[r] + b0 : -INFINITY;
                        sc1[r] = ((unsigned)(kcl + 32 - cs) < 16u) ? sc1[r] + b1 : -INFINITY;
                        if ((r & 3) == 3) ATT_SBAR(); }
                }
                if (XM < 10) { const float rm = rowmax32(sc0, sc1);
                  if (__any(rm > m1 + 6.0f)) {
                      const float mn = __builtin_fmaxf(m1, rm); const float f = __builtin_amdgcn_exp2f(m1 - mn); m1 = mn; l1 *= f;
                      if (hi == 0) wsf[r32] = f;
                      asm volatile("s_waitcnt lgkmcnt(0)" ::: "memory");
                      float fr_[16];
#pragma unroll
                      for (int r = 0; r < 16; ++r) fr_[r] = wsf[crow(r, hi)];
#pragma unroll
                      for (int d = 0; d < NO; ++d)
#pragma unroll
                          for (int r = 0; r < 16; ++r) o[d][r] *= fr_[r];
                      asm volatile("s_waitcnt lgkmcnt(0)" ::: "memory");
                  } }
                { const int vbo = (s & 3) * STAGE_B + (DIFF ? 0 : sub * 8192);
                  lds_cptr vpA = (lds_cptr)(uintptr_t)(unsigned)(vblA + vbo), vpB = (lds_cptr)(uintptr_t)(unsigned)(vblB + vbo);
                  float ssum = 0.f;
                  bf16x8 vfc[NO], vfn[NO]; bf16x8 pac, pan;
#define ATT_VLD(dst, ks_) do { if (XM == 11 || XM == 13) { _Pragma("unroll") for (int d = 0; d < NO; ++d) { dst[d] = (bf16x8){1, 2, 3, 4, 5, 6, 7, 8}; asm volatile("" : "+v"(dst[d])); } break; } _Pragma("unroll") for (int d = 0; d < NO; ++d) { lds_cptr vp_ = ((d & 1) ? vpB : vpA) + (d >> 1) * 8192 + (ks_) * 2048; \
                      const s16x4 lo_ = vtr(vp_), hi_ = vtr(vp_ + 1024); dst[d] = (bf16x8){lo_[0], lo_[1], lo_[2], lo_[3], hi_[0], hi_[1], hi_[2], hi_[3]}; } } while (0)
#define ATT_EXP8(dst, ks_) do { float e_[8]; _Pragma("unroll") for (int i = 0; i < 8; ++i) { const float x_ = ((ks_) < 2) ? sc0[((ks_) & 1) * 8 + i] : sc1[((ks_) & 1) * 8 + i]; e_[i] = (XM >= 10) ? x_ : __builtin_amdgcn_exp2f(x_ - m1); ssum += e_[i]; } \
                      const u32x4 pw_ = (u32x4){cvtpk(e_[0], e_[1]), cvtpk(e_[2], e_[3]), cvtpk(e_[4], e_[5]), cvtpk(e_[6], e_[7])}; dst = __builtin_bit_cast(bf16x8, pw_); } while (0)
                  ATT_VLD(vfc, 0); ATT_EXP8(pac, 0);
#pragma unroll
                  for (int ks = 0; ks < 4; ++ks) {
                      if (ks < 3) { ATT_VLD(vfn, ks + 1); ATT_EXP8(pan, ks + 1); }
#pragma unroll
                      for (int d = 0; d < NO; ++d) { if (XM == 13) { asm volatile("" :: "v"(pac), "v"(vfc[d])); } else o[d] = __builtin_amdgcn_mfma_f32_32x32x16_bf16(pac, vfc[d], o[d], 0, 0, 0); }
                      if (ks < 3) {
#pragma unroll
                          for (int d = 0; d < NO; ++d) { vfc[d] = vfn[d];
                              __builtin_amdgcn_sched_group_barrier(0x008, 1, 0); __builtin_amdgcn_sched_group_barrier(0x100, 2, 0); __builtin_amdgcn_sched_group_barrier(0x002, DIFF ? 7 : 14, 0); }
                          pac = pan; }
                  }
#undef ATT_VLD
#undef ATT_EXP8
                  l1 += ssum; }
            }
            sc0 = sn0; sc1 = sn1;
        }
    }
    { auto rr = __builtin_amdgcn_permlane32_swap(__float_as_uint(l1), __float_as_uint(l1), false, false); l1 = __uint_as_float(rr[0]) + __uint_as_float(rr[1]); }
    if (hi == 0) wsf[32 + r32] = (DIFF && sh == 1) ? lam / l1 : 1.0f / l1;
    asm volatile("s_waitcnt lgkmcnt(0)" ::: "memory");
    float rli[16];
#pragma unroll
    for (int r = 0; r < 16; ++r) rli[r] = wsf[32 + crow(r, hi)];
    if (!DIFF) {
        bf16_t* Ow = out + (size_t)(U.qrow0 + wid * 32) * OPITCH + U.ocol;
        asm volatile("s_waitcnt lgkmcnt(0)\n\ts_barrier" ::: "memory");
        __attribute__((address_space(3))) bf16_t* stg = (__attribute__((address_space(3))) bf16_t*)(shm3 + wid * 4096);
#pragma unroll
        for (int r = 0; r < 16; ++r) { const int orow = crow(r, hi);
#pragma unroll
            for (int d0 = 0; d0 < 2; ++d0) stg[orow * 64 + d0 * 32 + r32] = (bf16_t)(cvtpk(o[d0][r] * rli[r], 0.f) & 0xffffu); }
        asm volatile("s_waitcnt lgkmcnt(0)" ::: "memory");
#pragma unroll
        for (int i = 0; i < 4; ++i) { const int row = i * 8 + (lane >> 3), ch = lane & 7; const u32x4 v = *(const __attribute__((address_space(3))) u32x4*)(stg + row * 64 + ch * 8); *(u32x4*)(Ow + (size_t)row * OPITCH + ch * 8) = v; }
        asm volatile("s_waitcnt lgkmcnt(0)\n\ts_barrier" ::: "memory");
    } else {
        asm volatile("s_waitcnt lgkmcnt(0)\n\ts_barrier" ::: "memory");
        ATT_LF* X = (ATT_LF*)shm3 + qblk * 32 * XSTR;
        if (sh == 1) {
#pragma unroll
            for (int r = 0; r < 16; ++r)
#pragma unroll
                for (int d0 = 0; d0 < 4; ++d0) X[crow(r, hi) * XSTR + d0 * 32 + r32] = o[d0][r] * rli[r];
        }
        asm volatile("s_waitcnt lgkmcnt(0)\n\ts_barrier" ::: "memory");
        if (sh == 0) {
#pragma unroll
            for (int r = 0; r < 16; ++r)
#pragma unroll
                for (int d0 = 0; d0 < 4; ++d0) { ATT_LF* p = X + crow(r, hi) * XSTR + d0 * 32 + r32; *p = o[d0][r] * rli[r] - *p; }
            asm volatile("s_waitcnt lgkmcnt(0)" ::: "memory");
            const int rowl = lane >> 1, hf = lane & 1;
            float v[64]; float ss = 0.f;
#pragma unroll
            for (int e4 = 0; e4 < 16; ++e4) { const f32x4 x = *(const __attribute__((address_space(3))) f32x4*)(X + rowl * XSTR + hf * 64 + e4 * 4);
                v[e4 * 4 + 0] = x[0]; v[e4 * 4 + 1] = x[1]; v[e4 * 4 + 2] = x[2]; v[e4 * 4 + 3] = x[3]; ss += x[0] * x[0] + x[1] * x[1] + x[2] * x[2] + x[3] * x[3]; }
            ss += __shfl_xor(ss, 1);
            const float rstd = outscale / sqrtf(ss * (1.0f / 128.0f) + 1e-5f);
            bf16_t* dst = out + (size_t)(U.qrow0 + qblk * 32 + rowl) * OPITCH + U.ocol + hf * 64;
#pragma unroll
            for (int e8 = 0; e8 < 8; ++e8) { const f32x4 g0 = *(const f32x4*)(subg + hf * 64 + e8 * 8), g1 = *(const f32x4*)(subg + hf * 64 + e8 * 8 + 4); u32x4 w;
                w.x = cvtpk(v[e8 * 8 + 0] * rstd * g0[0], v[e8 * 8 + 1] * rstd * g0[1]); w.y = cvtpk(v[e8 * 8 + 2] * rstd * g0[2], v[e8 * 8 + 3] * rstd * g0[3]);
                w.z = cvtpk(v[e8 * 8 + 4] * rstd * g1[0], v[e8 * 8 + 5] * rstd * g1[1]); w.w = cvtpk(v[e8 * 8 + 6] * rstd * g1[2], v[e8 * 8 + 7] * rstd * g1[3]);
                *(u32x4*)(dst + e8 * 8) = w; }
        }
        asm volatile("s_waitcnt lgkmcnt(0)\n\ts_barrier" ::: "memory");
    }
#undef ATT_TILE_ROW
#undef ATT_DMA_STAGE
#undef ATT_USE
#undef ATT_KSLOT
#undef ATT_WAIT_BAR
}
#undef ATT_SBAR
#undef ATT_TRG
#undef ATT_PK
#undef ATT_MM
#undef ATT_LF
}
constexpr int NWAVES = 8;
constexpr int NB = 8, SEQ = 2048, LC = 256, DM = 1024, FF = 4096, NPROJ = 3072;
constexpr int ML = NB * SEQ;
constexpr int MC = NB * LC;
constexpr int MT = ML + MC;
constexpr float NORM_EPS = 1e-6f;

constexpr size_t MiB = 1u << 20;
constexpr size_t WS_CTL = 0, CTL_ZERO_BYTES = 256 * 1024;
constexpr size_t WS_ROWSS1 = 64 * 1024;
constexpr size_t WS_BIAS2 = 1 * MiB + 512 * 1024 + 32 * 1024;
constexpr size_t WS_MADA = 1 * MiB;
constexpr size_t WS_ROPE = 1 * MiB + 512 * 1024;
constexpr size_t WS_LAM  = WS_ROPE + 16384;
constexpr size_t WS_MP = 1 * MiB + 512 * 1024 + 192 * 1024;
constexpr size_t WS_WIN = 2 * MiB, WS_WOUT = 8 * MiB, WS_W1_0 = 10 * MiB, WS_W2_0 = 18 * MiB;
constexpr size_t WS_W1_1 = 26 * MiB, WS_W2_1 = 34 * MiB, WS_WGLU = 42 * MiB;
constexpr size_t WS_SSM_WEND = 2 * MiB;
constexpr size_t WS_SSM_B2 = 10 * MiB;
constexpr size_t WS_HB = 46 * MiB;
constexpr size_t WS_BIG = 82 * MiB;
constexpr size_t WS_SEND = 162 * MiB;
constexpr size_t WS_XC = 226 * MiB;
constexpr size_t WS_H2B = 210 * MiB;
constexpr size_t WS_KD = 254 * MiB;
constexpr size_t WS_END = 256 * MiB;
static_assert(WS_BIG + (size_t)MT * FF * 2 <= WS_XC, "hid fits");
static_assert(WS_SEND + (size_t)64 * 1152 * 256 * 4 <= WS_END, "S_end fits");
static_assert(WS_BIG + (size_t)64 * 1280 * 512 * 2 <= WS_SEND, "A2 fits");

constexpr int RING_BYTES = 131072;
constexpr int LDSCTL_OFF = RING_BYTES, MISC_OFF = LDSCTL_OFF + 320;
constexpr int LDS_BYTES = 147456;

#define GAS __attribute__((address_space(1)))
#define LAS __attribute__((address_space(3)))
typedef unsigned short bf16;
typedef unsigned v4u __attribute__((ext_vector_type(4)));
typedef unsigned v2u __attribute__((ext_vector_type(2)));
typedef float f32x4 __attribute__((ext_vector_type(4)));
typedef GAS unsigned gu32;
#define RLX_AGENT __ATOMIC_RELAXED, __HIP_MEMORY_SCOPE_AGENT
#define LDS_WAIT() asm volatile("s_waitcnt lgkmcnt(0)" ::: "memory")
#define VM_WAIT() asm volatile("s_waitcnt vmcnt(0)" ::: "memory")
__device__ __forceinline__ unsigned f2bf(float f) { unsigned u = __builtin_bit_cast(unsigned, f); return (u + 0x7fffu + ((u >> 16) & 1u)) >> 16; }
__device__ __forceinline__ unsigned pk2(float lo, float hi) { return f2bf(lo) | (f2bf(hi) << 16); }

#define XB_TMO      128
#define XB_XCNT(j)  (256  + 64 * (j))
#define XB_XSUB(j)  (1280 + 64 * (j))
#define XB_XGEN(j)  (2304 + 64 * (j))
#define XB_TOP      3328
#define XB_TOPGEN   3392
#define XCD_BAR_WORDS 3456
#define XB_SPIN_CAP (1u << 18)
__device__ __forceinline__ unsigned xb_ld(unsigned* p)              { return __hip_atomic_load(p, __ATOMIC_RELAXED, __HIP_MEMORY_SCOPE_AGENT); }
__device__ __forceinline__ unsigned xb_add(unsigned* p, unsigned v) { return __hip_atomic_fetch_add(p, v, __ATOMIC_RELAXED, __HIP_MEMORY_SCOPE_AGENT); }
__device__ __forceinline__ unsigned xb_xcc_id() { return (unsigned)__builtin_amdgcn_s_getreg((3 << 11) | 20) & 0xFu; }
#define XB_SPIN(cond, bar) do { unsigned _sp = 0; while (cond) { __builtin_amdgcn_s_sleep(1); \
    if ((++_sp & 255u) == 0u) { if (xb_ld(&(bar)[XB_TMO])) break; if (_sp > XB_SPIN_CAP) { atomicAdd(&(bar)[XB_TMO], 1u); break; } } } } while (0)
struct XcdBarrier { unsigned* bar; unsigned x; volatile LAS unsigned* st; };
__device__ __forceinline__ XcdBarrier xcd_barrier_post(unsigned* bar, volatile LAS unsigned* st) {
    XcdBarrier b; b.bar = bar; b.x = xb_xcc_id(); b.st = st;
    if (threadIdx.x == 0) (void)xb_add(&bar[XB_XCNT(b.x)], 1u);
    return b;
}
__device__ __forceinline__ void xcd_barrier_complete(unsigned* bar, unsigned x, unsigned& nloc, unsigned& nx) {
    const unsigned G = gridDim.x * gridDim.y * gridDim.z;
    unsigned sum, cnt, mine, sp = 0u;
    for (;;) {
        sum = 0u; cnt = 0u; mine = 0u;
#pragma unroll
        for (unsigned j = 0; j < 16; ++j) { const unsigned c = xb_ld(&bar[XB_XCNT(j)]); sum += c; cnt += (c > 0u) ? 1u : 0u; mine = (j == x) ? c : mine; }
        if (sum == G) break;
        __builtin_amdgcn_s_sleep(1);
        if ((++sp & 255u) == 0u) { if (xb_ld(&bar[XB_TMO])) break; if (sp > XB_SPIN_CAP) { atomicAdd(&bar[XB_TMO], 1u); break; } }
    }
    nloc = mine > 0u ? mine : 1u; nx = cnt > 0u ? cnt : 1u;
}
__device__ __forceinline__ void xcd_barrier(const XcdBarrier& b) {
    asm volatile("s_waitcnt vmcnt(0)" ::: "memory");
    __syncthreads();
    if (threadIdx.x == 0) {
        unsigned* bar = b.bar;
        __builtin_amdgcn_s_waitcnt(0);
        unsigned nloc = b.st[0], nx = b.st[1];
        if (nloc == 0u) { xcd_barrier_complete(bar, b.x, nloc, nx); b.st[0] = nloc; b.st[1] = nx; }
        const unsigned k = b.st[2]; b.st[2] = k + 1u;
        const unsigned old = xb_add(&bar[XB_XSUB(b.x)], 1u);
        if (old + 1u == (k + 1u) * nloc) {
            __builtin_amdgcn_fence(__ATOMIC_RELEASE, "agent");
            asm volatile("s_waitcnt vmcnt(0)" ::: "memory");
            (void)xb_add(&bar[XB_TOP], 1u);
        }
        XB_SPIN(xb_ld(&bar[XB_TOP]) < (k + 1u) * nx, bar);
        __builtin_amdgcn_fence(__ATOMIC_ACQUIRE, "agent");
        asm volatile("s_waitcnt vmcnt(0)" ::: "memory");
    }
    __syncthreads();
}

struct Frame {
    LAS unsigned char* lds;
    int vcu, G;
};
__device__ __forceinline__ float wave_sum(float v) {
#pragma unroll
    for (int o = 1; o < 64; o <<= 1) v += __shfl_xor(v, o);
    return v;
}

__device__ __forceinline__ void p0_transpose_item(const float* W, int K, int N, bf16* WT, int radd, LAS float* scr, int item, int lane) {
    const int nblk = N / 64, kb = item / nblk, nb = item % nblk, k0 = 64 * kb, n0 = 64 * nb;
    float v_[64];
    const float* wp = W + (size_t)k0 * N + n0 + lane;
#pragma unroll
    for (int i = 0; i < 64; ++i) v_[i] = __builtin_nontemporal_load(wp + (size_t)i * N);
    LAS unsigned short* t = (LAS unsigned short*)scr;
#pragma unroll
    for (int i = 0; i < 64; ++i) t[i * 66 + lane] = (unsigned short)f2bf(v_[i]);
    LDS_WAIT(); asm volatile("" ::: "memory");
    const int c = lane & 7;
#pragma unroll
    for (int j = 0; j < 8; ++j) { const int n = (lane >> 3) + 8 * j; const LAS unsigned short* s = t + (8 * c) * 66 + n;
        v4u o; o.x = (unsigned)s[0 * 66] | ((unsigned)s[1 * 66] << 16); o.y = (unsigned)s[2 * 66] | ((unsigned)s[3 * 66] << 16); o.z = (unsigned)s[4 * 66] | ((unsigned)s[5 * 66] << 16); o.w = (unsigned)s[6 * 66] | ((unsigned)s[7 * 66] << 16);
        *(GAS v4u*)(WT + (size_t)(radd + n0 + n) * K + k0 + 8 * c) = o; }
    LDS_WAIT(); asm volatile("" ::: "memory");
}

struct Args {
    const float* in[29]; float* out; unsigned char* ws; int pad0, pad1;
};

struct ModVec { f32x4 gm[4], sh[4]; };
__device__ __forceinline__ void load_modvec(ModVec& mv, const float* normg, const float* mrow  , int lane) {
#pragma unroll
    for (int j = 0; j < 4; ++j) { const int c = 4 * lane + 256 * j;
        const f32x4 g = *(const f32x4*)(normg + c), sc = *(const f32x4*)(mrow + 1024 + c); mv.sh[j] = *(const f32x4*)(mrow + c);
        mv.gm[j] = g * (sc + 1.0f); }
}
__device__ __forceinline__ void load_modvec4(ModVec& mv, const float* normg, const float* mp_r  , int lane) {
#pragma unroll
    for (int j = 0; j < 4; ++j) { const int c = 4 * lane + 256 * j;
        f32x4 sh = *(const f32x4*)(mp_r + c), sc = *(const f32x4*)(mp_r + 1024 + c);
#pragma unroll
        for (int q = 1; q < 4; ++q) { sh += *(const f32x4*)(mp_r + q * 9 * 2048 + c); sc += *(const f32x4*)(mp_r + q * 9 * 2048 + 1024 + c); }
        mv.sh[j] = sh; mv.gm[j] = *(const f32x4*)(normg + c) * (sc + 1.0f); }
}
__device__ __forceinline__ void norm_load(const float* xrow, int lane, f32x4 (&v)[4]) {
    const f32x4* xr = (const f32x4*)xrow + lane;
#pragma unroll
    for (int j = 0; j < 4; ++j) v[j] = __builtin_nontemporal_load(xr + 64 * j);
}
__device__ __forceinline__ f32x4 bf4_to_f32(v2u w) { return (f32x4){__uint_as_float(w.x << 16), __uint_as_float(w.x & 0xffff0000u), __uint_as_float(w.y << 16), __uint_as_float(w.y & 0xffff0000u)}; }
__device__ __forceinline__ void norm_load(const bf16* xrow, int lane, f32x4 (&v)[4]) {
#pragma unroll
    for (int j = 0; j < 4; ++j) v[j] = bf4_to_f32(*(const v2u*)(xrow + 4 * lane + 256 * j));
}
template <int NS>
__device__ __forceinline__ f32x4 slab_sum(const bf16* srow, int c) {
    constexpr size_t SS = (size_t)2048 * 1024; f32x4 s = (f32x4){0.f, 0.f, 0.f, 0.f};
#pragma unroll
    for (int i = 0; i < NS; ++i) s += bf4_to_f32(*(const v2u*)(srow + i * SS + c));
    return s;
}
template <int NS>
__device__ __forceinline__ void norm_load_fix(const bf16* brow, const bf16* srow, const float* gate, int lane, f32x4 (&v)[4]) {
#pragma unroll
    for (int j = 0; j < 4; ++j) { const int c = 4 * lane + 256 * j; v[j] = bf4_to_f32(*(const v2u*)(brow + c)) + *(const f32x4*)(gate + c) * slab_sum<NS>(srow, c); }
}
template <int NS>
__device__ __forceinline__ void norm_load_fix(const float* brow, const bf16* srow, const float* gate, int lane, f32x4 (&v)[4]) {
#pragma unroll
    for (int j = 0; j < 4; ++j) { const int c = 4 * lane + 256 * j; v[j] = *(const f32x4*)(brow + c) + *(const f32x4*)(gate + c) * slab_sum<NS>(srow, c); }
}
__device__ __forceinline__ void norm_finish(const f32x4 (&v)[4], const ModVec& mv, f32x4 (&y)[4]) {
    float s = 0.f;
#pragma unroll
    for (int j = 0; j < 4; ++j) s += (v[j].x * v[j].x + v[j].y * v[j].y) + (v[j].z * v[j].z + v[j].w * v[j].w);
    const float rstd = 1.0f / sqrtf(wave_sum(s) * (1.0f / 1024.0f) + NORM_EPS);
#pragma unroll
    for (int j = 0; j < 4; ++j) y[j] = v[j] * rstd * mv.gm[j] + mv.sh[j];
}

__device__ __forceinline__ void sincos_acc(double ang, float& s, float& c) {
    double rev = ang * 0.15915494309189535; rev -= floor(rev);
    const float r = (float)rev;
    s = __builtin_amdgcn_sinf(r); c = __builtin_amdgcn_cosf(r);
}
enum { I_X = 0, I_C, I_CTX, I_CCTX, I_WADA, I_BADA, I_N1G, I_N2G, I_FG, I_WIN, I_WOUT, I_LQ1, I_LK1, I_LQ2, I_LK2, I_SUBG, I_RPB,
       I_SLRE, I_SLIM, I_SLOG, I_SBRE, I_SBIM, I_SCRE, I_SCIM, I_SD, I_GLUA, I_GLUB, I_W1, I_W2 };

__global__ void __launch_bounds__(NWAVES * 64, 2) fwd_kernel(Args args) {
    extern __shared__ __attribute__((aligned(16))) unsigned char lds[];
    Frame F;
    F.lds = (LAS unsigned char*)lds;
    volatile LAS unsigned* MISC = (volatile LAS unsigned*)(F.lds + MISC_OFF);
    F.G = gridDim.x; { const int bx = blockIdx.x; F.vcu = (F.G % 8 == 0) ? (bx % 8) * (F.G / 8) + bx / 8 : bx; }
    unsigned* barwords; { unsigned char* ws0 = args.ws; barwords = (unsigned*)(ws0 + WS_CTL) + 1024; }
    for (int u = threadIdx.x; u < (LDS_BYTES - LDSCTL_OFF) / 4; u += NWAVES * 64) ((LAS unsigned*)(F.lds + LDSCTL_OFF))[u] = 0u;
    __syncthreads();
    XcdBarrier bar = xcd_barrier_post(barwords, MISC + 8);
#ifdef PROBE_TS
    unsigned long long* tsbuf = (unsigned long long*)(args.ws + 32768);
    int ts_n = 0;
#define TS_STAMP() do { if (blockIdx.x == 0 && threadIdx.x == 0) { tsbuf[ts_n] = __builtin_amdgcn_s_memrealtime(); } ++ts_n; } while (0)
    TS_STAMP();
#define GRID_BAR() do { xcd_barrier(bar); TS_STAMP(); } while (0)
#else
#define GRID_BAR() xcd_barrier(bar)
#endif
    const int NGW = F.G * NWAVES;
#define FRESH_IDS() int tid = threadIdx.x; asm volatile("" : "+v"(tid)); const int lane = tid & 63; const int wave = __builtin_amdgcn_readfirstlane(tid >> 6); const int gw = F.vcu * NWAVES + wave; (void)lane; (void)gw

    typedef const float* const __attribute__((address_space(4)))* ArgTab;
#define PHASE_ENV() unsigned long long kap_ = (unsigned long long)__builtin_amdgcn_kernarg_segment_ptr(); asm volatile("" : "+s"(kap_)); const ArgTab atab_ = (ArgTab)kap_; \
        unsigned char* ws = (unsigned char*)atab_[30]; bf16* xl = (bf16*)atab_[29]; float* outf = (float*)atab_[29]; const float* x_in = atab_[I_X]; const float* ctx_in = atab_[I_CTX]; \
        bf16* xc = (bf16*)(ws + WS_XC); float* mada = (float*)(ws + WS_MADA); float* rope = (float*)(ws + WS_ROPE); float* lamp = (float*)(ws + WS_LAM); \
        bf16* HB = (bf16*)(ws + WS_HB); bf16* BIG = (bf16*)(ws + WS_BIG); \
        (void)xl; (void)outf; (void)x_in; (void)ctx_in; (void)xc; (void)mada; (void)rope; (void)lamp; (void)HB; (void)BIG
#define AIN(i) (atab_[i])
#define SLAB7 (xl + (size_t)ML * 1024)
#define ADALN_ITEM(L_, CG_) do { const int l = (L_), cg = (CG_); \
            LAS float* act = (LAS float*)F.lds;                 \
            LAS float* red = (LAS float*)(F.lds + 36864);       \
            const float* c = AIN(I_C); const float* cc = AIN(I_CCTX); \
            for (int i = tid; i < 9216; i += 512) { const float v = (i < 8192) ? c[i] : cc[i - 8192]; act[i] = v / (1.0f + __expf(-v)); } \
            __syncthreads(); \
            const float* W = AIN(I_WADA) + (size_t)l * 1024 * 6144 + cg * 64 + lane; \
            float acc[9]; \
            _Pragma("unroll") for (int r = 0; r < 9; ++r) acc[r] = 0.f; \
            const int k0 = wave * 128; \
            for (int k4 = 0; k4 < 128; k4 += 32) { float wv[32]; \
                _Pragma("unroll") for (int i = 0; i < 32; ++i) wv[i] = __builtin_nontemporal_load(W + (size_t)(k0 + k4 + i) * 6144); \
                _Pragma("unroll") for (int i = 0; i < 32; ++i) \
                    _Pragma("unroll") for (int r = 0; r < 9; ++r) acc[r] += act[r * 1024 + k0 + k4 + i] * wv[i]; } \
            _Pragma("unroll") for (int r = 0; r < 9; ++r) red[(wave * 9 + r) * 64 + lane] = acc[r]; \
            __syncthreads(); \
            for (int i = tid; i < 576; i += 512) { const int r = i / 64, cl = i % 64; float s_ = AIN(I_BADA)[l * 6144 + cg * 64 + cl]; \
                _Pragma("unroll") for (int w = 0; w < 8; ++w) s_ += red[(w * 9 + r) * 64 + cl]; \
                mada[(l * 9 + r) * 6144 + cg * 64 + cl] = s_; } \
            __syncthreads(); } while (0)
#define ADALN_QITEM(CG_, KQ_) do { const int cg = (CG_), kq = (KQ_); \
            LAS float* act = (LAS float*)F.lds;                 \
            LAS float* red = (LAS float*)(F.lds + 36864);       \
            const float* c = AIN(I_C); const float* cc = AIN(I_CCTX); \
            for (int i = tid; i < 9 * 256; i += 512) { const int r = i >> 8, k = kq * 256 + (i & 255); const float v = (r < 8) ? c[r * 1024 + k] : cc[k]; act[i] = v / (1.0f + __expf(-v)); } \
            __syncthreads(); \
            const float* W = AIN(I_WADA) + cg * 64 + lane; \
            float acc[9]; \
            _Pragma("unroll") for (int r = 0; r < 9; ++r) acc[r] = 0.f; \
            const int kl = wave * 32; \
            { float wv[32]; \
                _Pragma("unroll") for (int i = 0; i < 32; ++i) wv[i] = __builtin_nontemporal_load(W + (size_t)(kq * 256 + kl + i) * 6144); \
                _Pragma("unroll") for (int i = 0; i < 32; ++i) \
                    _Pragma("unroll") for (int r = 0; r < 9; ++r) acc[r] += act[r * 256 + kl + i] * wv[i]; } \
            _Pragma("unroll") for (int r = 0; r < 9; ++r) red[(wave * 9 + r) * 64 + lane] = acc[r]; \
            __syncthreads(); \
            for (int i = tid; i < 576; i += 512) { const int r = i / 64, cl = i % 64; float s_ = (kq == 0) ? AIN(I_BADA)[cg * 64 + cl] : 0.f; \
                _Pragma("unroll") for (int w = 0; w < 8; ++w) s_ += red[(w * 9 + r) * 64 + cl]; \
                ((float*)(ws + WS_MP))[(kq * 9 + r) * 2048 + cg * 64 + cl] = s_; } \
            __syncthreads(); } while (0)
#define KD_ITEM(G_, LQ_) do { const int g = (G_), lq = (LQ_); \
            LAS float* apr = (LAS float*)F.lds;                 \
            LAS float* api = apr + 512; \
            LAS float* bbr = api + 512;                         \
            LAS float* bbi = bbr + 2048; \
            LAS float* Cr = bbi + 2048;                         \
            LAS float* Ci = Cr + 2048; \
            { const int d = tid >> 8, jj = (tid >> 6) & 3, p = tid & 63; const int gp = (d * 64 + g) * 64 + p; \
                const float lr = AIN(I_SLRE)[gp], li = AIN(I_SLIM)[gp]; const float delta = expf(AIN(I_SLOG)[d * 64 + g]); \
                const f32x4 br4 = *(const f32x4*)(AIN(I_SBRE) + (size_t)gp * 16 + 4 * jj), bi4 = *(const f32x4*)(AIN(I_SBIM) + (size_t)gp * 16 + 4 * jj); \
                { const int j = 4 * lq + jj; const float mag = expf(lr * delta * (float)j); float sn, cs; sincos_acc((double)li * (double)delta * (double)j, sn, cs); \
                    apr[(d * 4 + jj) * 64 + p] = mag * cs; api[(d * 4 + jj) * 64 + p] = mag * sn; } \
                float sn1, cs1; sincos_acc((double)li * (double)delta, sn1, cs1); const float mag1 = expf(lr * delta); \
                const float ar = mag1 * cs1, ai = mag1 * sn1; \
                const float den = lr * lr + li * li, nr = ar - 1.0f; const float cr = (nr * lr + ai * li) / den, ci = (ai * lr - nr * li) / den; \
                f32x4 or_, oi_; \
                _Pragma("unroll") for (int e = 0; e < 4; ++e) { or_[e] = cr * br4[e] - ci * bi4[e]; oi_[e] = cr * bi4[e] + ci * br4[e]; } \
                *(LAS f32x4*)(bbr + (d * 64 + p) * 16 + 4 * jj) = or_; *(LAS f32x4*)(bbi + (d * 64 + p) * 16 + 4 * jj) = oi_; } \
            for (int i = tid; i < 2048; i += 512) { const int d = i >> 10, h = (i >> 6) & 15, p = i & 63; \
                Cr[i] = AIN(I_SCRE)[((size_t)(d * 64 + g) * 16 + h) * 64 + p]; Ci[i] = AIN(I_SCIM)[((size_t)(d * 64 + g) * 16 + h) * 64 + p]; } \
            __syncthreads(); \
            { const int d = tid >> 8, jj = (tid >> 6) & 3, h = (tid >> 2) & 15, hq = tid & 3;     \
                float s0 = 0.f, s1 = 0.f, s2 = 0.f, s3 = 0.f; \
                for (int p = 0; p < 64; ++p) { const float ar = apr[(d * 4 + jj) * 64 + p], ai = api[(d * 4 + jj) * 64 + p]; const float cr = Cr[(d * 16 + h) * 64 + p], ci = Ci[(d * 16 + h) * 64 + p]; \
                    const float wr_ = cr * ar - ci * ai, wi_ = cr * ai + ci * ar;              \
                    const f32x4 br = *(const LAS f32x4*)(bbr + (d * 64 + p) * 16 + 4 * hq), bi = *(const LAS f32x4*)(bbi + (d * 64 + p) * 16 + 4 * hq); \
                    s0 += wr_ * br[0] - wi_ * bi[0]; s1 += wr_ * br[1] - wi_ * bi[1]; s2 += wr_ * br[2] - wi_ * bi[2]; s3 += wr_ * br[3] - wi_ * bi[3]; } \
                float* kd = (float*)(ws + WS_KD) + ((((size_t)g * 2 + d) * 16 + (4 * lq + jj)) * 16 + h) * 16 + 4 * hq; \
                *(f32x4*)kd = (f32x4){s0, s1, s2, s3}; } \
            __syncthreads(); } while (0)

    { PHASE_ENV();
        FRESH_IDS();
        for (int it = F.vcu; it < 128; it += F.G) ADALN_QITEM(it >> 2, it & 3);
        if (F.vcu == 128 % F.G) {
            for (int i = tid; i < 1024; i += 512) { const int pos = i >> 4, j = i & 15; const float inv = exp2f(-(float)j * (13.287712379549449f / 16.0f)); const float ang = (float)pos * inv;
                float sn, cs; sincos_acc((double)ang, sn, cs); rope[i] = cs; rope[1024 + i] = sn; }
            if (tid == 0) { float s1 = 0.f, s2 = 0.f;
                for (int i = 0; i < 64; ++i) { s1 += AIN(I_LQ1)[i] * AIN(I_LK1)[i]; s2 += AIN(I_LQ2)[i] * AIN(I_LK2)[i]; }
                lamp[0] = expf(s1) - expf(s2) + 0.2f; }
        }
        LAS float* scr = (LAS float*)(F.lds + 57344 + wave * 8448);
        constexpr int I_A = 16 * 48;
        for (int it = gw; it < I_A; it += NGW) p0_transpose_item(AIN(I_WIN), 1024, 3072, (bf16*)(ws + WS_WIN), 0, scr, it, lane);
    }
    GRID_BAR();

#define NORM_ROW_OF(q) ((q) < perl ? (((q) < nl_) ? gw * perl + (q) : -1) : ((((q) - perl) < nc_) ? ML + gw * perc + ((q) - perl) : -1))
#define NORM_TO_HB(LAYER, WHICH, NORMG_IDX, SRC_L, SRC_C, NROWS, SLABS, GATE, XCOUT, LATROWS) do { PHASE_ENV(); FRESH_IDS(); \
        const int latn_ = (LATROWS);        \
        const int perl = (latn_ + NGW - 1) / NGW, perc = ((NROWS) > ML) ? (MC + NGW - 1) / NGW : 0; \
        const int nl_ = (latn_ - gw * perl) < perl ? ((latn_ - gw * perl) > 0 ? (latn_ - gw * perl) : 0) : perl; \
        const int nc_ = perc ? ((MC - gw * perc) < perc ? ((MC - gw * perc) > 0 ? (MC - gw * perc) : 0) : perc) : 0; \
        int cur_r = -1; ModVec mv; const bf16* slabs_ = (SLABS); bf16* xcout_ = (XCOUT); \
        for (int q0 = 0; q0 < perl + perc; q0 += 3) { f32x4 v[3][4]; \
            _Pragma("unroll") for (int u = 0; u < 3; ++u) { const int row = (q0 + u < perl + perc) ? NORM_ROW_OF(q0 + u) : -1; if (row >= 0) { \
                if (row < ML) norm_load((SRC_L) + (size_t)row * 1024, lane, v[u]); \
                else if (slabs_) { norm_load_fix<4>((SRC_C) + (size_t)(row - ML) * 1024, slabs_ + (size_t)(row - ML) * 1024, (GATE), lane, v[u]); \
                    if (xcout_) { _Pragma("unroll") for (int j = 0; j < 4; ++j) { v2u w_; w_.x = pk2(v[u][j].x, v[u][j].y); w_.y = pk2(v[u][j].z, v[u][j].w); *(v2u*)(xcout_ + (size_t)(row - ML) * 1024 + 4 * lane + 256 * j) = w_; } } } \
                else norm_load((SRC_C) + (size_t)(row - ML) * 1024, lane, v[u]); } } \
            _Pragma("unroll") for (int u = 0; u < 3; ++u) { const int row = (q0 + u < perl + perc) ? NORM_ROW_OF(q0 + u) : -1; if (row >= 0) { const int r = row < ML ? (row >> 11) : 8; \
                if (r != cur_r) { if ((LAYER) == 0 && (WHICH) == 0) load_modvec4(mv, atab_[NORMG_IDX], (const float*)(ws + WS_MP) + r * 2048, lane); \
                    else load_modvec(mv, atab_[NORMG_IDX] + (LAYER) * 1024, mada + ((LAYER) * 9 + r) * 6144 + (WHICH) * 3072, lane); cur_r = r; } \
                f32x4 y[4]; norm_finish(v[u], mv, y); \
                GAS unsigned long long* o8 = (GAS unsigned long long*)(HB + (size_t)row * 1024) + lane; \
                _Pragma("unroll") for (int j = 0; j < 4; ++j) o8[64 * j] = (unsigned long long)pk2(y[j].x, y[j].y) | ((unsigned long long)pk2(y[j].z, y[j].w) << 32); } } } \
    } while (0)
    NORM_TO_HB(0, 0, I_N1G, x_in, ctx_in, MT, (const bf16*)nullptr, mada, (bf16*)nullptr, ML);
    GRID_BAR();

    { PHASE_ENV();
        pg8::Gemm g{HB, (const bf16*)(ws + WS_WIN), 1024, 1024, 1024}; pg8::StaticOrder S; S.init(MT, NPROJ, F.G, (int)blockIdx.x);
        LAS float* ropel = (LAS float*)(F.lds + 132096);
        for (int i = threadIdx.x; i < 2048; i += NWAVES * 64) ropel[i] = rope[i];
        __syncthreads();
        pg8::EpiInProj E{BIG, ropel};
        pg8::gemm_phase<pg8::EpiInProj, pg8::StaticOrder, true>(F.lds, g, S, E);
        const int nfull = (MT / 256) * (NPROJ / 256) - (((MT / 256) * (NPROJ / 256)) / F.G) * F.G;
        if ((int)blockIdx.x >= nfull) {
            FRESH_IDS();
            const int tb = (int)blockIdx.x - nfull, ntb = F.G - nfull;
            __syncthreads();
            for (int it = tb; it < 160; it += ntb) { const int l_ = it < 64 ? 0 : 1, cg_ = it < 64 ? 32 + it : it - 64; ADALN_ITEM(l_, cg_); }
            const int cw = tb * NWAVES + wave, ncw = ntb * NWAVES;
            LAS float* scr = (LAS float*)(F.lds + 57344 + wave * 8448);
            constexpr int I_B = 16 * 16, I_C1 = 16 * 64;
            constexpr int NITEMS = I_B + I_C1;
            for (int it = cw; it < NITEMS; it += ncw) {
                int r = it;
                if (r < I_B) { p0_transpose_item(AIN(I_WOUT), 1024, 1024, (bf16*)(ws + WS_WOUT), 0, scr, r, lane); continue; } r -= I_B;
                p0_transpose_item(AIN(I_W1) + (size_t)1024 * 4096, 1024, 4096, (bf16*)(ws + WS_W1_1), 0, scr, r, lane);
            }
        }
    }
    GRID_BAR();

#ifdef ATT_XM
    { PHASE_ENV();
        const float lam = lamp[0];
        const float* subg = AIN(I_SUBG); const float* rpb = AIN(I_RPB);
        const int v = F.vcu;
        att::lds_u8* shm = (att::lds_u8*)F.lds;
        const int nG = F.G;
#define ATT_FOR_UNITS(NUNITS, PERCU, IDEXPR) for (int k_ = 0; k_ < ((nG == 256) ? (PERCU) : ((NUNITS) + nG - 1) / nG); ++k_) { const int id = (nG == 256) ? (IDEXPR) : (k_ * nG + v); if (id < 0 || id >= (NUNITS)) continue;
        const int xq = v >> 5, iq = v & 31;
        const bool edge = ((iq & 7) == 0) || ((iq & 7) == 7); const int eidx = (iq >> 3) * 2 + ((iq & 7) == 7 ? 1 : 0), midx = (iq >> 3) * 6 + (iq & 7) - 1;
        ATT_FOR_UNITS(512, 2, ((xq * 4 + 2 * k_ + (iq >> 4)) * 16 + (iq & 15)))
            const int b = id >> 6, h = (id >> 4) & 3, qb = id & 15;
            att::UnitDesc U; U.qrow0 = b * 2048 + qb * 128; U.qcol = h * 128; U.kcol = 512 + h * 128; U.vcol = 1024 + h * 128;
            U.latrow = b * 2048; U.t0 = 0; U.nlat = 32; U.ctxrow = ML + b * 256; U.ocol = h * 128; U.r0 = 0; U.head = 0;
            att::attn_unit<true, false, ATT_XM>(U, BIG, HB, shm, rpb, subg, lam, 0.8f);
        }
        ATT_FOR_UNITS(512, 2, ((xq * 8 + 4 * k_ + (iq >> 3)) * 8 + (iq & 7)))
            const int b = id >> 6, h = (id >> 3) & 7, rq = id & 7;
            const int ra = 4 * rq, rb_ = 4 * rq + 3; const int rsa = ra < 4 ? 0 : (ra > 28 ? 24 : ra - 4), rsb = rb_ < 4 ? 0 : (rb_ > 28 ? 24 : rb_ - 4);
            att::UnitDesc U; U.qrow0 = b * 2048 + rq * 256; U.qcol = 1536 + h * 64; U.kcol = 2048 + h * 64; U.vcol = 2560 + h * 64;
            U.latrow = b * 2048; U.t0 = rsa; U.nlat = rsb + 7 - rsa + 1; U.ctxrow = ML + b * 256; U.ocol = 512 + h * 64; U.r0 = ra; U.head = h;
            att::attn_unit<false, true, ATT_XM>(U, BIG, HB, shm, rpb, subg, lam, 1.0f);
        }
        ATT_FOR_UNITS(64, 1, (edge ? xq * 8 + eidx : -1))
            const int b = id >> 3, h = (id >> 1) & 3, hf = id & 1;
            att::UnitDesc U; U.qrow0 = ML + b * 256 + hf * 128; U.qcol = h * 128; U.kcol = 512 + h * 128; U.vcol = 1024 + h * 128;
            U.latrow = 0; U.t0 = 0; U.nlat = 0; U.ctxrow = ML + b * 256; U.ocol = h * 128; U.r0 = 0; U.head = 0;
            att::attn_unit<true, false, ATT_XM>(U, BIG, HB, shm, rpb, subg, lam, 0.8f);
        }
        ATT_FOR_UNITS(64, 1, (edge ? xq * 8 + eidx : -1))
            const int b = id >> 3, h = id & 7;
            att::UnitDesc U; U.qrow0 = ML + b * 256; U.qcol = 1536 + h * 64; U.kcol = 2048 + h * 64; U.vcol = 2560 + h * 64;
            U.latrow = 0; U.t0 = 0; U.nlat = 0; U.ctxrow = ML + b * 256; U.ocol = 512 + h * 64; U.r0 = 0; U.head = 0;
            att::attn_unit<false, false, ATT_XM>(U, BIG, HB, shm, rpb, subg, lam, 1.0f);
        }
        {
            FRESH_IDS();
            const bool sel = (nG == 256) ? !edge : true;
            if (sel) { const int tb = (nG == 256) ? (xq * 24 + midx) : v, ntb = (nG == 256) ? 192 : nG;
                __syncthreads();
                LAS float* scr = (LAS float*)(F.lds + 57344 + wave * 8448);
                for (int it = tb * NWAVES + wave; it < 16 * 64; it += ntb * NWAVES) p0_transpose_item(AIN(I_W1), 1024, 4096, (bf16*)(ws + WS_W1_0), 0, scr, it, lane); }
        }
#undef ATT_FOR_UNITS
    }
    GRID_BAR();

#endif
    { PHASE_ENV();
        const float lam = lamp[0];
        const float* subg = AIN(I_SUBG); const float* rpb = AIN(I_RPB);
        const int v = F.vcu;
        att::lds_u8* shm = (att::lds_u8*)F.lds;
        const int nG = F.G;
#define ATT_FOR_UNITS(NUNITS, PERCU, IDEXPR) for (int k_ = 0; k_ < ((nG == 256) ? (PERCU) : ((NUNITS) + nG - 1) / nG); ++k_) { const int id = (nG == 256) ? (IDEXPR) : (k_ * nG + v); if (id < 0 || id >= (NUNITS)) continue;
        const int xq = v >> 5, iq = v & 31;
        const bool edge = ((iq & 7) == 0) || ((iq & 7) == 7); const int eidx = (iq >> 3) * 2 + ((iq & 7) == 7 ? 1 : 0), midx = (iq >> 3) * 6 + (iq & 7) - 1;
        ATT_FOR_UNITS(512, 2, ((xq * 4 + 2 * k_ + (iq >> 4)) * 16 + (iq & 15)))
            const int b = id >> 6, h = (id >> 4) & 3, qb = id & 15;
            att::UnitDesc U; U.qrow0 = b * 2048 + qb * 128; U.qcol = h * 128; U.kcol = 512 + h * 128; U.vcol = 1024 + h * 128;
            U.latrow = b * 2048; U.t0 = 0; U.nlat = 32; U.ctxrow = ML + b * 256; U.ocol = h * 128; U.r0 = 0; U.head = 0;
            att::attn_unit<true, false>(U, BIG, HB, shm, rpb, subg, lam, 0.8f);
        }
        ATT_FOR_UNITS(512, 2, ((xq * 8 + 4 * k_ + (iq >> 3)) * 8 + (iq & 7)))
            const int b = id >> 6, h = (id >> 3) & 7, rq = id & 7;
            const int ra = 4 * rq, rb_ = 4 * rq + 3; const int rsa = ra < 4 ? 0 : (ra > 28 ? 24 : ra - 4), rsb = rb_ < 4 ? 0 : (rb_ > 28 ? 24 : rb_ - 4);
            att::UnitDesc U; U.qrow0 = b * 2048 + rq * 256; U.qcol = 1536 + h * 64; U.kcol = 2048 + h * 64; U.vcol = 2560 + h * 64;
            U.latrow = b * 2048; U.t0 = rsa; U.nlat = rsb + 7 - rsa + 1; U.ctxrow = ML + b * 256; U.ocol = 512 + h * 64; U.r0 = ra; U.head = h;
            att::attn_unit<false, true>(U, BIG, HB, shm, rpb, subg, lam, 1.0f);
        }
        ATT_FOR_UNITS(64, 1, (edge ? xq * 8 + eidx : -1))
            const int b = id >> 3, h = (id >> 1) & 3, hf = id & 1;
            att::UnitDesc U; U.qrow0 = ML + b * 256 + hf * 128; U.qcol = h * 128; U.kcol = 512 + h * 128; U.vcol = 1024 + h * 128;
            U.latrow = 0; U.t0 = 0; U.nlat = 0; U.ctxrow = ML + b * 256; U.ocol = h * 128; U.r0 = 0; U.head = 0;
            att::attn_unit<true, false>(U, BIG, HB, shm, rpb, subg, lam, 0.8f);
        }
        ATT_FOR_UNITS(64, 1, (edge ? xq * 8 + eidx : -1))
            const int b = id >> 3, h = id & 7;
            att::UnitDesc U; U.qrow0 = ML + b * 256; U.qcol = 1536 + h * 64; U.kcol = 2048 + h * 64; U.vcol = 2560 + h * 64;
            U.latrow = 0; U.t0 = 0; U.nlat = 0; U.ctxrow = ML + b * 256; U.ocol = 512 + h * 64; U.r0 = 0; U.head = 0;
            att::attn_unit<false, false>(U, BIG, HB, shm, rpb, subg, lam, 1.0f);
        }
        {
            FRESH_IDS();
            const bool sel = (nG == 256) ? !edge : true;
            if (sel) { const int tb = (nG == 256) ? (xq * 24 + midx) : v, ntb = (nG == 256) ? 192 : nG;
                __syncthreads();
                LAS float* scr = (LAS float*)(F.lds + 57344 + wave * 8448);
                for (int it = tb * NWAVES + wave; it < 16 * 64; it += ntb * NWAVES) p0_transpose_item(AIN(I_W1), 1024, 4096, (bf16*)(ws + WS_W1_0), 0, scr, it, lane); }
        }
#undef ATT_FOR_UNITS
    }
    GRID_BAR();

    { PHASE_ENV();
        pg8::Gemm g{HB, (const bf16*)(ws + WS_WOUT), 1024, 1024, 1024}; pg8::SplitOrder S; S.init(F.G, (int)blockIdx.x, 1024, 2);
        if (F.G == 256) {
            { pg8::StaticOrder SL; SL.init(ML, DM, F.G, (int)blockIdx.x);
              pg8::EpiResidNorm E{x_in, xl, mada + 2048, HB, AIN(I_N2G), mada + 3072, (float*)(ws + WS_MP), (unsigned*)(ws + 2304), (LAS float*)(F.lds + 132096)};
              pg8::gemm_phase<pg8::EpiResidNorm, pg8::StaticOrder, true>(F.lds, g, SL, E); }
            { pg8::CtxSliceOrder SC{F.G, (int)blockIdx.x, 16, 2};
              pg8::EpiSlab E{(bf16*)BIG};
              pg8::gemm_phase<pg8::EpiSlab, pg8::CtxSliceOrder, true>(F.lds, g, SC, E); }
        } else {
            pg8::EpiResid<true> E{x_in, ctx_in, xl, xc, mada + 2048, (bf16*)BIG};
            pg8::gemm_phase<pg8::EpiResid<true>, pg8::SplitOrder, true>(F.lds, g, S, E);
        }
        const int nfull = 384 - (384 / F.G) * F.G;
        if ((int)blockIdx.x >= nfull) {
            FRESH_IDS();
            LAS float* scr = (LAS float*)(F.lds + 57344 + wave * 8448);
            constexpr int I_G = 16 * 16;
            for (int it = ((int)blockIdx.x - nfull) * NWAVES + wave; it < 2 * I_G; it += (F.G - nfull) * NWAVES) {
                const bool isb = it >= I_G; const int rr = isb ? it - I_G : it; const int n0 = 64 * (rr % 16); const int radd = 256 * (n0 / 128) + (n0 % 128) - n0 + (isb ? 128 : 0);
                p0_transpose_item(isb ? AIN(I_GLUB) : AIN(I_GLUA), 1024, 1024, (bf16*)(ws + WS_WGLU), radd, scr, rr, lane); }
        }
    }
    GRID_BAR();
    NORM_TO_HB(0, 1, I_N2G, xl, ctx_in, MT, (const bf16*)BIG, mada + 8 * 6144 + 2048, xc, (F.G == 256) ? 0 : ML);
    GRID_BAR();
    { PHASE_ENV();
        pg8::Gemm g{HB, (const bf16*)(ws + WS_W1_0), 1024, 1024, 1024}; pg8::StaticOrder S; S.init(MT, FF, F.G, (int)blockIdx.x);
        pg8::EpiRelu2<false> E{BIG, FF, nullptr, nullptr};
        pg8::gemm_phase<pg8::EpiRelu2<false>, pg8::StaticOrder, true>(F.lds, g, S, E);
        const int nfull = (MT / 256) * (FF / 256) - (((MT / 256) * (FF / 256)) / F.G) * F.G;
        if ((int)blockIdx.x >= nfull) {
            FRESH_IDS();
            const int tb = (int)blockIdx.x - nfull, ntb = F.G - nfull;
            __syncthreads();
            for (int it = tb; it < 256; it += ntb) KD_ITEM(it >> 2, it & 3);
            const int cw = tb * NWAVES + wave, ncw = ntb * NWAVES;
            LAS float* scr = (LAS float*)(F.lds + 57344 + wave * 8448);
            for (int it = cw; it < 64 * 16; it += ncw) p0_transpose_item(AIN(I_W2), 4096, 1024, (bf16*)(ws + WS_W2_0), 0, scr, it, lane);
        }
    }
    GRID_BAR();
    { PHASE_ENV();
        pg8::Gemm g{BIG, (const bf16*)(ws + WS_W2_0), FF, FF, FF}; pg8::SplitOrder S; S.init(F.G, (int)blockIdx.x, FF, 3);
        if (F.G == 256) {
            { pg8::StaticOrder SL; SL.init(ML, DM, F.G, (int)blockIdx.x, FF);
              pg8::EpiResidNormA E{xl, xl, mada + 5120, (bf16*)(ws + WS_HB), AIN(I_N1G) + 1024, mada + 9 * 6144, (float*)(ws + WS_MP), (unsigned*)(ws + 2560), (LAS float*)(F.lds + 132096)};
              pg8::gemm_phase<pg8::EpiResidNormA, pg8::StaticOrder, true>(F.lds, g, SL, E); }
            { pg8::CtxSliceOrder SC{F.G, (int)blockIdx.x, 64, 3};
              pg8::EpiSlab E{SLAB7};
              pg8::gemm_phase<pg8::EpiSlab, pg8::CtxSliceOrder, true>(F.lds, g, SC, E); }
        } else {
            pg8::EpiResid<false> E{xl, xc, xl, xc, mada + 5120, SLAB7};
            pg8::gemm_phase<pg8::EpiResid<false>, pg8::SplitOrder, true>(F.lds, g, S, E);
        }
    }
    GRID_BAR();

#define AUL HB
#define AUC ((bf16*)(ws + 230 * MiB))
#define ACR ((bf16*)(ws + WS_BIG + 32 * MiB))
#define ZB BIG
#define X3A ((bf16*)(ws + 2 * MiB))
#define X3B ((bf16*)(ws + 242 * MiB) - (size_t)12288 * 1024)
#define SEND ((bf16*)(ws + WS_SEND))
    { PHASE_ENV();
        FRESH_IDS();
        v2u rawn[2][4], rawm[2][4];
#define P8_ROW0(ci_) (((ci_) >> 7) * 2048 + ((ci_) & 127) * 16)
        const int ci0 = (F.G == 256) ? 1024 + F.vcu : F.vcu;
        if (ci0 < 1024) {
#pragma unroll
            for (int u = 0; u < 2; ++u)
#pragma unroll
                for (int j = 0; j < 4; ++j) rawn[u][j] = *(const v2u*)(xl + (size_t)(P8_ROW0(ci0) + 2 * wave + u) * 1024 + 4 * lane + 256 * j); }
        if (ci0 + F.G < 1024) {
#pragma unroll
            for (int u = 0; u < 2; ++u)
#pragma unroll
                for (int j = 0; j < 4; ++j) rawm[u][j] = *(const v2u*)(xl + (size_t)(P8_ROW0(ci0 + F.G) + 2 * wave + u) * 1024 + 4 * lane + 256 * j); }
        {
            const int g = F.vcu >> 2, q = F.vcu & 3;
            LAS float* apr = (LAS float*)F.lds;
            LAS float* api = apr + 2 * 17 * 64;
            LAS float* bbr = api + 2 * 17 * 64;
            LAS float* bbi = bbr + 2 * 64 * 16;
            LAS float* Cr = bbi + 2 * 64 * 16;
            LAS float* Ci = Cr + 2 * 16 * 64;
            { const int d = tid >> 8, jq = (tid >> 6) & 3, p = tid & 63; const int gp = (d * 64 + g) * 64 + p;
                const float lr = AIN(I_SLRE)[gp], li = AIN(I_SLIM)[gp]; const float delta = expf(AIN(I_SLOG)[d * 64 + g]);
                const f32x4 br4 = *(const f32x4*)(AIN(I_SBRE) + (size_t)gp * 16 + 4 * jq), bi4 = *(const f32x4*)(AIN(I_SBIM) + (size_t)gp * 16 + 4 * jq);
#pragma unroll
                for (int jj = 0; jj < 5; ++jj) { const int j = jq + 4 * jj; if (j <= 16) { const float mag = expf(lr * delta * (float)j); float sn, cs; sincos_acc((double)li * (double)delta * (double)j, sn, cs);
                    apr[(d * 17 + j) * 64 + p] = mag * cs; api[(d * 17 + j) * 64 + p] = mag * sn; } }
                float sn1, cs1; sincos_acc((double)li * (double)delta, sn1, cs1); const float mag1 = expf(lr * delta);
                const float ar = mag1 * cs1, ai = mag1 * sn1;
                const float den = lr * lr + li * li, nr = ar - 1.0f; const float cr = (nr * lr + ai * li) / den, ci = (ai * lr - nr * li) / den;
                f32x4 or_, oi_;
#pragma unroll
                for (int e = 0; e < 4; ++e) { or_[e] = cr * br4[e] - ci * bi4[e]; oi_[e] = cr * bi4[e] + ci * br4[e]; }
                *(LAS f32x4*)(bbr + (d * 64 + p) * 16 + 4 * jq) = or_; *(LAS f32x4*)(bbi + (d * 64 + p) * 16 + 4 * jq) = oi_; }
            for (int i = tid; i < 2048; i += 512) { const int d = i >> 10, h = (i >> 6) & 15, p = i & 63;
                Cr[i] = AIN(I_SCRE)[((size_t)(d * 64 + g) * 16 + h) * 64 + p]; Ci[i] = AIN(I_SCIM)[((size_t)(d * 64 + g) * 16 + h) * 64 + p]; }
            __syncthreads();
            LAS float* Kd = Ci + 2 * 16 * 64;
            { const float* Kg = (const float*)(ws + WS_KD) + (size_t)g * 2 * 16 * 256;
#pragma unroll
              for (int i = 0; i < 4; ++i) *(LAS f32x4*)(Kd + (tid + 512 * i) * 4) = *(const f32x4*)(Kg + (tid + 512 * i) * 4); }
            __syncthreads();
            bf16* B2 = (bf16*)(ws + WS_SSM_B2) + (size_t)g * 256 * 512;
            for (int i = tid; i < 64 * 64; i += 512) { const int row = 64 * q + (i >> 6), c8 = (i & 63) * 8; const int t = row >> 4, h = row & 15;
                f32x4 v0, v1;
                if (c8 < 256) { const int k = c8 >> 4, hp0 = c8 & 15; v0 = (f32x4){0.f, 0.f, 0.f, 0.f}; v1 = v0;
                    if (k <= t) { const LAS float* kp = Kd + ((0 * 16 + (t - k)) * 16 + h) * 16 + hp0; v0 += *(const LAS f32x4*)kp; v1 += *(const LAS f32x4*)(kp + 4); }
                    if (k >= t) { const LAS float* kp = Kd + ((1 * 16 + (k - t)) * 16 + h) * 16 + hp0; v0 += *(const LAS f32x4*)kp; v1 += *(const LAS f32x4*)(kp + 4); }
                    if (k == t && (h >> 3) == (hp0 >> 3)) { const float dsk = AIN(I_SD)[g * 16 + h];
#pragma unroll
                        for (int e = 0; e < 4; ++e) { if ((h & 7) == e) v0[e] += dsk; if ((h & 7) == 4 + e) v1[e] += dsk; } } }
                else { const int qq = c8 - 256; const int d = qq >> 7, im = (qq >> 6) & 1, p0 = qq & 63; const int j = d == 0 ? t + 1 : 16 - t;
                    const LAS float* ap = apr + (d * 17 + j) * 64 + p0; const LAS float* aq = api + (d * 17 + j) * 64 + p0; const LAS float* cp_ = Cr + (d * 16 + h) * 64 + p0; const LAS float* cq = Ci + (d * 16 + h) * 64 + p0;
                    const f32x4 ar0 = *(const LAS f32x4*)ap, ar1 = *(const LAS f32x4*)(ap + 4), ai0 = *(const LAS f32x4*)aq, ai1 = *(const LAS f32x4*)(aq + 4);
                    const f32x4 cr0 = *(const LAS f32x4*)cp_, cr1 = *(const LAS f32x4*)(cp_ + 4), ci0 = *(const LAS f32x4*)cq, ci1 = *(const LAS f32x4*)(cq + 4);
                    if (im) { v0 = -(cr0 * ai0 + ci0 * ar0); v1 = -(cr1 * ai1 + ci1 * ar1); } else { v0 = cr0 * ar0 - ci0 * ai0; v1 = cr1 * ar1 - ci1 * ai1; } }
                v4u w; w.x = pk2(v0[0], v0[1]); w.y = pk2(v0[2], v0[3]); w.z = pk2(v1[0], v1[1]); w.w = pk2(v1[2], v1[3]);
                *(v4u*)(B2 + (size_t)row * 512 + c8) = w; }
            bf16* WE = (bf16*)(ws + WS_SSM_WEND) + (size_t)g * 256 * 256;
            for (int i = tid; i < 64 * 32; i += 512) { const int n = 64 * q + (i >> 5), c8 = (i & 31) * 8; const int d = n >> 7, im = (n >> 6) & 1, p = n & 63;
                const int k = c8 >> 4, hp0 = c8 & 15; const int j = d == 0 ? 15 - k : k;
                const float ar = apr[(d * 17 + j) * 64 + p], ai = api[(d * 17 + j) * 64 + p];
                const LAS float* bp = bbr + (d * 64 + p) * 16 + hp0; const LAS float* bq = bbi + (d * 64 + p) * 16 + hp0;
                const f32x4 br0 = *(const LAS f32x4*)bp, br1 = *(const LAS f32x4*)(bp + 4), bi0 = *(const LAS f32x4*)bq, bi1 = *(const LAS f32x4*)(bq + 4);
                f32x4 v0, v1;
                if (im) { v0 = ar * bi0 + ai * br0; v1 = ar * bi1 + ai * br1; } else { v0 = ar * br0 - ai * bi0; v1 = ar * br1 - ai * bi1; }
                v4u w; w.x = pk2(v0[0], v0[1]); w.y = pk2(v0[2], v0[3]); w.z = pk2(v1[0], v1[1]); w.w = pk2(v1[2], v1[3]);
                *(v4u*)(WE + (size_t)n * 256 + c8) = w; }
            __syncthreads();
        }
        {
            __syncthreads();
            int cur_r = -1; ModVec mv; int it = 0;
            for (int ci = ci0; ci < 1152; ci += F.G, ++it) {
                LAS unsigned char* T = F.lds + (it & 1) * 32768;
                const bool lat = ci < 1024; const int r = lat ? (ci >> 7) : 8;
                if (r != cur_r) { load_modvec(mv, AIN(I_N1G) + 1024, mada + (9 + r) * 6144, lane); cur_r = r; }
                f32x4 v[2][4];
                if (lat) {
#pragma unroll
                    for (int u = 0; u < 2; ++u)
#pragma unroll
                        for (int j = 0; j < 4; ++j) { v[u][j] = bf4_to_f32(rawn[u][j]); rawn[u][j] = rawm[u][j]; }
                    const int cn = ci + 2 * F.G;
                    if (cn < 1024) {
#pragma unroll
                        for (int u = 0; u < 2; ++u)
#pragma unroll
                            for (int j = 0; j < 4; ++j) rawm[u][j] = *(const v2u*)(xl + (size_t)(P8_ROW0(cn) + 2 * wave + u) * 1024 + 4 * lane + 256 * j); }
                } else {
                    const int row0 = (ci - 1024) * 16;
#pragma unroll
                    for (int u = 0; u < 2; ++u) norm_load_fix<8>(xc + (size_t)(row0 + 2 * wave + u) * 1024, (const bf16*)SLAB7 + (size_t)(row0 + 2 * wave + u) * 1024, mada + 8 * 6144 + 5120, lane, v[u]);
                }
#pragma unroll
                for (int u = 0; u < 2; ++u) { const int k = 2 * wave + u; f32x4 y[4]; norm_finish(v[u], mv, y);
#pragma unroll
                    for (int j = 0; j < 4; ++j) *(LAS unsigned long long*)(T + k * 2048 + (4 * lane + 256 * j) * 2) = (unsigned long long)pk2(y[j].x, y[j].y) | ((unsigned long long)pk2(y[j].z, y[j].w) << 32); }
                asm volatile("s_waitcnt lgkmcnt(0)\n\ts_barrier" ::: "memory");
                { const int g = tid >> 3;
#pragma unroll
                  for (int i = 0; i < 4; ++i) { const int piece = (tid & 7) + 8 * i; const int k = piece >> 1, hf = piece & 1;
                      const v4u w = *(const LAS v4u*)(T + k * 2048 + (g * 16 + hf * 8) * 2);
                      bf16* dst = lat ? AUL + ((size_t)(g * 1024 + ci)) * 256 : AUC + ((size_t)(g * 256 + (ci - 1024))) * 256;
                      *(GAS v4u*)(dst + k * 16 + hf * 8) = w; } }
            }
            __syncthreads();
#undef P8_ROW0
        }
    }
    GRID_BAR();
    { PHASE_ENV();
        pg8::Gemm g{AUL, (const bf16*)(ws + WS_SSM_WEND), 256, 256, 256}; pg8::SsmOrder S{F.G, (int)blockIdx.x, 5, 4};
        pg8::EpiSsm1 E{SEND};
        pg8::gemm_phase<pg8::EpiSsm1, pg8::SsmOrder, true>(F.lds, g, S, E);
        FRESH_IDS();
        {
            const int nfull = 320 - (320 / F.G) * F.G;
            if ((int)blockIdx.x >= nfull) {
                const int cw = ((int)blockIdx.x - nfull) * NWAVES + wave, ncw = (F.G - nfull) * NWAVES;
                LAS float* scr = (LAS float*)(F.lds + 57344 + wave * 8448);
                for (int it = cw; it < 64 * 16; it += ncw) p0_transpose_item(AIN(I_W2) + (size_t)4096 * 1024, 4096, 1024, (bf16*)(ws + WS_W2_1), 0, scr, it, lane);
            }
        }
        {
            const int nbn = (4096 + F.G - 1) / F.G, nb0 = (int)blockIdx.x * nbn;
            const bf16* W1T = (const bf16*)(ws + WS_W1_1); float* b2 = (float*)(ws + WS_BIAS2);
            for (int n = nb0 + wave; n < nb0 + nbn && n < 4096; n += NWAVES) {
                const v4u w0 = *(const v4u*)(W1T + (size_t)n * 1024 + lane * 16), w1 = *(const v4u*)(W1T + (size_t)n * 1024 + lane * 16 + 8);
                float wv[16]; wv[0] = __uint_as_float(w0.x << 16); wv[1] = __uint_as_float(w0.x & 0xffff0000u); wv[2] = __uint_as_float(w0.y << 16); wv[3] = __uint_as_float(w0.y & 0xffff0000u);
                wv[4] = __uint_as_float(w0.z << 16); wv[5] = __uint_as_float(w0.z & 0xffff0000u); wv[6] = __uint_as_float(w0.w << 16); wv[7] = __uint_as_float(w0.w & 0xffff0000u);
                wv[8] = __uint_as_float(w1.x << 16); wv[9] = __uint_as_float(w1.x & 0xffff0000u); wv[10] = __uint_as_float(w1.y << 16); wv[11] = __uint_as_float(w1.y & 0xffff0000u);
                wv[12] = __uint_as_float(w1.z << 16); wv[13] = __uint_as_float(w1.z & 0xffff0000u); wv[14] = __uint_as_float(w1.w << 16); wv[15] = __uint_as_float(w1.w & 0xffff0000u);
#pragma unroll
                for (int b = 0; b < 8; ++b) { const float* sh = mada + (9 + b) * 6144 + 3072 + lane * 16; float s = 0.f;
#pragma unroll
                    for (int q4 = 0; q4 < 4; ++q4) { const f32x4 sv = *(const f32x4*)(sh + 4 * q4); s += sv[0] * wv[4 * q4] + sv[1] * wv[4 * q4 + 1] + sv[2] * wv[4 * q4 + 2] + sv[3] * wv[4 * q4 + 3]; }
                    s = wave_sum(s);
                    if (lane == 0) b2[b * 4096 + n] = s; }
            }
        }
    }
    GRID_BAR();
    { PHASE_ENV();
        pg8::SsmOrder S{F.G, (int)blockIdx.x, 4, 8};
        {
            pg8::Gemm g0{AUL, (const bf16*)(ws + WS_SSM_B2), 256, 512, 512, (long)((WS_BIG + 32 * MiB) - WS_HB) - 4 * 128};
            pg8::EpiSsm2 E0{ZB, (const bf16*)nullptr, AIN(I_SD)};
            pg8::gemm_phase<pg8::EpiSsm2, pg8::SsmOrder, true, 4, 1>(F.lds, g0, S, E0); }
        {
            FRESH_IDS(); pg8::Unit su;
            for (int ui_ = 0; S.next(ui_, su); ++ui_) {
        if (tid < 256) {
            const int p = tid & 63, d = (tid >> 6) & 1, b = 2 * (su.pm - 5 * su.pn) + (tid >> 7), g = su.pn;
            const int gp = (d * 64 + g) * 64 + p;
            const float lr = AIN(I_SLRE)[gp], li = AIN(I_SLIM)[gp]; const float delta = expf(AIN(I_SLOG)[d * 64 + g]);
            const float mag = expf(lr * delta * 16.0f); float sn, cs; sincos_acc((double)li * (double)delta * 16.0, sn, cs);
            const float aTr = mag * cs, aTi = mag * sn;
            const bf16* Sg = SEND + (size_t)g * 1152 * 256 + d * 128 + p;
            bf16* Ag = ACR + (size_t)g * 1024 * 256 + d * 128 + p;
            float cr = 0.f, ci = 0.f;
            for (int s0 = 0; s0 < 144; s0 += 24) {
                float sr[24], si[24];
#pragma unroll
                for (int q = 0; q < 24; ++q) { const int s = s0 + q; const int ridx = (s < 16) ? (1024 + b * 16 + (d == 0 ? s : 15 - s)) : (b * 128 + (d == 0 ? s - 16 : 143 - s));
                    sr[q] = __uint_as_float((unsigned)Sg[(size_t)ridx * 256] << 16); si[q] = __uint_as_float((unsigned)Sg[(size_t)ridx * 256 + 64] << 16); }
#pragma unroll
                for (int q = 0; q < 24; ++q) { const int s = s0 + q;
                    if (s >= 16) { const int ridx = b * 128 + (d == 0 ? s - 16 : 143 - s); Ag[(size_t)ridx * 256] = (bf16)f2bf(cr); Ag[(size_t)ridx * 256 + 64] = (bf16)f2bf(ci); }
                    const float nr = aTr * cr - aTi * ci + sr[q], ni = aTr * ci + aTi * cr + si[q]; cr = nr; ci = ni; }
            }
        }
            }
            asm volatile("s_waitcnt vmcnt(0)" ::: "memory"); __syncthreads();
        }

        pg8::Gemm g{AUL, (const bf16*)(ws + WS_SSM_B2), 256, 512, 512, (long)((WS_BIG + 32 * MiB) - WS_HB) - 4 * 128};
        pg8::EpiSsm2 E{ZB, (const bf16*)nullptr, AIN(I_SD)};
        pg8::gemm_phase<pg8::EpiSsm2, pg8::SsmOrder, true, 4, 2>(F.lds, g, S, E);

    }
    GRID_BAR();
    { PHASE_ENV();
        pg8::Gemm g{ZB, (const bf16*)(ws + WS_WGLU), 1024, 1024, 1024}; pg8::StaticOrder S; S.init(ML, 2048, F.G, (int)blockIdx.x);
        pg8::EpiGlu E{xl, (F.G == 256) ? X3A : xl, (F.G == 256) ? X3B : xl, mada + 9 * 6144 + 2048, (bf16*)(ws + WS_H2B), AIN(I_N2G) + 1024, mada + 9 * 6144 + 4096, (float*)(ws + WS_ROWSS1)};
        pg8::gemm_phase<pg8::EpiGlu, pg8::StaticOrder, true>(F.lds, g, S, E);
    }
    GRID_BAR();
    { PHASE_ENV();
        pg8::Gemm g{(const bf16*)(ws + WS_H2B), (const bf16*)(ws + WS_W1_1), 1024, 1024, 1024}; pg8::StaticOrder S; S.init(ML, FF, F.G, (int)blockIdx.x);
        pg8::EpiRelu2<true> E{BIG, FF, (const float*)(ws + WS_ROWSS1), (const float*)(ws + WS_BIAS2)};
        pg8::gemm_phase<pg8::EpiRelu2<true>, pg8::StaticOrder, true>(F.lds, g, S, E);
    }
    GRID_BAR();
    if (F.G == 256) {
        PHASE_ENV();
        pg8::Gemm g{BIG, (const bf16*)(ws + WS_W2_1), FF, FF, FF}; pg8::StaticOrder S; S.init(ML, DM, F.G, (int)blockIdx.x, FF);
        pg8::EpiResidFinal E{X3A, X3B, outf, mada + 9 * 6144 + 5120, AIN(I_FG), (float*)(ws + WS_MP), (unsigned*)(ws + 2048), (LAS float*)(F.lds + 132096)};
        pg8::gemm_phase<pg8::EpiResidFinal, pg8::StaticOrder, true>(F.lds, g, S, E);
    } else {
    { PHASE_ENV();
        pg8::Gemm g{BIG, (const bf16*)(ws + WS_W2_1), FF, FF, FF}; pg8::StaticOrder S; S.init(ML, DM, F.G, (int)blockIdx.x, FF);
        pg8::EpiResid<false> E{xl, xc, HB, xc, mada + 9 * 6144 + 5120, (bf16*)nullptr};
        pg8::gemm_phase<pg8::EpiResid<false>, pg8::StaticOrder, true>(F.lds, g, S, E);
    }
    GRID_BAR();
    { PHASE_ENV();
        FRESH_IDS();
        const float* fg = AIN(I_FG);
        f32x4 gv[4];
#pragma unroll
        for (int j = 0; j < 4; ++j) gv[j] = *(const f32x4*)(fg + 4 * lane + 256 * j);
        const int per16 = (ML + NGW - 1) / NGW; const int r16e = (gw + 1) * per16 < ML ? (gw + 1) * per16 : ML;
        for (int row0 = gw * per16; row0 < r16e; row0 += 4) {
            f32x4 v[4][4];
#pragma unroll
            for (int u = 0; u < 4; ++u) if (row0 + u < r16e) norm_load(HB + (size_t)(row0 + u) * 1024, lane, v[u]);
#pragma unroll
            for (int u = 0; u < 4; ++u) { if (row0 + u >= r16e) continue; float s = 0.f;
#pragma unroll
                for (int j = 0; j < 4; ++j) s += (v[u][j].x * v[u][j].x + v[u][j].y * v[u][j].y) + (v[u][j].z * v[u][j].z + v[u][j].w * v[u][j].w);
                const float rstd = 1.0f / sqrtf(wave_sum(s) * (1.0f / 1024.0f) + NORM_EPS);
                f32x4* xr = (f32x4*)(outf + (size_t)(row0 + u) * 1024) + lane;
#pragma unroll
                for (int j = 0; j < 4; ++j) xr[64 * j] = v[u][j] * rstd * gv[j]; }
        }
    }
    }
#ifdef PROBE_TS
    GRID_BAR();
    if (blockIdx.x == 0) {
        asm volatile("s_waitcnt vmcnt(0)" ::: "memory"); __syncthreads();
#ifndef PROBE_SPAN
#define PROBE_SPAN 1
#endif
#ifndef PROBE_Q
#define PROBE_Q 1.0f
#endif
        const float ta = PROBE_Q * floorf((float)(tsbuf[PROBE_A + 1] - tsbuf[PROBE_A]) * 0.01f / PROBE_Q + 0.5f);
        const float tb = PROBE_Q * floorf((float)(tsbuf[PROBE_B + PROBE_SPAN] - tsbuf[PROBE_B]) * 0.01f / PROBE_Q + 0.5f);
        if (threadIdx.x == 0) args.out[7] += ta * 0.005f;
        for (int i = threadIdx.x; i < 67080; i += 512) args.out[4096 + i] += tb * 0.005f;
    }
#endif
#undef GRID_BAR
#undef FRESH_IDS
#undef AUL
#undef AUC
#undef ACR
#undef ZB
#undef SLAB7
#undef SEND
#undef PHASE_ENV
#undef AIN
#undef NORM_TO_HB
#undef NORM_ROW_OF
}

extern "C" void kernel_launch(void* const* d_in, const int* in_sizes, int n_in, void* d_out, int out_size, void* d_ws, size_t ws_size, hipStream_t stream) {
    static int grid = 0;
    if (grid == 0) {
        if (n_in != 29 || out_size != ML * DM || ws_size < WS_END) { fprintf(stderr, "kernel_launch: unexpected shapes (n_in %d out %d ws %zu)\n", n_in, out_size, ws_size); grid = -1; return; }
        int dev = 0, cus = 0;
        if (hipGetDevice(&dev) != hipSuccess || hipDeviceGetAttribute(&cus, hipDeviceAttributeMultiprocessorCount, dev) != hipSuccess) { grid = -1; return; }
        if (hipFuncSetAttribute((const void*)fwd_kernel, hipFuncAttributeMaxDynamicSharedMemorySize, LDS_BYTES) != hipSuccess) { fprintf(stderr, "kernel_launch: hipFuncSetAttribute failed\n"); grid = -1; return; }
        int per_cu = 0;
        if (hipOccupancyMaxActiveBlocksPerMultiprocessor(&per_cu, (const void*)fwd_kernel, NWAVES * 64, LDS_BYTES) != hipSuccess || per_cu < 1) fprintf(stderr, "kernel_launch: occupancy query says %d\n", per_cu);
        (void)hipGetLastError();
        grid = cus;
    }
    if (grid < 0) return;
    (void)hipMemsetAsync((char*)d_ws + WS_CTL, 0, CTL_ZERO_BYTES, stream);
    Args a{};
    for (int i = 0; i < 29; ++i) a.in[i] = (const float*)d_in[i];
    a.out = (float*)d_out; a.ws = (unsigned char*)d_ws;
    hipLaunchKernelGGL(fwd_kernel, dim3(grid), dim3(NWAVES * 64), LDS_BYTES, stream, a);
}
```

```cpp
#include <hip/hip_runtime.h>
#include <hip/hip_bf16.h>
#include <cstdio>
#include <cstdint>
#include <cmath>
namespace pg8 {
#define PG8_LAS __attribute__((address_space(3)))
typedef unsigned short bf16_t;
typedef short bf16x8 __attribute__((ext_vector_type(8)));
typedef float f32x4 __attribute__((ext_vector_type(4)));
typedef float f32x2 __attribute__((ext_vector_type(2)));
typedef unsigned u32x4 __attribute__((ext_vector_type(4)));
typedef unsigned u32x2 __attribute__((ext_vector_type(2)));
constexpr int BM = 256, BK = 64, HALF = 128, HTB = HALF * BK * 2, STAGE_BYTES = 8 * HTB, NXCD = 8, WGM = 8;

__host__ __device__ __forceinline__ int lds_byte(int r, int c) { const int st = (r >> 4) * 2 + (c >> 5), rr = r & 15, cc = c & 31, ob = rr * 64 + cc * 2; return st * 1024 + (ob ^ (((ob >> 9) & 1) << 5)); }
__host__ __device__ __forceinline__ void stage_rc(int b, int& R, int& C) { const int st = b / 1024, sb = b % 1024, swz = sb ^ (((sb >> 9) & 1) << 5); R = (st >> 1) * 16 + swz / 64; C = (st & 1) * 32 + (swz % 64) / 2; }
__host__ __device__ __forceinline__ int perm32(int rho) { const int n = rho >> 4, i = rho & 15; return 8 * (i >> 2) + 4 * n + (i & 3); }

constexpr int ACTX_TILE0 = 1472;
struct Unit { int pm, pn, kt0, nt, slab; };
struct Gemm { const bf16_t* A; const bf16_t* Bt; int lda, ldb, K; long ajump = 0; };

struct StaticOrder {
    int nM, nN, nwg, G, c, ntk;
    __host__ __device__ __forceinline__ int atile(const Unit& u) const { return u.pm; }
    __host__ __device__ __forceinline__ void init(int M, int N, int G_, int c_, int K_ = 1024) { nM = M / BM; nN = N / BM; nwg = nM * nN; G = G_; c = c_; ntk = K_ / BK; }
    __host__ __device__ __forceinline__ bool next(int i, Unit& u) const {
        const long L = (long)i * G + c; if (L >= nwg) return false;
        int wgid = (int)L; { const int q = nwg / NXCD, r = nwg % NXCD, xcd = wgid % NXCD, off = wgid / NXCD; wgid = (xcd < r ? xcd * (q + 1) : r * (q + 1) + (xcd - r) * q) + off; }
        const int nig = WGM * nN, gid = wgid / nig, fm = gid * WGM, gsz = (nM - fm) < WGM ? (nM - fm) : WGM;
        u.pm = fm + ((wgid % nig) % gsz); u.pn = (wgid % nig) / gsz; u.kt0 = 0; u.nt = ntk; u.slab = -1; return true;
    }
};
struct SplitOrder {
    int G, c, ntk, lsp;
    __device__ __forceinline__ int atile(const Unit& u) const { return u.pm; }
    __device__ __forceinline__ void init(int G_, int c_, int K_, int lsp_) { G = G_; c = c_; ntk = K_ / BK; lsp = lsp_; }
    __device__ __forceinline__ bool next(int i, Unit& u) const {
        const int L = i * G + c;
        if (L >= 256 + (32 << lsp)) return false;
        const bool lat = L < 256;
        const int wl = (L & 7) * 32 + (L >> 3); const int gid = wl >> 5, wi = wl & 31;
        const int j = L - 256;
        const int pm = lat ? gid * 8 + (wi & 7) : 64 + (j >> (lsp + 2));
        const int pn = lat ? (wi >> 3) : ((j >> lsp) & 3);
        const int sl = lat ? -1 : (j & ((1 << lsp) - 1));
        const int nt = lat ? ntk : (ntk >> lsp);
        u.pm = pm; u.pn = pn; u.slab = sl; u.nt = nt; u.kt0 = lat ? 0 : sl * nt;
        return true;
    }
};
struct CtxSliceOrder {
    int G, c, ntk, lsp;
    __device__ __forceinline__ int atile(const Unit& u) const { return u.pm; }
    __device__ __forceinline__ bool next(int i, Unit& u) const {
        const int j = i * G + c;
        if (j >= (32 << lsp)) return false;
        const int sl = j & ((1 << lsp) - 1), nt = ntk >> lsp;
        u.pm = 64 + (j >> (lsp + 2)); u.pn = (j >> lsp) & 3; u.slab = sl; u.nt = nt; u.kt0 = sl * nt;
        return true;
    }
};
struct SsmOrder {
    int G, c, nrow, ntk;
    __device__ __forceinline__ int atile(const Unit& u) const { const int i = u.pm - 5 * u.pn; return i < 4 ? u.pn * 4 + i : ACTX_TILE0 + u.pn; }
    __device__ __forceinline__ bool next(int i, Unit& u) const {
        const int L = i * G + c; if (L >= 64 * nrow) return false;
        if (nrow == 4 && G == 256) {
            const int x = c & 7, s = c >> 3, q = x * 8 + (s >> 2), e = s & 3; const int g = 4 * (q & 15) + e, it = q >> 4;
            u.pm = g * 5 + it; u.pn = g; u.kt0 = 0; u.nt = ntk; u.slab = -1; return true; }
        const int g = L / nrow; u.pm = g * 5 + (L - g * nrow); u.pn = g; u.kt0 = 0; u.nt = ntk; u.slab = -1; return true;
    }
};

__device__ __forceinline__ unsigned cvt_pk_bf16(float lo, float hi) { unsigned r; asm volatile("v_cvt_pk_bf16_f32 %0, %1, %2" : "=v"(r) : "v"(lo), "v"(hi)); return r; }
__device__ __forceinline__ float bf16lo(unsigned w) { return __uint_as_float(w << 16); }
__device__ __forceinline__ float bf16hi(unsigned w) { return __uint_as_float(w & 0xffff0000u); }

constexpr float QSCALE = 0.125f * 1.4426950408889634f;


struct EpiInProj {
    static constexpr bool PERM = true;
    bf16_t* O; const PG8_LAS float* rope;
    __device__ __forceinline__ void operator()(const f32x4 (&acc)[2][2][4][2], const Unit& u, int wr, int wc, int fr, int fq) const {
        asm volatile("" : "+v"(fr), "+v"(fq));
        const int pn = u.pn; const bool dorope = (u.pm < 64) && (pn < 4);
        const float sc = (pn < 2 || pn == 6 || pn == 7) ? QSCALE : 1.0f;
        const int row0 = u.pm * BM + wr * 64 + fr, col0 = pn * BM + wc * 32 + 8 * fq;
        const float sgn = (fq < 2) ? -1.0f : 1.0f; const int j0 = 8 * (fq & 1);
#pragma unroll
        for (int ai = 0; ai < 2; ++ai)
#pragma unroll
            for (int m = 0; m < 4; ++m) {
                const int row = row0 + ai * HALF + m * 16;
                f32x4 cs0 = (f32x4){1.f, 1.f, 1.f, 1.f}, cs1 = cs0, sn0 = (f32x4){0.f, 0.f, 0.f, 0.f}, sn1 = sn0;
                if (dorope) { const int t = row & 2047; const int pos = (wc & 1) ? (t & 63) : (t >> 6); const PG8_LAS float* rp = rope + pos * 16 + j0;
                    cs0 = *(const PG8_LAS f32x4*)rp; cs1 = *(const PG8_LAS f32x4*)(rp + 4); sn0 = *(const PG8_LAS f32x4*)(rp + 1024) * sgn; sn1 = *(const PG8_LAS f32x4*)(rp + 1028) * sgn; }
                bf16_t* rowp = O + (size_t)row * 3072 + col0;
#pragma unroll
                for (int bj = 0; bj < 2; ++bj) {
                    f32x4 x0 = acc[ai][bj][m][0], x1 = acc[ai][bj][m][1], y0 = x0, y1 = x1;
                    if (dorope) {
#pragma unroll
                        for (int e2 = 0; e2 < 4; ++e2) {
                            const auto ra = __builtin_amdgcn_permlane32_swap(__float_as_uint(x0[e2]), __float_as_uint(x0[e2]), false, false);
                            const auto rb = __builtin_amdgcn_permlane32_swap(__float_as_uint(x1[e2]), __float_as_uint(x1[e2]), false, false);
                            const float p0 = (fq < 2) ? __uint_as_float(ra[1]) : __uint_as_float(ra[0]);
                            const float p1 = (fq < 2) ? __uint_as_float(rb[1]) : __uint_as_float(rb[0]);
                            y0[e2] = x0[e2] * cs0[e2] + p0 * sn0[e2]; y1[e2] = x1[e2] * cs1[e2] + p1 * sn1[e2]; } }
                    y0 = y0 * sc; y1 = y1 * sc;
                    u32x4 w; w.x = cvt_pk_bf16(y0[0], y0[1]); w.y = cvt_pk_bf16(y0[2], y0[3]); w.z = cvt_pk_bf16(y1[0], y1[1]); w.w = cvt_pk_bf16(y1[2], y1[3]);
                    *(u32x4*)(rowp + bj * HALF) = w;
                }
            }
    }
};

template <bool BASEF32>
struct EpiResid {
    static constexpr bool PERM = true;
    const void* base_l; const void* base_c; bf16_t* out_l; bf16_t* out_c; const float* gate; bf16_t* slabs;
    __device__ __forceinline__ void operator()(const f32x4 (&acc)[2][2][4][2], const Unit& u, int wr, int wc, int fr, int fq) const {
        asm volatile("" : "+v"(fr), "+v"(fq));
        const bool lat = u.pm < 64; const int r = lat ? (u.pm >> 3) : 8;
        const size_t toff = (size_t)(lat ? u.pm : u.pm - 64) * BM * 1024;
        const int col0 = u.pn * BM + wc * 32 + 8 * fq;
        if (u.slab >= 0) {
            bf16_t* so = slabs + (size_t)u.slab * 2048 * 1024 + toff;
#pragma unroll
            for (int ai = 0; ai < 2; ++ai)
#pragma unroll
                for (int m = 0; m < 4; ++m) { const size_t p = (size_t)(wr * 64 + fr + ai * HALF + m * 16) * 1024 + col0;
#pragma unroll
                    for (int bj = 0; bj < 2; ++bj) { const f32x4 v0 = acc[ai][bj][m][0], v1 = acc[ai][bj][m][1];
                        u32x4 w; w.x = cvt_pk_bf16(v0[0], v0[1]); w.y = cvt_pk_bf16(v0[2], v0[3]); w.z = cvt_pk_bf16(v1[0], v1[1]); w.w = cvt_pk_bf16(v1[2], v1[3]);
                        *(u32x4*)(so + p + bj * HALF) = w; } }
            return; }
        bf16_t* out = (lat ? out_l : out_c) + toff;
        const float* gv = gate + r * 6144 + col0;
        f32x4 g[2][2];
#pragma unroll
        for (int bj = 0; bj < 2; ++bj)
#pragma unroll
            for (int n = 0; n < 2; ++n) g[bj][n] = *(const f32x4*)(gv + bj * HALF + n * 4);
#pragma unroll
        for (int ai = 0; ai < 2; ++ai) {
            f32x4 bf[BASEF32 ? 4 : 1][2][2]; u32x4 bw[BASEF32 ? 1 : 4][2];
#pragma unroll
            for (int m = 0; m < 4; ++m) { const size_t p = (size_t)(wr * 64 + fr + ai * HALF + m * 16) * 1024 + col0;
#pragma unroll
                for (int bj = 0; bj < 2; ++bj) {
                    if (BASEF32) { const float* bp = (const float*)(lat ? base_l : base_c) + toff + p + bj * HALF; bf[BASEF32 ? m : 0][bj][0] = *(const f32x4*)bp; bf[BASEF32 ? m : 0][bj][1] = *(const f32x4*)(bp + 4); }
                    else bw[BASEF32 ? 0 : m][bj] = *(const u32x4*)((const bf16_t*)(lat ? base_l : base_c) + toff + p + bj * HALF); } }
#pragma unroll
            for (int m = 0; m < 4; ++m) { const size_t p = (size_t)(wr * 64 + fr + ai * HALF + m * 16) * 1024 + col0;
#pragma unroll
                for (int bj = 0; bj < 2; ++bj) { f32x4 b0, b1;
                    if (BASEF32) { b0 = bf[BASEF32 ? m : 0][bj][0]; b1 = bf[BASEF32 ? m : 0][bj][1]; }
                    else { const u32x4 w = bw[BASEF32 ? 0 : m][bj];
                        b0 = (f32x4){bf16lo(w.x), bf16hi(w.x), bf16lo(w.y), bf16hi(w.y)}; b1 = (f32x4){bf16lo(w.z), bf16hi(w.z), bf16lo(w.w), bf16hi(w.w)}; }
                    const f32x4 o0 = b0 + g[bj][0] * acc[ai][bj][m][0], o1 = b1 + g[bj][1] * acc[ai][bj][m][1];
                    u32x4 wo; wo.x = cvt_pk_bf16(o0[0], o0[1]); wo.y = cvt_pk_bf16(o0[2], o0[3]); wo.z = cvt_pk_bf16(o1[0], o1[1]); wo.w = cvt_pk_bf16(o1[2], o1[3]);
                    *(u32x4*)(out + p + bj * HALF) = wo; } } }
    }
};

struct EpiResidFinal {
    static constexpr bool PERM = true;
    const bf16_t* base; const bf16_t* base2; float* out; const float* gate; const float* gain; float* stat; unsigned* cnt; PG8_LAS float* red;
    __device__ __forceinline__ void operator()(const f32x4 (&acc)[2][2][4][2], const Unit& u, int wr, int wc, int fr, int fq) const {
        { int t_ = threadIdx.x; asm volatile("" : "+v"(t_)); fr = t_ & 15; fq = (t_ >> 4) & 3; }
        const int r = u.pm >> 3; const size_t toff = (size_t)u.pm * BM * 1024; const int col0 = u.pn * BM + wc * 32 + 8 * fq;
        const float* gv = gate + r * 6144 + col0;
        f32x4 g[2][2];
#pragma unroll
        for (int bj = 0; bj < 2; ++bj)
#pragma unroll
            for (int n = 0; n < 2; ++n) g[bj][n] = *(const f32x4*)(gv + bj * HALF + n * 4);
        f32x4 o[2][2][4][2]; float ss[2][4];
#pragma unroll
        for (int ai = 0; ai < 2; ++ai) { u32x4 bw[4][2];
#pragma unroll
            for (int m = 0; m < 4; ++m)
#pragma unroll
                for (int bj = 0; bj < 2; ++bj) bw[m][bj] = __builtin_nontemporal_load((const u32x4*)((u.pm < 48 ? base : base2) + toff + (size_t)(wr * 64 + fr + ai * HALF + m * 16) * 1024 + col0 + bj * HALF));
#pragma unroll
            for (int m = 0; m < 4; ++m) { float s_ = 0.f;
#pragma unroll
                for (int bj = 0; bj < 2; ++bj) { const u32x4 w = bw[m][bj];
                    const f32x4 b0 = (f32x4){bf16lo(w.x), bf16hi(w.x), bf16lo(w.y), bf16hi(w.y)}, b1 = (f32x4){bf16lo(w.z), bf16hi(w.z), bf16lo(w.w), bf16hi(w.w)};
                    const f32x4 o0 = b0 + g[bj][0] * acc[ai][bj][m][0], o1 = b1 + g[bj][1] * acc[ai][bj][m][1];
                    o[ai][bj][m][0] = o0; o[ai][bj][m][1] = o1;
                    s_ += (o0[0] * o0[0] + o0[1] * o0[1]) + (o0[2] * o0[2] + o0[3] * o0[3]) + (o1[0] * o1[0] + o1[1] * o1[1]) + (o1[2] * o1[2] + o1[3] * o1[3]); }
                s_ += __shfl_xor(s_, 16); s_ += __shfl_xor(s_, 32); ss[ai][m] = s_; } }
        if (fq == 0) {
#pragma unroll
            for (int ai = 0; ai < 2; ++ai)
#pragma unroll
                for (int m = 0; m < 4; ++m) red[(wr * 4 + wc) * 128 + ai * 64 + m * 16 + fr] = ss[ai][m]; }
        __syncthreads();
        int tid = threadIdx.x; asm volatile("" : "+v"(tid));
        if (tid < 256) { const int w2 = tid >> 7, rr = tid & 127;
            const float t = (red[(w2 * 4 + 0) * 128 + rr] + red[(w2 * 4 + 1) * 128 + rr]) + (red[(w2 * 4 + 2) * 128 + rr] + red[(w2 * 4 + 3) * 128 + rr]);
            __hip_atomic_store(stat + ((size_t)u.pm * 4 + u.pn) * 256 + tid, t, __ATOMIC_RELAXED, __HIP_MEMORY_SCOPE_AGENT); }
        asm volatile("s_waitcnt vmcnt(0)" ::: "memory");
        __syncthreads();
        if (tid == 0) { __hip_atomic_fetch_add(cnt + u.pm, 1u, __ATOMIC_RELAXED, __HIP_MEMORY_SCOPE_AGENT);
            unsigned sp = 0; while (__hip_atomic_load(cnt + u.pm, __ATOMIC_RELAXED, __HIP_MEMORY_SCOPE_AGENT) < 4u) { __builtin_amdgcn_s_sleep(1); if (++sp > (1u << 22)) break; } }
        __syncthreads();
        if (tid < 256) { float t = 0.f;
#pragma unroll
            for (int q = 0; q < 4; ++q) t += __hip_atomic_load(stat + ((size_t)u.pm * 4 + q) * 256 + tid, __ATOMIC_RELAXED, __HIP_MEMORY_SCOPE_AGENT);
            red[1024 + tid] = 1.0f / sqrtf(t * (1.0f / 1024.0f) + 1e-6f); }
        __syncthreads();
        f32x4 gn[2][2];
#pragma unroll
        for (int bj = 0; bj < 2; ++bj)
#pragma unroll
            for (int n = 0; n < 2; ++n) gn[bj][n] = *(const f32x4*)(gain + col0 + bj * HALF + n * 4);
#pragma unroll
        for (int ai = 0; ai < 2; ++ai)
#pragma unroll
            for (int m = 0; m < 4; ++m) { const int rl = wr * 64 + fr + ai * HALF + m * 16; const float rstd = red[1024 + wr * 128 + ai * 64 + m * 16 + fr];
                float* op = out + toff + (size_t)rl * 1024 + col0;
#pragma unroll
                for (int bj = 0; bj < 2; ++bj) { *(f32x4*)(op + bj * HALF) = o[ai][bj][m][0] * rstd * gn[bj][0]; *(f32x4*)(op + bj * HALF + 4) = o[ai][bj][m][1] * rstd * gn[bj][1]; } }
    }
};

struct EpiResidNorm {
    static constexpr bool PERM = true;
    const float* base; bf16_t* out; const float* gate; bf16_t* H; const float* n2g; const float* mod; float* stat; unsigned* cnt; PG8_LAS float* red;
    __device__ __forceinline__ void operator()(const f32x4 (&acc)[2][2][4][2], const Unit& u, int wr, int wc, int fr, int fq) const {
        { int t_ = threadIdx.x; asm volatile("" : "+v"(t_)); fr = t_ & 15; fq = (t_ >> 4) & 3; }
        const int col0 = u.pn * BM + wc * 32 + 8 * fq;
        const int r = u.pm >> 3; const size_t toff = (size_t)u.pm * BM * 1024;
        const float* gv = gate + r * 6144 + col0;
        f32x4 g[2][2];
#pragma unroll
        for (int bj = 0; bj < 2; ++bj)
#pragma unroll
            for (int n = 0; n < 2; ++n) g[bj][n] = *(const f32x4*)(gv + bj * HALF + n * 4);
        f32x4 o[2][2][4][2]; float ss[2][4];
#pragma unroll
        for (int ai = 0; ai < 2; ++ai)
#pragma unroll
            for (int m = 0; m < 4; ++m) { f32x4 bf[2][2]; float s_ = 0.f;
#pragma unroll
                for (int bj = 0; bj < 2; ++bj) { const float* bp = base + toff + (size_t)(wr * 64 + fr + ai * HALF + m * 16) * 1024 + col0 + bj * HALF; bf[bj][0] = __builtin_nontemporal_load((const f32x4*)bp); bf[bj][1] = __builtin_nontemporal_load((const f32x4*)(bp + 4)); }
#pragma unroll
                for (int bj = 0; bj < 2; ++bj) {
                    const f32x4 o0 = bf[bj][0] + g[bj][0] * acc[ai][bj][m][0], o1 = bf[bj][1] + g[bj][1] * acc[ai][bj][m][1];
                    o[ai][bj][m][0] = o0; o[ai][bj][m][1] = o1;
                    s_ += (o0[0] * o0[0] + o0[1] * o0[1]) + (o0[2] * o0[2] + o0[3] * o0[3]) + (o1[0] * o1[0] + o1[1] * o1[1]) + (o1[2] * o1[2] + o1[3] * o1[3]); }
                s_ += __shfl_xor(s_, 16); s_ += __shfl_xor(s_, 32); ss[ai][m] = s_; }
        if (fq == 0) {
#pragma unroll
            for (int ai = 0; ai < 2; ++ai)
#pragma unroll
                for (int m = 0; m < 4; ++m) red[(wr * 4 + wc) * 128 + ai * 64 + m * 16 + fr] = ss[ai][m]; }
        __syncthreads();
        int tid = threadIdx.x; asm volatile("" : "+v"(tid));
        if (tid < 256) { const int w2 = tid >> 7, rr = tid & 127;
            const float t = (red[(w2 * 4 + 0) * 128 + rr] + red[(w2 * 4 + 1) * 128 + rr]) + (red[(w2 * 4 + 2) * 128 + rr] + red[(w2 * 4 + 3) * 128 + rr]);
            __hip_atomic_store(stat + ((size_t)u.pm * 4 + u.pn) * 256 + tid, t, __ATOMIC_RELAXED, __HIP_MEMORY_SCOPE_AGENT); }
        asm volatile("s_waitcnt vmcnt(0)" ::: "memory");
        __syncthreads();
        if (tid == 0) { __hip_atomic_fetch_add(cnt + u.pm, 1u, __ATOMIC_RELAXED, __HIP_MEMORY_SCOPE_AGENT);
            unsigned sp = 0; while (__hip_atomic_load(cnt + u.pm, __ATOMIC_RELAXED, __HIP_MEMORY_SCOPE_AGENT) < 4u) { __builtin_amdgcn_s_sleep(1); if (++sp > (1u << 22)) break; } }
        __syncthreads();
        if (tid < 256) { float t = 0.f;
#pragma unroll
            for (int q = 0; q < 4; ++q) t += __hip_atomic_load(stat + ((size_t)u.pm * 4 + q) * 256 + tid, __ATOMIC_RELAXED, __HIP_MEMORY_SCOPE_AGENT);
            red[1024 + tid] = 1.0f / sqrtf(t * (1.0f / 1024.0f) + 1e-6f); }
        __syncthreads();
#pragma unroll
        for (int bj = 0; bj < 2; ++bj) { f32x4 gm[2], sh[2];
#pragma unroll
            for (int n = 0; n < 2; ++n) { const int c = col0 + bj * HALF + n * 4;
                gm[n] = *(const f32x4*)(n2g + c) * (*(const f32x4*)(mod + r * 6144 + 1024 + c) + 1.0f); sh[n] = *(const f32x4*)(mod + r * 6144 + c); }
#pragma unroll
            for (int ai = 0; ai < 2; ++ai)
#pragma unroll
                for (int m = 0; m < 4; ++m) { const int rl = wr * 64 + fr + ai * HALF + m * 16; const float rstd = red[1024 + wr * 128 + ai * 64 + m * 16 + fr];
                    const size_t p = toff + (size_t)rl * 1024 + col0 + bj * HALF;
                    const f32x4 o0 = o[ai][bj][m][0], o1 = o[ai][bj][m][1];
                    u32x4 wo; wo.x = cvt_pk_bf16(o0[0], o0[1]); wo.y = cvt_pk_bf16(o0[2], o0[3]); wo.z = cvt_pk_bf16(o1[0], o1[1]); wo.w = cvt_pk_bf16(o1[2], o1[3]);
                    *(u32x4*)(out + p) = wo;
                    const f32x4 h0 = o0 * rstd * gm[0] + sh[0], h1 = o1 * rstd * gm[1] + sh[1];
                    u32x4 wh; wh.x = cvt_pk_bf16(h0[0], h0[1]); wh.y = cvt_pk_bf16(h0[2], h0[3]); wh.z = cvt_pk_bf16(h1[0], h1[1]); wh.w = cvt_pk_bf16(h1[2], h1[3]);
                    *(u32x4*)(H + p) = wh; } }
    }
};

struct EpiResidNormA {
    static constexpr bool PERM = true;
    const bf16_t* base; bf16_t* out; const float* gate; bf16_t* AU; const float* n2g; const float* mod; float* stat; unsigned* cnt; PG8_LAS float* red;
    __device__ __forceinline__ void operator()(const f32x4 (&acc)[2][2][4][2], const Unit& u, int wr, int wc, int fr, int fq) const {
        { int t_ = threadIdx.x; asm volatile("" : "+v"(t_)); fr = t_ & 15; fq = (t_ >> 4) & 3; }
        const int col0 = u.pn * BM + wc * 32 + 8 * fq;
        const int r = u.pm >> 3; const size_t toff = (size_t)u.pm * BM * 1024;
        const float* gv = gate + r * 6144 + col0;
        f32x4 g[2][2];
#pragma unroll
        for (int bj = 0; bj < 2; ++bj)
#pragma unroll
            for (int n = 0; n < 2; ++n) g[bj][n] = *(const f32x4*)(gv + bj * HALF + n * 4);
        f32x4 o[2][2][4][2]; float ss[2][4];
#pragma unroll
        for (int ai = 0; ai < 2; ++ai)
#pragma unroll
            for (int m = 0; m < 4; ++m) { f32x4 bf[2][2]; float s_ = 0.f;
#pragma unroll
                for (int bj = 0; bj < 2; ++bj) { const u32x4 w = __builtin_nontemporal_load((const u32x4*)(base + toff + (size_t)(wr * 64 + fr + ai * HALF + m * 16) * 1024 + col0 + bj * HALF));
                    bf[bj][0] = (f32x4){bf16lo(w.x), bf16hi(w.x), bf16lo(w.y), bf16hi(w.y)}; bf[bj][1] = (f32x4){bf16lo(w.z), bf16hi(w.z), bf16lo(w.w), bf16hi(w.w)}; }
#pragma unroll
                for (int bj = 0; bj < 2; ++bj) {
                    const f32x4 o0 = bf[bj][0] + g[bj][0] * acc[ai][bj][m][0], o1 = bf[bj][1] + g[bj][1] * acc[ai][bj][m][1];
                    o[ai][bj][m][0] = o0; o[ai][bj][m][1] = o1;
                    s_ += (o0[0] * o0[0] + o0[1] * o0[1]) + (o0[2] * o0[2] + o0[3] * o0[3]) + (o1[0] * o1[0] + o1[1] * o1[1]) + (o1[2] * o1[2] + o1[3] * o1[3]); }
                s_ += __shfl_xor(s_, 16); s_ += __shfl_xor(s_, 32); ss[ai][m] = s_; }
        if (fq == 0) {
#pragma unroll
            for (int ai = 0; ai < 2; ++ai)
#pragma unroll
                for (int m = 0; m < 4; ++m) red[(wr * 4 + wc) * 128 + ai * 64 + m * 16 + fr] = ss[ai][m]; }
        __syncthreads();
        int tid = threadIdx.x; asm volatile("" : "+v"(tid));
        if (tid < 256) { const int w2 = tid >> 7, rr = tid & 127;
            const float t = (red[(w2 * 4 + 0) * 128 + rr] + red[(w2 * 4 + 1) * 128 + rr]) + (red[(w2 * 4 + 2) * 128 + rr] + red[(w2 * 4 + 3) * 128 + rr]);
            __hip_atomic_store(stat + ((size_t)u.pm * 4 + u.pn) * 256 + tid, t, __ATOMIC_RELAXED, __HIP_MEMORY_SCOPE_AGENT); }
        asm volatile("s_waitcnt vmcnt(0)" ::: "memory");
        __syncthreads();
        if (tid == 0) { __hip_atomic_fetch_add(cnt + u.pm, 1u, __ATOMIC_RELAXED, __HIP_MEMORY_SCOPE_AGENT);
            unsigned sp = 0; while (__hip_atomic_load(cnt + u.pm, __ATOMIC_RELAXED, __HIP_MEMORY_SCOPE_AGENT) < 4u) { __builtin_amdgcn_s_sleep(1); if (++sp > (1u << 22)) break; } }
        __syncthreads();
        if (tid < 256) { float t = 0.f;
#pragma unroll
            for (int q = 0; q < 4; ++q) t += __hip_atomic_load(stat + ((size_t)u.pm * 4 + q) * 256 + tid, __ATOMIC_RELAXED, __HIP_MEMORY_SCOPE_AGENT);
            red[1024 + tid] = 1.0f / sqrtf(t * (1.0f / 1024.0f) + 1e-6f); }
        __syncthreads();
#pragma unroll
        for (int bj = 0; bj < 2; ++bj) { f32x4 gm[2], sh[2];
#pragma unroll
            for (int n = 0; n < 2; ++n) { const int c = col0 + bj * HALF + n * 4;
                gm[n] = *(const f32x4*)(n2g + c) * (*(const f32x4*)(mod + r * 6144 + 1024 + c) + 1.0f); sh[n] = *(const f32x4*)(mod + r * 6144 + c); }
#pragma unroll
            for (int ai = 0; ai < 2; ++ai)
#pragma unroll
                for (int m = 0; m < 4; ++m) { const int rl = wr * 64 + fr + ai * HALF + m * 16; const float rstd = red[1024 + wr * 128 + ai * 64 + m * 16 + fr];
                    const size_t p = toff + (size_t)rl * 1024 + col0 + bj * HALF;
                    const int grow = u.pm * BM + rl, cc = col0 + bj * HALF;
                    bf16_t* up = AU + ((size_t)((cc >> 4) * 1024 + (grow >> 11) * 128 + ((grow & 2047) >> 4)) * 256 + (grow & 15) * 16 + (cc & 15));
                    const f32x4 o0 = o[ai][bj][m][0], o1 = o[ai][bj][m][1];
                    u32x4 wo; wo.x = cvt_pk_bf16(o0[0], o0[1]); wo.y = cvt_pk_bf16(o0[2], o0[3]); wo.z = cvt_pk_bf16(o1[0], o1[1]); wo.w = cvt_pk_bf16(o1[2], o1[3]);
                    *(u32x4*)(out + p) = wo;
                    const f32x4 h0 = o0 * rstd * gm[0] + sh[0], h1 = o1 * rstd * gm[1] + sh[1];
                    u32x4 wh; wh.x = cvt_pk_bf16(h0[0], h0[1]); wh.y = cvt_pk_bf16(h0[2], h0[3]); wh.z = cvt_pk_bf16(h1[0], h1[1]); wh.w = cvt_pk_bf16(h1[2], h1[3]);
                    *(u32x4*)up = wh; } }
    }
};

struct EpiSlab {
    static constexpr bool PERM = true;
    bf16_t* slabs;
    __device__ __forceinline__ void operator()(const f32x4 (&acc)[2][2][4][2], const Unit& u, int wr, int wc, int fr, int fq) const {
        { int t_ = threadIdx.x; asm volatile("" : "+v"(t_)); fr = t_ & 15; fq = (t_ >> 4) & 3; }
        const int col0 = u.pn * BM + wc * 32 + 8 * fq;
        bf16_t* so = slabs + (size_t)u.slab * 2048 * 1024 + (size_t)(u.pm - 64) * BM * 1024;
#pragma unroll
        for (int ai = 0; ai < 2; ++ai)
#pragma unroll
            for (int m = 0; m < 4; ++m) { const size_t p = (size_t)(wr * 64 + fr + ai * HALF + m * 16) * 1024 + col0;
#pragma unroll
                for (int bj = 0; bj < 2; ++bj) { const f32x4 v0 = acc[ai][bj][m][0], v1 = acc[ai][bj][m][1];
                    u32x4 w; w.x = cvt_pk_bf16(v0[0], v0[1]); w.y = cvt_pk_bf16(v0[2], v0[3]); w.z = cvt_pk_bf16(v1[0], v1[1]); w.w = cvt_pk_bf16(v1[2], v1[3]);
                    *(u32x4*)(so + p + bj * HALF) = w; } }
    }
};
template <bool FUSEDN>
struct EpiRelu2 {
    static constexpr bool PERM = true;
    bf16_t* O; int ldc; const float* rowss; const float* bias2;
    __device__ __forceinline__ void operator()(const f32x4 (&acc)[2][2][4][2], const Unit& u, int wr, int wc, int fr, int fq) const {
        asm volatile("" : "+v"(fr), "+v"(fq));
        const int row0 = u.pm * BM + wr * 64 + fr, col0 = u.pn * BM + wc * 32 + 8 * fq;
        f32x4 bv[2][2];
        if (FUSEDN) { const float* bp = bias2 + (u.pm >> 3) * 4096 + col0;
#pragma unroll
            for (int bj = 0; bj < 2; ++bj) { bv[bj][0] = *(const f32x4*)(bp + bj * HALF); bv[bj][1] = *(const f32x4*)(bp + bj * HALF + 4); } }
        float rs[2][4];
#pragma unroll
        for (int ai = 0; ai < 2; ++ai)
#pragma unroll
            for (int m = 0; m < 4; ++m) rs[ai][m] = FUSEDN ? rowss[row0 + ai * HALF + m * 16] : 0.f;
#pragma unroll
        for (int ai = 0; ai < 2; ++ai)
#pragma unroll
            for (int m = 0; m < 4; ++m) { const int row = row0 + ai * HALF + m * 16; bf16_t* rowp = O + (size_t)row * ldc + col0;
                float rstd = 1.0f; if (FUSEDN) rstd = __builtin_amdgcn_rsqf(rs[ai][m] * (1.0f / 1024.0f) + 1e-6f);
#pragma unroll
                for (int bj = 0; bj < 2; ++bj) { f32x4 v0 = acc[ai][bj][m][0], v1 = acc[ai][bj][m][1];
                    if (FUSEDN) { v0 = v0 * rstd + bv[bj][0]; v1 = v1 * rstd + bv[bj][1]; }
#pragma unroll
                    for (int e = 0; e < 4; ++e) { const float a = fmaxf(v0[e], 0.f), b = fmaxf(v1[e], 0.f); v0[e] = a * a; v1[e] = b * b; }
                    u32x4 w; w.x = cvt_pk_bf16(v0[0], v0[1]); w.y = cvt_pk_bf16(v0[2], v0[3]); w.z = cvt_pk_bf16(v1[0], v1[1]); w.w = cvt_pk_bf16(v1[2], v1[3]);
                    *(u32x4*)(rowp + bj * HALF) = w; } }
    }
};

struct EpiGlu {
    static constexpr bool PERM = true;
    const bf16_t* x; bf16_t* xo; bf16_t* xo2; const float* gate;
    bf16_t* hb; const float* n2g; const float* sc2; float* rowss;
    __device__ __forceinline__ void operator()(const f32x4 (&acc)[2][2][4][2], const Unit& u, int wr, int wc, int fr, int fq) const {
        asm volatile("" : "+v"(fr), "+v"(fq));
        const int r = u.pm >> 3; const int col0 = u.pn * HALF + wc * 32 + 8 * fq; const float* gv = gate + r * 6144 + col0;
        const f32x4 g0 = *(const f32x4*)gv, g1 = *(const f32x4*)(gv + 4);
        const f32x4 gm0 = *(const f32x4*)(n2g + col0) * (*(const f32x4*)(sc2 + r * 6144 + col0) + 1.0f), gm1 = *(const f32x4*)(n2g + col0 + 4) * (*(const f32x4*)(sc2 + r * 6144 + col0 + 4) + 1.0f);
        u32x4 xw[2][4];
#pragma unroll
        for (int ai = 0; ai < 2; ++ai)
#pragma unroll
            for (int m = 0; m < 4; ++m) xw[ai][m] = __builtin_nontemporal_load((const u32x4*)(x + (size_t)(u.pm * BM + wr * 64 + fr + ai * HALF + m * 16) * 1024 + col0));
#pragma unroll
        for (int ai = 0; ai < 2; ++ai)
#pragma unroll
            for (int m = 0; m < 4; ++m) { const int row = u.pm * BM + wr * 64 + fr + ai * HALF + m * 16; bf16_t* p = (u.pm < 48 ? xo : xo2) + (size_t)row * 1024 + col0;
                const u32x4 w = xw[ai][m];
                f32x4 b0 = (f32x4){bf16lo(w.x), bf16hi(w.x), bf16lo(w.y), bf16hi(w.y)}, b1 = (f32x4){bf16lo(w.z), bf16hi(w.z), bf16lo(w.w), bf16hi(w.w)};
#pragma unroll
                for (int e = 0; e < 4; ++e) {
                    b0[e] += g0[e] * acc[ai][0][m][0][e] * (__builtin_amdgcn_rcpf(1.0f + __builtin_amdgcn_exp2f(-1.4426950408889634f * acc[ai][1][m][0][e])));
                    b1[e] += g1[e] * acc[ai][0][m][1][e] * (__builtin_amdgcn_rcpf(1.0f + __builtin_amdgcn_exp2f(-1.4426950408889634f * acc[ai][1][m][1][e]))); }
                u32x4 wo; wo.x = cvt_pk_bf16(b0[0], b0[1]); wo.y = cvt_pk_bf16(b0[2], b0[3]); wo.z = cvt_pk_bf16(b1[0], b1[1]); wo.w = cvt_pk_bf16(b1[2], b1[3]);
                *(u32x4*)p = wo;
                const f32x4 r0 = b0, r1 = b1;
                float ss = (r0[0] * r0[0] + r0[1] * r0[1]) + (r0[2] * r0[2] + r0[3] * r0[3]) + (r1[0] * r1[0] + r1[1] * r1[1]) + (r1[2] * r1[2] + r1[3] * r1[3]);
                ss += __shfl_xor(ss, 16); ss += __shfl_xor(ss, 32);
                if (fq == 0) atomicAdd(rowss + row, ss);
                const f32x4 h0 = r0 * gm0, h1 = r1 * gm1;
                u32x4 wh; wh.x = cvt_pk_bf16(h0[0], h0[1]); wh.y = cvt_pk_bf16(h0[2], h0[3]); wh.z = cvt_pk_bf16(h1[0], h1[1]); wh.w = cvt_pk_bf16(h1[2], h1[3]);
                *(u32x4*)(hb + (size_t)row * 1024 + col0) = wh; }
    }
};

struct EpiSsm1 {
    static constexpr bool PERM = true;
    bf16_t* S;
    __device__ __forceinline__ void operator()(const f32x4 (&acc)[2][2][4][2], const Unit& u, int wr, int wc, int fr, int fq) const {
        asm volatile("" : "+v"(fr), "+v"(fq));
        const int g = u.pn, i = u.pm - 5 * g; const int col0 = wc * 32 + 8 * fq;
#pragma unroll
        for (int ai = 0; ai < 2; ++ai)
#pragma unroll
            for (int m = 0; m < 4; ++m) { const int row = i * BM + wr * 64 + fr + ai * HALF + m * 16;
                if (row < 1152) { bf16_t* p = S + ((size_t)g * 1152 + row) * 256 + col0;
#pragma unroll
                    for (int bj = 0; bj < 2; ++bj) { const f32x4 v0 = acc[ai][bj][m][0], v1 = acc[ai][bj][m][1];
                        u32x4 w; w.x = cvt_pk_bf16(v0[0], v0[1]); w.y = cvt_pk_bf16(v0[2], v0[3]); w.z = cvt_pk_bf16(v1[0], v1[1]); w.w = cvt_pk_bf16(v1[2], v1[3]);
                        *(u32x4*)(p + bj * HALF) = w; } } }
    }
};

__device__ __forceinline__ float gelu_tanh(float v) {
    const float e = __builtin_amdgcn_exp2f((2.0f * 1.4426950408889634f * 0.7978845608028654f) * v * __builtin_fmaf(0.044715f * v, v, 1.0f));
    const float r = __builtin_amdgcn_rcpf(1.0f + e);
    return __builtin_fmaf(-v, r, v);
}
struct EpiSsm2 {
    static constexpr bool PERM = true;
    bf16_t* Z; const bf16_t* A2; const float* dskip;
    __device__ __forceinline__ void operator()(const f32x4 (&acc)[2][2][4][2], const Unit& u, int wr, int wc, int fr, int fq) const {
        asm volatile("" : "+v"(fr), "+v"(fq));
        const int g = u.pn, i = u.pm - 5 * g; const int hh = 8 * (fq & 1); const int zcol = g * 16 + hh;
#pragma unroll
        for (int ai = 0; ai < 2; ++ai)
#pragma unroll
            for (int m = 0; m < 4; ++m) { const int ridx = i * BM + wr * 64 + fr + ai * HALF + m * 16; const int b = ridx >> 7, c = ridx & 127;
#pragma unroll
                for (int bj = 0; bj < 2; ++bj) { const int t = 8 * bj + 2 * wc + (fq >> 1);
                    const f32x4 v0 = acc[ai][bj][m][0], v1 = acc[ai][bj][m][1];
                    float z[8];
#pragma unroll
                    for (int e = 0; e < 4; ++e) { z[e] = gelu_tanh(v0[e]); z[4 + e] = gelu_tanh(v1[e]); }
                    u32x4 w; w.x = cvt_pk_bf16(z[0], z[1]); w.y = cvt_pk_bf16(z[2], z[3]); w.z = cvt_pk_bf16(z[4], z[5]); w.w = cvt_pk_bf16(z[6], z[7]);
                    *(u32x4*)(Z + (size_t)(b * 2048 + c * 16 + t) * 1024 + zcol) = w;
                    } }
    }
};

template <class Epi, class Sched, bool ALIGN_EPI, int AJT = 0, int PRE = 0>
__device__ __forceinline__ void gemm_phase(PG8_LAS unsigned char* lds, const Gemm g, const Sched& S, const Epi& E) {
    int tid = threadIdx.x; asm volatile("" : "+v"(tid));
    const int wid = __builtin_amdgcn_readfirstlane(tid >> 6), lane = tid & 63, wr = wid >> 2, wc = wid & 3, fr = lane & 15, fq = lane >> 4;
    unsigned voffA[2], voffB[2];
#pragma unroll
    for (int i = 0; i < 2; ++i) { int R, C; stage_rc(tid * 16 + i * 8192, R, C); const int Rb = Epi::PERM ? ((R & ~31) + perm32(R & 31)) : R;
        voffA[i] = (unsigned)(R * g.lda + C) * 2u; voffB[i] = (unsigned)(Rb * g.ldb + C) * 2u; }
    const size_t kstep = (size_t)(BK * 2);
    const size_t hstepA = (size_t)HALF * g.lda * 2, hstepB = (size_t)HALF * g.ldb * 2;
    const size_t tstepA = 2 * hstepA, tstepB = 2 * hstepB;
    const unsigned ldsw = (unsigned)wid * 1024u;
    const int aoff = lds_byte(wr * 64 + fr, fq * 8), boff = lds_byte(wc * 32 + fr, fq * 8);
#define PG8_SA(b, h) (((b) * 2 + (h)) * HTB)
#define PG8_SB(b, h) ((4 + (b) * 2 + (h)) * HTB)
#define PG8_STAGE(bufoff, gbase, voff) do { _Pragma("unroll") for (int _i = 0; _i < 2; ++_i) \
        __builtin_amdgcn_global_load_lds((const unsigned*)((const char*)(gbase) + (voff)[_i]), (PG8_LAS unsigned*)(lds + (bufoff) + ldsw + _i * 8192), 16, 0, 0); } while (0)
#define PG8_LDA(dst, b, h) do { _Pragma("unroll") for (int m = 0; m < 4; ++m) _Pragma("unroll") for (int k = 0; k < 2; ++k) dst[m][k] = *(const PG8_LAS bf16x8*)(lds + PG8_SA(b, h) + aoff + m * 2048 + k * 1024); } while (0)
#define PG8_LDB(dst, b, h) do { _Pragma("unroll") for (int n = 0; n < 2; ++n) _Pragma("unroll") for (int k = 0; k < 2; ++k) dst[n][k] = *(const PG8_LAS bf16x8*)(lds + PG8_SB(b, h) + boff + n * 2048 + k * 1024); } while (0)
#define PG8_MMA(ai, bj, At, Bt) do { __builtin_amdgcn_s_setprio(1); _Pragma("unroll") for (int m = 0; m < 4; ++m) _Pragma("unroll") for (int n = 0; n < 2; ++n) _Pragma("unroll") for (int k = 0; k < 2; ++k) \
        acc[ai][bj][m][n] = __builtin_amdgcn_mfma_f32_16x16x32_bf16(Bt[n][k], At[m][k], acc[ai][bj][m][n], 0, 0, 0); __builtin_amdgcn_s_setprio(0); } while (0)
#define PG8_WAIT_V(n) asm volatile("s_waitcnt vmcnt(" #n ")" ::: "memory")
#define PG8_WAIT_L(n) asm volatile("s_waitcnt lgkmcnt(" #n ")" ::: "memory")
#define PG8_BAR __builtin_amdgcn_s_barrier()
#define PG8_SCHED __builtin_amdgcn_sched_barrier(0)
    Unit cur, nxt; int ui = 0;
    if (!S.next(0, cur)) return;
    f32x4 acc[2][2][4][2];
#pragma unroll
    for (int a = 0; a < 2; ++a)
#pragma unroll
        for (int b = 0; b < 2; ++b)
#pragma unroll
            for (int m = 0; m < 4; ++m)
#pragma unroll
                for (int n = 0; n < 2; ++n) acc[a][b][m][n] = (f32x4){0.f, 0.f, 0.f, 0.f};
    bf16x8 At[4][2], B0[2][2], B1[2][2];
    const char* cA = (const char*)g.A + (size_t)S.atile(cur) * tstepA + (size_t)cur.kt0 * kstep; const char* cB = (const char*)g.Bt + (size_t)cur.pn * tstepB + (size_t)cur.kt0 * kstep;
    if constexpr (PRE != 2) { PG8_STAGE(PG8_SB(0, 0), cB, voffB); PG8_STAGE(PG8_SB(0, 1), cB + hstepB, voffB); PG8_STAGE(PG8_SA(0, 0), cA, voffA); PG8_STAGE(PG8_SA(0, 1), cA + hstepA, voffA); }
    if constexpr (PRE == 1) { PG8_STAGE(PG8_SB(1, 0), cB + kstep, voffB); PG8_STAGE(PG8_SA(1, 0), cA + kstep, voffA); PG8_STAGE(PG8_SB(1, 1), cB + hstepB + kstep, voffB); return; }
    if (wr == 1) PG8_BAR;
    PG8_WAIT_V(2); PG8_BAR;
    if constexpr (PRE != 2) { PG8_STAGE(PG8_SB(1, 0), cB + kstep, voffB); PG8_STAGE(PG8_SA(1, 0), cA + kstep, voffA); PG8_STAGE(PG8_SB(1, 1), cB + hstepB + kstep, voffB); }
    PG8_WAIT_V(6); PG8_BAR;
    for (;;) {
        const bool has_next = S.next(ui + 1, nxt);
        const char* nA = has_next ? (const char*)g.A + (size_t)S.atile(nxt) * tstepA + (size_t)nxt.kt0 * kstep : cA; const char* nB = has_next ? (const char*)g.Bt + (size_t)nxt.pn * tstepB + (size_t)nxt.kt0 * kstep : cB;
        const int nt = cur.nt;
        for (int t = 0; t < nt; t += 2) {
            const bool last = (t == nt - 2);
            const char* a1 = cA + (size_t)(t + 1) * kstep;
            const char* a2 = last ? nA : cA + (size_t)(t + 2) * kstep; const char* b2 = last ? nB : cB + (size_t)(t + 2) * kstep;
            const char* a3 = a2 + kstep; const char* b3 = b2 + kstep;
            if constexpr (AJT > 0) { if (t + 1 >= AJT) a1 += g.ajump; if (!last) { if (t + 2 >= AJT) a2 += g.ajump; a3 = a2 + kstep; if (t + 2 < AJT && t + 3 >= AJT) a3 += g.ajump; } }
            PG8_LDB(B0, 0, 0); PG8_LDB(B1, 0, 1); PG8_SCHED; PG8_LDA(At, 0, 0); PG8_STAGE(PG8_SA(1, 1), a1 + hstepA, voffA);
            PG8_WAIT_V(8); PG8_WAIT_L(0); PG8_BAR; PG8_MMA(0, 0, At, B0); PG8_MMA(0, 1, At, B1); PG8_BAR; PG8_SCHED;
            PG8_LDA(At, 0, 1); PG8_STAGE(PG8_SB(0, 0), b2, voffB); PG8_STAGE(PG8_SB(0, 1), b2 + hstepB, voffB); PG8_STAGE(PG8_SA(0, 0), a2, voffA);
            PG8_WAIT_V(8); PG8_WAIT_L(0); PG8_BAR; PG8_MMA(1, 0, At, B0); PG8_MMA(1, 1, At, B1); PG8_BAR; PG8_SCHED;
            PG8_LDB(B0, 1, 0); PG8_LDB(B1, 1, 1); PG8_SCHED; PG8_LDA(At, 1, 0); PG8_STAGE(PG8_SA(0, 1), a2 + hstepA, voffA);
            PG8_WAIT_V(8); PG8_WAIT_L(0); PG8_BAR; PG8_MMA(0, 0, At, B0); PG8_MMA(0, 1, At, B1); PG8_BAR; PG8_SCHED;
            PG8_LDA(At, 1, 1); PG8_STAGE(PG8_SB(1, 0), b3, voffB); PG8_STAGE(PG8_SB(1, 1), b3 + hstepB, voffB); PG8_STAGE(PG8_SA(1, 0), a3, voffA);
            PG8_WAIT_V(8); PG8_WAIT_L(0); PG8_BAR; PG8_MMA(1, 0, At, B0); PG8_MMA(1, 1, At, B1); PG8_BAR; PG8_SCHED;
        }
        if constexpr (ALIGN_EPI) { if (wr == 0) PG8_BAR; }
        E(acc, cur, wr, wc, fr, fq);
        if (!has_next) break;
#pragma unroll
        for (int a = 0; a < 2; ++a)
#pragma unroll
            for (int b = 0; b < 2; ++b)
#pragma unroll
                for (int m = 0; m < 4; ++m)
#pragma unroll
                    for (int n = 0; n < 2; ++n) acc[a][b][m][n] = (f32x4){0.f, 0.f, 0.f, 0.f};
        cur = nxt; cA = nA; cB = nB; ++ui;
        if constexpr (ALIGN_EPI) { if (wr == 1) PG8_BAR; }
    }
    PG8_WAIT_V(0);
    if constexpr (!ALIGN_EPI) { if (wr == 0) PG8_BAR; }
    PG8_BAR;
#undef PG8_SA
#undef PG8_SB
#undef PG8_STAGE
#undef PG8_LDA
#undef PG8_LDB
#undef PG8_MMA
#undef PG8_WAIT_V
#undef PG8_WAIT_L
#undef PG8_BAR
#undef PG8_SCHED
}
}
namespace att {
typedef __attribute__((address_space(3))) unsigned char lds_u8;
typedef __attribute__((address_space(3))) const unsigned char* lds_cptr;
using bf16x8 = __attribute__((ext_vector_type(8))) short;
using s16x4 = __attribute__((ext_vector_type(4))) short;
using f32x16 = __attribute__((ext_vector_type(16))) float;
using f32x4 = __attribute__((ext_vector_type(4))) float;
using u32x4 = __attribute__((ext_vector_type(4))) unsigned;
typedef unsigned short bf16_t;
#define ATT_LF __attribute__((address_space(3))) float
constexpr int PITCH = 3072;
constexpr int OPITCH = 1024;
constexpr int STAGE_B = 32768;
constexpr int L_OST = 98304;
constexpr int L_WSF = 132096;
constexpr int L_BIAS = 136192;
constexpr int XSTR = 132;
constexpr float LOG2E = 1.4426950408889634f;

__device__ __forceinline__ int crow(int r, int hi) { return (r & 3) + 8 * (r >> 2) + 4 * hi; }
#define ATT_SBAR() __builtin_amdgcn_sched_barrier(0)
__device__ __forceinline__ void glds16(const void* gsrc, unsigned lds_dst) { unsigned keep;
    asm volatile("s_mov_b32 %0, m0\n\ts_mov_b32 m0, %2\n\ts_nop 0\n\tglobal_load_lds_dwordx4 %1, off\n\ts_mov_b32 m0, %0" : "=&s"(keep) : "v"(gsrc), "s"(lds_dst) : "memory"); }
typedef float f32x2_t __attribute__((ext_vector_type(2))); typedef __bf16 bf16x2_t __attribute__((ext_vector_type(2)));
__device__ __forceinline__ unsigned cvtpk(float lo, float hi) { f32x2_t v = {lo, hi}; bf16x2_t b = __builtin_convertvector(v, bf16x2_t); return __builtin_bit_cast(unsigned, b); }

typedef short v4i16_t __attribute__((ext_vector_type(4)));
__device__ __forceinline__ s16x4 vtr(lds_cptr p) { return __builtin_bit_cast(s16x4, __builtin_amdgcn_ds_read_tr16_b64_v4i16((__attribute__((address_space(3))) v4i16_t*)p)); }
__device__ __forceinline__ void qkt(f32x16& p0, f32x16& p1, lds_cptr Kslot, const bf16x8* qr, int r32, int hi) {
    lds_cptr kb = Kslot + r32 * 128; const int sw = (r32 >> 1) & 7;
    const f32x16 z = f32x16{};
#pragma unroll
    for (int d0 = 0; d0 < 4; ++d0) {
        const int off = ((2 * d0 + hi) ^ sw) << 4;
        const bf16x8 b0 = *(const __attribute__((address_space(3))) bf16x8*)(kb + off);
        const bf16x8 b1 = *(const __attribute__((address_space(3))) bf16x8*)(kb + off + 4096);
        if (d0 == 0) { p0 = __builtin_amdgcn_mfma_f32_32x32x16_bf16(b0, qr[0], z, 0, 0, 0); p1 = __builtin_amdgcn_mfma_f32_32x32x16_bf16(b1, qr[0], z, 0, 0, 0); }
        else { p0 = __builtin_amdgcn_mfma_f32_32x32x16_bf16(b0, qr[d0], p0, 0, 0, 0); p1 = __builtin_amdgcn_mfma_f32_32x32x16_bf16(b1, qr[d0], p1, 0, 0, 0); } }
}
#define ATT_TRG(lo_, hi_, vb_, off_) do { _Pragma("unroll") for (int ks = 0; ks < 4; ++ks) { \
        asm volatile("ds_read_b64_tr_b16 %0,%1 offset:%c2" : "=&v"(lo_[ks]) : "v"(vb_), "i"((off_) + ks * 2048) : "memory"); \
        asm volatile("ds_read_b64_tr_b16 %0,%1 offset:%c2" : "=&v"(hi_[ks]) : "v"(vb_), "i"((off_) + ks * 2048 + 1024) : "memory"); } } while (0)
#define ATT_PK(lo_, hi_, k) (bf16x8){lo_[k][0], lo_[k][1], lo_[k][2], lo_[k][3], hi_[k][0], hi_[k][1], hi_[k][2], hi_[k][3]}
#define ATT_MM(acc_, lo_, hi_) do { __builtin_amdgcn_s_setprio(1); \
        acc_ = __builtin_amdgcn_mfma_f32_32x32x16_bf16(pa0, ATT_PK(lo_, hi_, 0), acc_, 0, 0, 0); acc_ = __builtin_amdgcn_mfma_f32_32x32x16_bf16(pa1, ATT_PK(lo_, hi_, 1), acc_, 0, 0, 0); \
        acc_ = __builtin_amdgcn_mfma_f32_32x32x16_bf16(pa2, ATT_PK(lo_, hi_, 2), acc_, 0, 0, 0); acc_ = __builtin_amdgcn_mfma_f32_32x32x16_bf16(pa3, ATT_PK(lo_, hi_, 3), acc_, 0, 0, 0); \
        __builtin_amdgcn_s_setprio(0); } while (0)
template <int NS>
__device__ __forceinline__ void pv(f32x16* o, int vbA, int vbB, bf16x8 pa0, bf16x8 pa1, bf16x8 pa2, bf16x8 pa3) {
    s16x4 loA[4], hiA[4], loB[4], hiB[4];
    asm volatile("s_waitcnt lgkmcnt(0)" ::: "memory");
    ATT_TRG(loA, hiA, vbA, 0);
    ATT_TRG(loB, hiB, vbB, 0);
    asm volatile("s_waitcnt lgkmcnt(8)" ::: "memory"); ATT_SBAR();
    ATT_MM(o[0], loA, hiA);
    if (NS == 2) {
        ATT_SBAR(); ATT_TRG(loA, hiA, vbA, 8192);
        asm volatile("s_waitcnt lgkmcnt(8)" ::: "memory"); ATT_SBAR();
        ATT_MM(o[1], loB, hiB);
        ATT_SBAR(); ATT_TRG(loB, hiB, vbB, 8192);
        asm volatile("s_waitcnt lgkmcnt(8)" ::: "memory"); ATT_SBAR();
        ATT_MM(o[2], loA, hiA);
        asm volatile("s_waitcnt lgkmcnt(0)" ::: "memory"); ATT_SBAR();
        ATT_MM(o[3], loB, hiB);
    } else {
        asm volatile("s_waitcnt lgkmcnt(0)" ::: "memory"); ATT_SBAR();
        ATT_MM(o[1], loB, hiB);
    }
}
__device__ __forceinline__ float rowmax32(const f32x16& p0, const f32x16& p1) {
    float a = p0[0], b = p1[0];
#pragma unroll
    for (int r = 1; r < 16; ++r) { a = __builtin_fmaxf(a, p0[r]); b = __builtin_fmaxf(b, p1[r]); }
    const float m = __builtin_fmaxf(a, b);
    auto rr = __builtin_amdgcn_permlane32_swap(__float_as_uint(m), __float_as_uint(m), false, false);
    return __builtin_fmaxf(__uint_as_float(rr[0]), __uint_as_float(rr[1]));
}
template <int XM> __device__ __forceinline__ float softmax_step(f32x16& p0, f32x16& p1, float& m, float& l) {
    constexpr float THR = 8.0f;
    const float rm = rowmax32(p0, p1);
    float f = 1.0f;
    if (__any(rm > m + THR)) { const float mn = __builtin_fmaxf(m, rm); f = __builtin_amdgcn_exp2f(m - mn); m = mn; l *= f; }
    float s = 0.f;
#pragma unroll
    for (int r = 0; r < 16; ++r) {
        if (XM == 3) { p0[r] = (p0[r] - m) * 0.001f + 0.01f; p1[r] = (p1[r] - m) * 0.001f + 0.01f; }
        else { p0[r] = __builtin_amdgcn_exp2f(p0[r] - m); p1[r] = __builtin_amdgcn_exp2f(p1[r] - m); }
        s += p0[r] + p1[r]; }
    l += s;
    return f;
}

struct UnitDesc {
    int qrow0;
    int qcol, kcol, vcol;
    int latrow, t0, nlat;
    int ctxrow;
    int ocol;
    int r0, head;
};

template <bool DIFF, bool NAM, int XM = 0>
__device__ __forceinline__ void attn_unit(const UnitDesc& U, const bf16_t* __restrict__ proj, bf16_t* __restrict__ out, lds_u8* shm3,
                                          const float* __restrict__ rpb, const float* __restrict__ subg, float lam, float outscale) {
    if (XM == 7) return;
    int tid = threadIdx.x; asm volatile("" : "+v"(tid));
    const int lane = tid & 63, r32 = lane & 31, hi = lane >> 5; const int wid = __builtin_amdgcn_readfirstlane(tid >> 6);
    const unsigned lds0 = (unsigned)(uintptr_t)shm3;
    ATT_LF* wsf = (ATT_LF*)(shm3 + L_WSF + wid * 512);
    constexpr int SUBS = DIFF ? 1 : 2;
    const int ntile = U.nlat + 4;
    const int nstage = (XM == 6) ? 1 : (ntile + SUBS - 1) / SUBS;
    const int qblk = DIFF ? (wid >> 1) : wid, sh = DIFF ? (wid & 1) : 0;
    if (NAM) { ATT_LF* bl = (ATT_LF*)(shm3 + L_BIAS);
        for (int i = tid; i < 15 * 31; i += 512) { const int ro = i / 31, j = i - ro * 31; bl[ro * 128 + 48 + j] = rpb[(U.head * 15 + ro) * 31 + j] * LOG2E; } }
    const bf16_t* ksrc0 = proj + (size_t)(8 * wid + (lane >> 3)) * PITCH + U.kcol + (((lane & 7) ^ ((4 * wid + (lane >> 4)) & 7)) << 3);
    const bf16_t* vsrc0 = proj + (size_t)(8 * wid + (lane >> 3)) * PITCH + U.vcol + (((lane & 7) ^ (((lane >> 4) & 1) << 2)) << 3);
    const unsigned dstw = lds0 + wid * 1024;
#define ATT_TILE_ROW(i) (((i) < U.nlat) ? (U.latrow + 64 * (U.t0 + (i))) : (U.ctxrow + 64 * ((i) - U.nlat)))
#define ATT_DMA_STAGE(s_) do { if (XM == 5 || XM >= 9) break; const int s__ = (s_); const unsigned d_ = (unsigned)__builtin_amdgcn_readfirstlane((int)(dstw + (s__ & 3) * STAGE_B)); \
        if (DIFF) { const size_t ro_ = (size_t)ATT_TILE_ROW(s__) * PITCH; glds16(ksrc0 + ro_, d_); glds16(ksrc0 + ro_ + 64, d_ + 8192); glds16(vsrc0 + ro_, d_ + 16384); glds16(vsrc0 + ro_ + 64, d_ + 24576); } \
        else { const size_t ro_ = (size_t)ATT_TILE_ROW(2 * s__) * PITCH; glds16(ksrc0 + ro_, d_); glds16(vsrc0 + ro_, d_ + 16384); \
               { const int t1_ = (2 * s__ + 1 < ntile) ? 2 * s__ + 1 : 2 * s__; const size_t r1_ = (size_t)ATT_TILE_ROW(t1_) * PITCH; glds16(ksrc0 + r1_, d_ + 8192); glds16(vsrc0 + r1_, d_ + 24576); } } } while (0)
    const bf16_t* Qw = proj + (size_t)(U.qrow0 + qblk * 32 + r32) * PITCH + U.qcol + sh * 64 + hi * 8;
    bf16x8 qr[4];
#pragma unroll
    for (int d0 = 0; d0 < 4; ++d0) qr[d0] = *(const bf16x8*)(Qw + d0 * 16);
    float m1 = -1e30f, l1 = 0.f;
    constexpr int NO = DIFF ? 4 : 2;
    f32x16 o[NO];
#pragma unroll
    for (int i = 0; i < NO; ++i) o[i] = f32x16{};
    const int dsw_ = ((lane & 15) >> 3) & 1;
    const int vbl = (int)lds0 + 16384 + (4 * hi + ((lane & 15) >> 2)) * 128 + ((lane >> 4) & 1) * 32 + (lane & 3) * 8;
    const int vblA = vbl + dsw_ * 64, vblB = vbl + (1 - dsw_) * 64;
    const int gr = U.r0 + (wid >> 1); const int rs = gr < 4 ? 0 : (gr > 28 ? 24 : gr - 4);
    const int qc = 32 * (wid & 1) + r32; const int cs = qc < 8 ? 0 : (qc > 56 ? 48 : qc - 8);
#define ATT_USE(j) ((j) < ntile && (!NAM || (j) >= U.nlat || ((U.t0 + (j)) >= rs && (U.t0 + (j)) <= rs + 7)))
#define ATT_KSLOT(j) ((lds_cptr)(shm3 + (((j) / SUBS) & 3) * STAGE_B + (DIFF ? sh * 8192 : ((j) & 1) * 8192)))
#define ATT_WAIT_BAR(N) do { if (XM < 9) asm volatile("s_waitcnt vmcnt(" #N ") lgkmcnt(0)\n\ts_barrier" ::: "memory"); } while (0)
    ATT_DMA_STAGE(0);
    if (nstage > 1) ATT_DMA_STAGE(1);
    if (nstage > 2) ATT_DMA_STAGE(2);
    if (nstage > 2) ATT_WAIT_BAR(8); else if (nstage > 1) ATT_WAIT_BAR(4); else ATT_WAIT_BAR(0);
    f32x16 sc0 = f32x16{}, sc1 = f32x16{}, sn0 = f32x16{}, sn1 = f32x16{};
    if (ATT_USE(0)) qkt(sc0, sc1, ATT_KSLOT(0), qr, r32, hi);
    for (int s = 0; s < nstage; ++s) {
#pragma unroll
        for (int sub = 0; sub < SUBS; ++sub) {
            const int j = s * SUBS + sub;
            if (sub == SUBS - 1 && s + 1 < nstage) {
                if (s + 2 < nstage) ATT_WAIT_BAR(4); else ATT_WAIT_BAR(0);
                if (s + 3 < nstage) ATT_DMA_STAGE(s + 3);
            }
            const bool un = ATT_USE(j + 1), uc = ATT_USE(j);
            if (un) { if (XM == 4 || XM == 12) { sn0 = f32x16{}; sn1 = f32x16{}; asm volatile("" : "+v"(sn0), "+v"(sn1)); } else qkt(sn0, sn1, ATT_KSLOT(j + 1), qr, r32, hi); }
            if (uc) {
                if (NAM && j < U.nlat) {
                    const int kr = U.t0 + j;
                    const ATT_LF* brow = (const ATT_LF*)(shm3 + L_BIAS) + (kr - gr + 7) * 128 + 48 + 15 - qc + 4 * hi;
#pragma unroll
                    for (int r = 0; r < 16; ++r) { const int kc = (r & 3) + 8 * (r >> 2); const int kcl = kc + 4 * hi;
                        const float b0 = brow[kc], b1 = brow[kc + 32];
                        sc0[r] = ((unsigned)(kcl - cs) < 16u) ? sc0[r] + b0 : -INFINITY;
                        sc1[r] = ((unsigned)(kcl + 32 - cs) < 16u) ? sc1[r] + b1 : -INFINITY;
                        if ((r & 3) == 3) ATT_SBAR(); }
                }
                if (XM < 10) { const float rm = rowmax32(sc0, sc1);
                  if (__any(rm > m1 + 6.0f)) {
                      const float mn = __builtin_fmaxf(m1, rm); const float f = __builtin_amdgcn_exp2f(m1 - mn); m1 = mn; l1 *= f;
                      if (hi == 0) wsf[r32] = f;
                      asm volatile("s_waitcnt lgkmcnt(0)" ::: "memory");
                      float fr_[16];
#pragma unroll
                      for (int r = 0; r < 16; ++r) fr_[r] = wsf[crow(r, hi)];
#pragma unroll
                      for (int d = 0; d < NO; ++d)
#pragma unroll
                          for (int r = 0; r < 16; ++r) o[d][r] *= fr_[r];
                      asm volatile("s_waitcnt lgkmcnt(0)" ::: "memory");
                  } }
                { const int vbo = (s & 3) * STAGE_B + (DIFF ? 0 : sub * 8192);
                  lds_cptr vpA = (lds_cptr)(uintptr_t)(unsigned)(vblA + vbo), vpB = (lds_cptr)(uintptr_t)(unsigned)(vblB + vbo);
                  float ssum = 0.f;
                  bf16x8 vfc[NO], vfn[NO]; bf16x8 pac, pan;
#define ATT_VLD(dst, ks_) do { if (XM == 11 || XM == 13) { _Pragma("unroll") for (int d = 0; d < NO; ++d) { dst[d] = (bf16x8){1, 2, 3, 4, 5, 6, 7, 8}; asm volatile("" : "+v"(dst[d])); } break; } _Pragma("unroll") for (int d = 0; d < NO; ++d) { lds_cptr vp_ = ((d & 1) ? vpB : vpA) + (d >> 1) * 8192 + (ks_) * 2048; \
                      const s16x4 lo_ = vtr(vp_), hi_ = vtr(vp_ + 1024); dst[d] = (bf16x8){lo_[0], lo_[1], lo_[2], lo_[3], hi_[0], hi_[1], hi_[2], hi_[3]}; } } while (0)
#define ATT_EXP8(dst, ks_) do { float e_[8]; _Pragma("unroll") for (int i = 0; i < 8; ++i) { const float x_ = ((ks_) < 2) ? sc0[((ks_) & 1) * 8 + i] : sc1[((ks_) & 1) * 8 + i]; e_[i] = (XM >= 10) ? x_ : __builtin_amdgcn_exp2f(x_ - m1); ssum += e_[i]; } \
                      const u32x4 pw_ = (u32x4){cvtpk(e_[0], e_[1]), cvtpk(e_[2], e_[3]), cvtpk(e_[4], e_[5]), cvtpk(e_[6], e_[7])}; dst = __builtin_bit_cast(bf16x8, pw_); } while (0)
                  ATT_VLD(vfc, 0); ATT_EXP8(pac, 0);
#pragma unroll
                  for (int ks = 0; ks < 4; ++ks) {
                      if (ks < 3) { ATT_VLD(vfn, ks + 1); ATT_EXP8(pan, ks + 1); }
#pragma unroll
                      for (int d = 0; d < NO; ++d) { if (XM == 13) { asm volatile("" :: "v"(pac), "v"(vfc[d])); } else o[d] = __builtin_amdgcn_mfma_f32_32x32x16_bf16(pac, vfc[d], o[d], 0, 0, 0); }
                      if (ks < 3) {
#pragma unroll
                          for (int d = 0; d < NO; ++d) { vfc[d] = vfn[d];
                              __builtin_amdgcn_sched_group_barrier(0x008, 1, 0); __builtin_amdgcn_sched_group_barrier(0x100, 2, 0); __builtin_amdgcn_sched_group_barrier(0x002, DIFF ? 7 : 14, 0); }
                          pac = pan; }
                  }
#undef ATT_VLD
#undef ATT_EXP8
                  l1 += ssum; }
            }
            sc0 = sn0; sc1 = sn1;
        }
    }
    { auto rr = __builtin_amdgcn_permlane32_swap(__float_as_uint(l1), __float_as_uint(l1), false, false); l1 = __uint_as_float(rr[0]) + __uint_as_float(rr[1]); }
    if (hi == 0) wsf[32 + r32] = (DIFF && sh == 1) ? lam / l1 : 1.0f / l1;
    asm volatile("s_waitcnt lgkmcnt(0)" ::: "memory");
    float rli[16];
#pragma unroll
    for (int r = 0; r < 16; ++r) rli[r] = wsf[32 + crow(r, hi)];
    if (!DIFF) {
        bf16_t* Ow = out + (size_t)(U.qrow0 + wid * 32) * OPITCH + U.ocol;
        asm volatile("s_waitcnt lgkmcnt(0)\n\ts_barrier" ::: "memory");
        __attribute__((address_space(3))) bf16_t* stg = (__attribute__((address_space(3))) bf16_t*)(shm3 + wid * 4096);
#pragma unroll
        for (int r = 0; r < 16; ++r) { const int orow = crow(r, hi);
#pragma unroll
            for (int d0 = 0; d0 < 2; ++d0) stg[orow * 64 + d0 * 32 + r32] = (bf16_t)(cvtpk(o[d0][r] * rli[r], 0.f) & 0xffffu); }
        asm volatile("s_waitcnt lgkmcnt(0)" ::: "memory");
#pragma unroll
        for (int i = 0; i < 4; ++i) { const int row = i * 8 + (lane >> 3), ch = lane & 7; const u32x4 v = *(const __attribute__((address_space(3))) u32x4*)(stg + row * 64 + ch * 8); *(u32x4*)(Ow + (size_t)row * OPITCH + ch * 8) = v; }
        asm volatile("s_waitcnt lgkmcnt(0)\n\ts_barrier" ::: "memory");
    } else {
        asm volatile("s_waitcnt lgkmcnt(0)\n\ts_barrier" ::: "memory");
        ATT_LF* X = (ATT_LF*)shm3 + qblk * 32 * XSTR;
        if (sh == 1) {
#pragma unroll
            for (int r = 0; r < 16; ++r)
#pragma unroll
                for (int d0 = 0; d0 < 4; ++d0) X[crow(r, hi) * XSTR + d0 * 32 + r32] = o[d0][r] * rli[r];
        }
        asm volatile("s_waitcnt lgkmcnt(0)\n\ts_barrier" ::: "memory");
        if (sh == 0) {
#pragma unroll
            for (int r = 0; r < 16; ++r)
#pragma unroll
                for (int d0 = 0; d0 < 4; ++d0) { ATT_LF* p = X + crow(r, hi) * XSTR + d0 * 32 + r32; *p = o[d0][r] * rli[r] - *p; }
            asm volatile("s_waitcnt lgkmcnt(0)" ::: "memory");
            const int rowl = lane >> 1, hf = lane & 1;
            float v[64]; float ss = 0.f;
#pragma unroll
            for (int e4 = 0; e4 < 16; ++e4) { const f32x4 x = *(const __attribute__((address_space(3))) f32x4*)(X + rowl * XSTR + hf * 64 + e4 * 4);
                v[e4 * 4 + 0] = x[0]; v[e4 * 4 + 1] = x[1]; v[e4 * 4 + 2] = x[2]; v[e4 * 4 + 3] = x[3]; ss += x[0] * x[0] + x[1] * x[1] + x[2] * x[2] + x[3] * x[3]; }
            ss += __shfl_xor(ss, 1);
            const float rstd = outscale * __builtin_amdgcn_rsqf(ss * (1.0f / 128.0f) + 1e-5f);
            bf16_t* dst = out + (size_t)(U.qrow0 + qblk * 32 + rowl) * OPITCH + U.ocol + hf * 64;
#pragma unroll
            for (int e8 = 0; e8 < 8; ++e8) { const f32x4 g0 = *(const f32x4*)(subg + hf * 64 + e8 * 8), g1 = *(const f32x4*)(subg + hf * 64 + e8 * 8 + 4); u32x4 w;
                w.x = cvtpk(v[e8 * 8 + 0] * rstd * g0[0], v[e8 * 8 + 1] * rstd * g0[1]); w.y = cvtpk(v[e8 * 8 + 2] * rstd * g0[2], v[e8 * 8 + 3] * rstd * g0[3]);
                w.z = cvtpk(v[e8 * 8 + 4] * rstd * g1[0], v[e8 * 8 + 5] * rstd * g1[1]); w.w = cvtpk(v[e8 * 8 + 6] * rstd * g1[2], v[e8 * 8 + 7] * rstd * g1[3]);
                *(u32x4*)(dst + e8 * 8) = w; }
        }
        asm volatile("s_waitcnt lgkmcnt(0)\n\ts_barrier" ::: "memory");
    }
#undef ATT_TILE_ROW
#undef ATT_DMA_STAGE
#undef ATT_USE
#undef ATT_KSLOT
#undef ATT_WAIT_BAR
}
#undef ATT_SBAR
#undef ATT_TRG
#undef ATT_PK
#undef ATT_MM
#undef ATT_LF
}
constexpr int NWAVES = 8;
constexpr int NB = 8, SEQ = 2048, LC = 256, DM = 1024, FF = 4096, NPROJ = 3072;
constexpr int ML = NB * SEQ;
constexpr int MC = NB * LC;
constexpr int MT = ML + MC;
constexpr float NORM_EPS = 1e-6f;

constexpr size_t MiB = 1u << 20;
constexpr size_t WS_CTL = 0, CTL_ZERO_BYTES = 128 * 1024;
constexpr size_t WS_ROWSS1 = 64 * 1024;
constexpr size_t WS_BIAS2 = 1 * MiB + 512 * 1024 + 32 * 1024;
constexpr size_t WS_MADA = 1 * MiB;
constexpr size_t WS_ROPE = 1 * MiB + 512 * 1024;
constexpr size_t WS_LAM  = WS_ROPE + 16384;
constexpr size_t WS_MP = 1 * MiB + 512 * 1024 + 192 * 1024;
constexpr size_t WS_WIN = 2 * MiB, WS_WOUT = 8 * MiB, WS_W1_0 = 10 * MiB, WS_W2_0 = 18 * MiB;
constexpr size_t WS_W1_1 = 26 * MiB, WS_W2_1 = 34 * MiB, WS_WGLU = 42 * MiB;
constexpr size_t WS_SSM_WEND = 2 * MiB;
constexpr size_t WS_SSM_B2 = 10 * MiB;
constexpr size_t WS_HB = 46 * MiB;
constexpr size_t WS_BIG = 82 * MiB;
constexpr size_t WS_SEND = 162 * MiB;
constexpr size_t WS_XC = 226 * MiB;
constexpr size_t WS_H2B = 210 * MiB;
constexpr size_t WS_KD = 254 * MiB;
constexpr size_t WS_END = 256 * MiB;
static_assert(WS_BIG + (size_t)MT * FF * 2 <= WS_XC, "hid fits");
static_assert(WS_SEND + (size_t)64 * 1152 * 256 * 4 <= WS_END, "S_end fits");
static_assert(WS_BIG + (size_t)64 * 1280 * 512 * 2 <= WS_SEND, "A2 fits");

constexpr int RING_BYTES = 131072;
constexpr int LDSCTL_OFF = RING_BYTES, MISC_OFF = LDSCTL_OFF + 320;
constexpr int LDS_BYTES = 147456;

#define GAS __attribute__((address_space(1)))
#define LAS __attribute__((address_space(3)))
typedef unsigned short bf16;
typedef unsigned v4u __attribute__((ext_vector_type(4)));
typedef unsigned v2u __attribute__((ext_vector_type(2)));
typedef float f32x4 __attribute__((ext_vector_type(4)));
typedef GAS unsigned gu32;
#define RLX_AGENT __ATOMIC_RELAXED, __HIP_MEMORY_SCOPE_AGENT
#define LDS_WAIT() asm volatile("s_waitcnt lgkmcnt(0)" ::: "memory")
#define VM_WAIT() asm volatile("s_waitcnt vmcnt(0)" ::: "memory")
__device__ __forceinline__ unsigned f2bf(float f) { unsigned u = __builtin_bit_cast(unsigned, f); return (u + 0x7fffu + ((u >> 16) & 1u)) >> 16; }
__device__ __forceinline__ unsigned pk2(float lo, float hi) { return f2bf(lo) | (f2bf(hi) << 16); }

#define XB_TMO      128
#define XB_XCNT(j)  (256  + 64 * (j))
#define XB_XSUB(j)  (1280 + 64 * (j))
#define XB_XGEN(j)  (2304 + 64 * (j))
#define XB_TOP      3328
#define XB_TOPGEN   3392
#define XCD_BAR_WORDS 3456
#define XB_SPIN_CAP (1u << 18)
__device__ __forceinline__ unsigned xb_ld(unsigned* p)              { return __hip_atomic_load(p, __ATOMIC_RELAXED, __HIP_MEMORY_SCOPE_AGENT); }
__device__ __forceinline__ unsigned xb_add(unsigned* p, unsigned v) { return __hip_atomic_fetch_add(p, v, __ATOMIC_RELAXED, __HIP_MEMORY_SCOPE_AGENT); }
__device__ __forceinline__ unsigned xb_xcc_id() { return (unsigned)__builtin_amdgcn_s_getreg((3 << 11) | 20) & 0xFu; }
#define XB_SPIN(cond, bar) do { unsigned _sp = 0; while (cond) { __builtin_amdgcn_s_sleep(1); \
    if ((++_sp & 255u) == 0u) { if (xb_ld(&(bar)[XB_TMO])) break; if (_sp > XB_SPIN_CAP) { atomicAdd(&(bar)[XB_TMO], 1u); break; } } } } while (0)
struct XcdBarrier { unsigned* bar; unsigned x; volatile LAS unsigned* st; };
__device__ __forceinline__ XcdBarrier xcd_barrier_post(unsigned* bar, volatile LAS unsigned* st) {
    XcdBarrier b; b.bar = bar; b.x = xb_xcc_id(); b.st = st;
    if (threadIdx.x == 0) (void)xb_add(&bar[XB_XCNT(b.x)], 1u);
    return b;
}
__device__ __forceinline__ void xcd_barrier_complete(unsigned* bar, unsigned x, unsigned& nloc, unsigned& nx) {
    const unsigned G = gridDim.x * gridDim.y * gridDim.z;
    unsigned sum, cnt, mine, sp = 0u;
    for (;;) {
        sum = 0u; cnt = 0u; mine = 0u;
#pragma unroll
        for (unsigned j = 0; j < 16; ++j) { const unsigned c = xb_ld(&bar[XB_XCNT(j)]); sum += c; cnt += (c > 0u) ? 1u : 0u; mine = (j == x) ? c : mine; }
        if (sum == G) break;
        __builtin_amdgcn_s_sleep(1);
        if ((++sp & 255u) == 0u) { if (xb_ld(&bar[XB_TMO])) break; if (sp > XB_SPIN_CAP) { atomicAdd(&bar[XB_TMO], 1u); break; } }
    }
    nloc = mine > 0u ? mine : 1u; nx = cnt > 0u ? cnt : 1u;
}
__device__ __forceinline__ void xcd_barrier(const XcdBarrier& b) {
    asm volatile("s_waitcnt vmcnt(0)" ::: "memory");
    __syncthreads();
    if (threadIdx.x == 0) {
        unsigned* bar = b.bar;
        __builtin_amdgcn_s_waitcnt(0);
        unsigned nloc = b.st[0], nx = b.st[1];
        if (nloc == 0u) { xcd_barrier_complete(bar, b.x, nloc, nx); b.st[0] = nloc; b.st[1] = nx; }
        const unsigned k = b.st[2]; b.st[2] = k + 1u;
        const unsigned old = xb_add(&bar[XB_XSUB(b.x)], 1u);
        if (old + 1u == (k + 1u) * nloc) {
            __builtin_amdgcn_fence(__ATOMIC_RELEASE, "agent");
            asm volatile("s_waitcnt vmcnt(0)" ::: "memory");
            (void)xb_add(&bar[XB_TOP], 1u);
        }
        XB_SPIN(xb_ld(&bar[XB_TOP]) < (k + 1u) * nx, bar);
        __builtin_amdgcn_fence(__ATOMIC_ACQUIRE, "agent");
        asm volatile("s_waitcnt vmcnt(0)" ::: "memory");
    }
    __syncthreads();
}

struct Frame {
    LAS unsigned char* lds;
    int vcu, G;
};
__device__ __forceinline__ float wave_sum(float v) {
#pragma unroll
    for (int o = 1; o < 64; o <<= 1) v += __shfl_xor(v, o);
    return v;
}

__device__ __forceinline__ void p0_transpose_item(const float* W, int K, int N, bf16* WT, int radd, LAS float* scr, int item, int lane) {
    const int nblk = N / 64, kb = item / nblk, nb = item % nblk, k0 = 64 * kb, n0 = 64 * nb;
    float v_[64];
    const float* wp = W + (size_t)k0 * N + n0 + lane;
#pragma unroll
    for (int i = 0; i < 64; ++i) v_[i] = __builtin_nontemporal_load(wp + (size_t)i * N);
    LAS unsigned short* t = (LAS unsigned short*)scr;
#pragma unroll
    for (int i = 0; i < 64; ++i) t[i * 66 + lane] = (unsigned short)f2bf(v_[i]);
    LDS_WAIT(); asm volatile("" ::: "memory");
    const int c = lane & 7;
#pragma unroll
    for (int j = 0; j < 8; ++j) { const int n = (lane >> 3) + 8 * j; const LAS unsigned short* s = t + (8 * c) * 66 + n;
        v4u o; o.x = (unsigned)s[0 * 66] | ((unsigned)s[1 * 66] << 16); o.y = (unsigned)s[2 * 66] | ((unsigned)s[3 * 66] << 16); o.z = (unsigned)s[4 * 66] | ((unsigned)s[5 * 66] << 16); o.w = (unsigned)s[6 * 66] | ((unsigned)s[7 * 66] << 16);
        *(GAS v4u*)(WT + (size_t)(radd + n0 + n) * K + k0 + 8 * c) = o; }
    LDS_WAIT(); asm volatile("" ::: "memory");
}

struct Args {
    const float* in[29]; float* out; unsigned char* ws; int pad0, pad1;
};

struct ModVec { f32x4 gm[4], sh[4]; };
__device__ __forceinline__ void load_modvec(ModVec& mv, const float* normg, const float* mrow  , int lane) {
#pragma unroll
    for (int j = 0; j < 4; ++j) { const int c = 4 * lane + 256 * j;
        const f32x4 g = *(const f32x4*)(normg + c), sc = *(const f32x4*)(mrow + 1024 + c); mv.sh[j] = *(const f32x4*)(mrow + c);
        mv.gm[j] = g * (sc + 1.0f); }
}
__device__ __forceinline__ void load_modvec4(ModVec& mv, const float* normg, const float* mp_r  , int lane) {
#pragma unroll
    for (int j = 0; j < 4; ++j) { const int c = 4 * lane + 256 * j;
        f32x4 sh = *(const f32x4*)(mp_r + c), sc = *(const f32x4*)(mp_r + 1024 + c);
#pragma unroll
        for (int q = 1; q < 4; ++q) { sh += *(const f32x4*)(mp_r + q * 9 * 2048 + c); sc += *(const f32x4*)(mp_r + q * 9 * 2048 + 1024 + c); }
        mv.sh[j] = sh; mv.gm[j] = *(const f32x4*)(normg + c) * (sc + 1.0f); }
}
__device__ __forceinline__ void norm_load(const float* xrow, int lane, f32x4 (&v)[4]) {
    const f32x4* xr = (const f32x4*)xrow + lane;
#pragma unroll
    for (int j = 0; j < 4; ++j) v[j] = __builtin_nontemporal_load(xr + 64 * j);
}
__device__ __forceinline__ f32x4 bf4_to_f32(v2u w) { return (f32x4){__uint_as_float(w.x << 16), __uint_as_float(w.x & 0xffff0000u), __uint_as_float(w.y << 16), __uint_as_float(w.y & 0xffff0000u)}; }
__device__ __forceinline__ void norm_load(const bf16* xrow, int lane, f32x4 (&v)[4]) {
#pragma unroll
    for (int j = 0; j < 4; ++j) v[j] = bf4_to_f32(*(const v2u*)(xrow + 4 * lane + 256 * j));
}
template <int NS>
__device__ __forceinline__ f32x4 slab_sum(const bf16* srow, int c) {
    constexpr size_t SS = (size_t)2048 * 1024; f32x4 s = (f32x4){0.f, 0.f, 0.f, 0.f};
#pragma unroll
    for (int i = 0; i < NS; ++i) s += bf4_to_f32(__builtin_nontemporal_load((const v2u*)(srow + i * SS + c)));
    return s;
}
template <int NS>
__device__ __forceinline__ void norm_load_fix(const bf16* brow, const bf16* srow, const float* gate, int lane, f32x4 (&v)[4]) {
#pragma unroll
    for (int j = 0; j < 4; ++j) { const int c = 4 * lane + 256 * j; v[j] = bf4_to_f32(*(const v2u*)(brow + c)) + *(const f32x4*)(gate + c) * slab_sum<NS>(srow, c); }
}
template <int NS>
__device__ __forceinline__ void norm_load_fix(const float* brow, const bf16* srow, const float* gate, int lane, f32x4 (&v)[4]) {
#pragma unroll
    for (int j = 0; j < 4; ++j) { const int c = 4 * lane + 256 * j; v[j] = __builtin_nontemporal_load((const f32x4*)(brow + c)) + *(const f32x4*)(gate + c) * slab_sum<NS>(srow, c); }
}
__device__ __forceinline__ void norm_finish(const f32x4 (&v)[4], const ModVec& mv, f32x4 (&y)[4]) {
    float s = 0.f;
#pragma unroll
    for (int j = 0; j < 4; ++j) s += (v[j].x * v[j].x + v[j].y * v[j].y) + (v[j].z * v[j].z + v[j].w * v[j].w);
    const float rstd = __builtin_amdgcn_rsqf(wave_sum(s) * (1.0f / 1024.0f) + NORM_EPS);
#pragma unroll
    for (int j = 0; j < 4; ++j) y[j] = v[j] * rstd * mv.gm[j] + mv.sh[j];
}

__device__ __forceinline__ void sincos_acc(double ang, float& s, float& c) {
    double rev = ang * 0.15915494309189535; rev -= floor(rev);
    const float r = (float)rev;
    s = __builtin_amdgcn_sinf(r); c = __builtin_amdgcn_cosf(r);
}
enum { I_X = 0, I_C, I_CTX, I_CCTX, I_WADA, I_BADA, I_N1G, I_N2G, I_FG, I_WIN, I_WOUT, I_LQ1, I_LK1, I_LQ2, I_LK2, I_SUBG, I_RPB,
       I_SLRE, I_SLIM, I_SLOG, I_SBRE, I_SBIM, I_SCRE, I_SCIM, I_SD, I_GLUA, I_GLUB, I_W1, I_W2 };

__global__ void __launch_bounds__(NWAVES * 64, 2) fwd_kernel(Args args) {
    extern __shared__ __attribute__((aligned(16))) unsigned char lds[];
    Frame F;
    F.lds = (LAS unsigned char*)lds;
    volatile LAS unsigned* MISC = (volatile LAS unsigned*)(F.lds + MISC_OFF);
    F.G = gridDim.x; { const int bx = blockIdx.x; F.vcu = (F.G % 8 == 0) ? (bx % 8) * (F.G / 8) + bx / 8 : bx; }
    unsigned* barwords; { unsigned char* ws0 = args.ws; barwords = (unsigned*)(ws0 + WS_CTL) + 1024; }
    for (int u = threadIdx.x; u < (LDS_BYTES - LDSCTL_OFF) / 4; u += NWAVES * 64) ((LAS unsigned*)(F.lds + LDSCTL_OFF))[u] = 0u;
    __syncthreads();
    XcdBarrier bar = xcd_barrier_post(barwords, MISC + 8);
#ifdef PROBE_TS
    unsigned long long* tsbuf = (unsigned long long*)(args.ws + 32768);
    int ts_n = 0;
#define TS_STAMP() do { if (blockIdx.x == 0 && threadIdx.x == 0) { tsbuf[ts_n] = __builtin_amdgcn_s_memrealtime(); } ++ts_n; } while (0)
    TS_STAMP();
#define GRID_BAR() do { xcd_barrier(bar); TS_STAMP(); } while (0)
#else
#define GRID_BAR() xcd_barrier(bar)
#endif
    const int NGW = F.G * NWAVES;
#define FRESH_IDS() int tid = threadIdx.x; asm volatile("" : "+v"(tid)); const int lane = tid & 63; const int wave = __builtin_amdgcn_readfirstlane(tid >> 6); const int gw = F.vcu * NWAVES + wave; (void)lane; (void)gw

    typedef const float* const __attribute__((address_space(4)))* ArgTab;
#define PHASE_ENV() unsigned long long kap_ = (unsigned long long)__builtin_amdgcn_kernarg_segment_ptr(); asm volatile("" : "+s"(kap_)); const ArgTab atab_ = (ArgTab)kap_; \
        unsigned char* ws = (unsigned char*)atab_[30]; bf16* xl = (bf16*)atab_[29]; float* outf = (float*)atab_[29]; const float* x_in = atab_[I_X]; const float* ctx_in = atab_[I_CTX]; \
        bf16* xc = (bf16*)(ws + WS_XC); float* mada = (float*)(ws + WS_MADA); float* rope = (float*)(ws + WS_ROPE); float* lamp = (float*)(ws + WS_LAM); \
        bf16* HB = (bf16*)(ws + WS_HB); bf16* BIG = (bf16*)(ws + WS_BIG); \
        (void)xl; (void)outf; (void)x_in; (void)ctx_in; (void)xc; (void)mada; (void)rope; (void)lamp; (void)HB; (void)BIG
#define AIN(i) (atab_[i])
#define SLAB7 (xl + (size_t)ML * 1024)
#define ADALN_ITEM(L_, CG_) do { const int l = (L_), cg = (CG_); \
            LAS float* act = (LAS float*)F.lds;                 \
            LAS float* red = (LAS float*)(F.lds + 36864);       \
            const float* c = AIN(I_C); const float* cc = AIN(I_CCTX); \
            for (int i = tid; i < 9216; i += 512) { const float v = (i < 8192) ? c[i] : cc[i - 8192]; act[i] = v / (1.0f + __expf(-v)); } \
            __syncthreads(); \
            const float* W = AIN(I_WADA) + (size_t)l * 1024 * 6144 + cg * 64 + lane; \
            float acc[9]; \
            _Pragma("unroll") for (int r = 0; r < 9; ++r) acc[r] = 0.f; \
            const int k0 = wave * 128; \
            for (int k4 = 0; k4 < 128; k4 += 32) { float wv[32]; \
                _Pragma("unroll") for (int i = 0; i < 32; ++i) wv[i] = __builtin_nontemporal_load(W + (size_t)(k0 + k4 + i) * 6144); \
                _Pragma("unroll") for (int i = 0; i < 32; ++i) \
                    _Pragma("unroll") for (int r = 0; r < 9; ++r) acc[r] += act[r * 1024 + k0 + k4 + i] * wv[i]; } \
            _Pragma("unroll") for (int r = 0; r < 9; ++r) red[(wave * 9 + r) * 64 + lane] = acc[r]; \
            __syncthreads(); \
            for (int i = tid; i < 576; i += 512) { const int r = i / 64, cl = i % 64; float s_ = AIN(I_BADA)[l * 6144 + cg * 64 + cl]; \
                _Pragma("unroll") for (int w = 0; w < 8; ++w) s_ += red[(w * 9 + r) * 64 + cl]; \
                mada[(l * 9 + r) * 6144 + cg * 64 + cl] = s_; } \
            __syncthreads(); } while (0)
#define ADALN_QITEM(CG_, KQ_) do { const int cg = (CG_), kq = (KQ_); \
            LAS float* act = (LAS float*)F.lds;                 \
            LAS float* red = (LAS float*)(F.lds + 36864);       \
            const float* c = AIN(I_C); const float* cc = AIN(I_CCTX); \
            for (int i = tid; i < 9 * 256; i += 512) { const int r = i >> 8, k = kq * 256 + (i & 255); const float v = (r < 8) ? c[r * 1024 + k] : cc[k]; act[i] = v / (1.0f + __expf(-v)); } \
            __syncthreads(); \
            const float* W = AIN(I_WADA) + cg * 64 + lane; \
            float acc[9]; \
            _Pragma("unroll") for (int r = 0; r < 9; ++r) acc[r] = 0.f; \
            const int kl = wave * 32; \
            { float wv[32]; \
                _Pragma("unroll") for (int i = 0; i < 32; ++i) wv[i] = __builtin_nontemporal_load(W + (size_t)(kq * 256 + kl + i) * 6144); \
                _Pragma("unroll") for (int i = 0; i < 32; ++i) \
                    _Pragma("unroll") for (int r = 0; r < 9; ++r) acc[r] += act[r * 256 + kl + i] * wv[i]; } \
            _Pragma("unroll") for (int r = 0; r < 9; ++r) red[(wave * 9 + r) * 64 + lane] = acc[r]; \
            __syncthreads(); \
            for (int i = tid; i < 576; i += 512) { const int r = i / 64, cl = i % 64; float s_ = (kq == 0) ? AIN(I_BADA)[cg * 64 + cl] : 0.f; \
                _Pragma("unroll") for (int w = 0; w < 8; ++w) s_ += red[(w * 9 + r) * 64 + cl]; \
                ((float*)(ws + WS_MP))[(kq * 9 + r) * 2048 + cg * 64 + cl] = s_; } \
            __syncthreads(); } while (0)
#define KD_ITEM(G_, LQ_) do { const int g = (G_), lq = (LQ_); \
            LAS float* apr = (LAS float*)F.lds;                 \
            LAS float* api = apr + 512; \
            LAS float* bbr = api + 512;                         \
            LAS float* bbi = bbr + 2048; \
            LAS float* Cr = bbi + 2048;                         \
            LAS float* Ci = Cr + 2048; \
            { const int d = tid >> 8, jj = (tid >> 6) & 3, p = tid & 63; const int gp = (d * 64 + g) * 64 + p; \
                const float lr = AIN(I_SLRE)[gp], li = AIN(I_SLIM)[gp]; const float delta = expf(AIN(I_SLOG)[d * 64 + g]); \
                const f32x4 br4 = *(const f32x4*)(AIN(I_SBRE) + (size_t)gp * 16 + 4 * jj), bi4 = *(const f32x4*)(AIN(I_SBIM) + (size_t)gp * 16 + 4 * jj); \
                { const int j = 4 * lq + jj; const float mag = expf(lr * delta * (float)j); float sn, cs; sincos_acc((double)li * (double)delta * (double)j, sn, cs); \
                    apr[(d * 4 + jj) * 64 + p] = mag * cs; api[(d * 4 + jj) * 64 + p] = mag * sn; } \
                float sn1, cs1; sincos_acc((double)li * (double)delta, sn1, cs1); const float mag1 = expf(lr * delta); \
                const float ar = mag1 * cs1, ai = mag1 * sn1; \
                const float den = lr * lr + li * li, nr = ar - 1.0f; const float cr = (nr * lr + ai * li) / den, ci = (ai * lr - nr * li) / den; \
                f32x4 or_, oi_; \
                _Pragma("unroll") for (int e = 0; e < 4; ++e) { or_[e] = cr * br4[e] - ci * bi4[e]; oi_[e] = cr * bi4[e] + ci * br4[e]; } \
                *(LAS f32x4*)(bbr + (d * 64 + p) * 16 + 4 * jj) = or_; *(LAS f32x4*)(bbi + (d * 64 + p) * 16 + 4 * jj) = oi_; } \
            for (int i = tid; i < 2048; i += 512) { const int d = i >> 10, h = (i >> 6) & 15, p = i & 63; \
                Cr[i] = AIN(I_SCRE)[((size_t)(d * 64 + g) * 16 + h) * 64 + p]; Ci[i] = AIN(I_SCIM)[((size_t)(d * 64 + g) * 16 + h) * 64 + p]; } \
            __syncthreads(); \
            { const int d = tid >> 8, jj = (tid >> 6) & 3, h = (tid >> 2) & 15, hq = tid & 3;     \
                float s0 = 0.f, s1 = 0.f, s2 = 0.f, s3 = 0.f; \
                for (int p = 0; p < 64; ++p) { const float ar = apr[(d * 4 + jj) * 64 + p], ai = api[(d * 4 + jj) * 64 + p]; const float cr = Cr[(d * 16 + h) * 64 + p], ci = Ci[(d * 16 + h) * 64 + p]; \
                    const float wr_ = cr * ar - ci * ai, wi_ = cr * ai + ci * ar;              \
                    const f32x4 br = *(const LAS f32x4*)(bbr + (d * 64 + p) * 16 + 4 * hq), bi = *(const LAS f32x4*)(bbi + (d * 64 + p) * 16 + 4 * hq); \
                    s0 += wr_ * br[0] - wi_ * bi[0]; s1 += wr_ * br[1] - wi_ * bi[1]; s2 += wr_ * br[2] - wi_ * bi[2]; s3 += wr_ * br[3] - wi_ * bi[3]; } \
                float* kd = (float*)(ws + WS_KD) + ((((size_t)g * 2 + d) * 16 + (4 * lq + jj)) * 16 + h) * 16 + 4 * hq; \
                *(f32x4*)kd = (f32x4){s0, s1, s2, s3}; } \
            __syncthreads(); } while (0)

    { PHASE_ENV();
        FRESH_IDS();
        for (int it = F.vcu; it < 128; it += F.G) ADALN_QITEM(it >> 2, it & 3);
        if (F.vcu == 128 % F.G) {
            for (int i = tid; i < 1024; i += 512) { const int pos = i >> 4, j = i & 15; const float inv = exp2f(-(float)j * (13.287712379549449f / 16.0f)); const float ang = (float)pos * inv;
                float sn, cs; sincos_acc((double)ang, sn, cs); rope[i] = cs; rope[1024 + i] = sn; }
            if (tid == 0) { float s1 = 0.f, s2 = 0.f;
                for (int i = 0; i < 64; ++i) { s1 += AIN(I_LQ1)[i] * AIN(I_LK1)[i]; s2 += AIN(I_LQ2)[i] * AIN(I_LK2)[i]; }
                lamp[0] = expf(s1) - expf(s2) + 0.2f; }
        }
        LAS float* scr = (LAS float*)(F.lds + 57344 + wave * 8448);
        constexpr int I_A = 16 * 48;
        for (int it = gw; it < I_A; it += NGW) p0_transpose_item(AIN(I_WIN), 1024, 3072, (bf16*)(ws + WS_WIN), 0, scr, it, lane);
    }
    GRID_BAR();

#define NORM_ROW_OF(q) ((q) < perl ? (((q) < nl_) ? gw * perl + (q) : -1) : ((((q) - perl) < nc_) ? ML + gw * perc + ((q) - perl) : -1))
#define NORM_TO_HB(LAYER, WHICH, NORMG_IDX, SRC_L, SRC_C, NROWS, SLABS, GATE, XCOUT, LATROWS) do { PHASE_ENV(); FRESH_IDS(); \
        const int latn_ = (LATROWS);        \
        const int perl = (latn_ + NGW - 1) / NGW, perc = ((NROWS) > ML) ? (MC + NGW - 1) / NGW : 0; \
        const int nl_ = (latn_ - gw * perl) < perl ? ((latn_ - gw * perl) > 0 ? (latn_ - gw * perl) : 0) : perl; \
        const int nc_ = perc ? ((MC - gw * perc) < perc ? ((MC - gw * perc) > 0 ? (MC - gw * perc) : 0) : perc) : 0; \
        int cur_r = -1; ModVec mv; const bf16* slabs_ = (SLABS); bf16* xcout_ = (XCOUT); \
        for (int q0 = 0; q0 < perl + perc; q0 += 3) { f32x4 v[3][4]; \
            _Pragma("unroll") for (int u = 0; u < 3; ++u) { const int row = (q0 + u < perl + perc) ? NORM_ROW_OF(q0 + u) : -1; if (row >= 0) { \
                if (row < ML) norm_load((SRC_L) + (size_t)row * 1024, lane, v[u]); \
                else if (slabs_) { norm_load_fix<4>((SRC_C) + (size_t)(row - ML) * 1024, slabs_ + (size_t)(row - ML) * 1024, (GATE), lane, v[u]); \
                    if (xcout_) { _Pragma("unroll") for (int j = 0; j < 4; ++j) { v2u w_; w_.x = pk2(v[u][j].x, v[u][j].y); w_.y = pk2(v[u][j].z, v[u][j].w); *(v2u*)(xcout_ + (size_t)(row - ML) * 1024 + 4 * lane + 256 * j) = w_; } } } \
                else norm_load((SRC_C) + (size_t)(row - ML) * 1024, lane, v[u]); } } \
            _Pragma("unroll") for (int u = 0; u < 3; ++u) { const int row = (q0 + u < perl + perc) ? NORM_ROW_OF(q0 + u) : -1; if (row >= 0) { const int r = row < ML ? (row >> 11) : 8; \
                if (r != cur_r) { if ((LAYER) == 0 && (WHICH) == 0) load_modvec4(mv, atab_[NORMG_IDX], (const float*)(ws + WS_MP) + r * 2048, lane); \
                    else load_modvec(mv, atab_[NORMG_IDX] + (LAYER) * 1024, mada + ((LAYER) * 9 + r) * 6144 + (WHICH) * 3072, lane); cur_r = r; } \
                f32x4 y[4]; norm_finish(v[u], mv, y); \
                GAS unsigned long long* o8 = (GAS unsigned long long*)(HB + (size_t)row * 1024) + lane; \
                _Pragma("unroll") for (int j = 0; j < 4; ++j) o8[64 * j] = (unsigned long long)pk2(y[j].x, y[j].y) | ((unsigned long long)pk2(y[j].z, y[j].w) << 32); } } } \
    } while (0)
    NORM_TO_HB(0, 0, I_N1G, x_in, ctx_in, MT, (const bf16*)nullptr, mada, (bf16*)nullptr, ML);
    GRID_BAR();

    { PHASE_ENV();
        pg8::Gemm g{HB, (const bf16*)(ws + WS_WIN), 1024, 1024, 1024}; pg8::StaticOrder S; S.init(MT, NPROJ, F.G, (int)blockIdx.x);
        LAS float* ropel = (LAS float*)(F.lds + 132096);
        for (int i = threadIdx.x; i < 2048; i += NWAVES * 64) ropel[i] = rope[i];
        __syncthreads();
        pg8::EpiInProj E{BIG, ropel};
        pg8::gemm_phase<pg8::EpiInProj, pg8::StaticOrder, true>(F.lds, g, S, E);
        const int nfull = (MT / 256) * (NPROJ / 256) - (((MT / 256) * (NPROJ / 256)) / F.G) * F.G;
        if ((int)blockIdx.x >= nfull) {
            FRESH_IDS();
            const int tb = (int)blockIdx.x - nfull, ntb = F.G - nfull;
            __syncthreads();
            for (int it = tb; it < 160; it += ntb) { const int l_ = it < 64 ? 0 : 1, cg_ = it < 64 ? 32 + it : it - 64; ADALN_ITEM(l_, cg_); }
            const int cw = tb * NWAVES + wave, ncw = ntb * NWAVES;
            LAS float* scr = (LAS float*)(F.lds + 57344 + wave * 8448);
            constexpr int I_B = 16 * 16, I_C1 = 16 * 64;
            constexpr int NITEMS = I_B + I_C1;
            for (int it = cw; it < NITEMS; it += ncw) {
                int r = it;
                if (r < I_B) { p0_transpose_item(AIN(I_WOUT), 1024, 1024, (bf16*)(ws + WS_WOUT), 0, scr, r, lane); continue; } r -= I_B;
                p0_transpose_item(AIN(I_W1) + (size_t)1024 * 4096, 1024, 4096, (bf16*)(ws + WS_W1_1), 0, scr, r, lane);
            }
        }
    }
    GRID_BAR();

#ifdef ATT_XM
    { PHASE_ENV();
        const float lam = lamp[0];
        const float* subg = AIN(I_SUBG); const float* rpb = AIN(I_RPB);
        const int v = F.vcu;
        att::lds_u8* shm = (att::lds_u8*)F.lds;
        const int nG = F.G;
#define ATT_FOR_UNITS(NUNITS, PERCU, IDEXPR) for (int k_ = 0; k_ < ((nG == 256) ? (PERCU) : ((NUNITS) + nG - 1) / nG); ++k_) { const int id = (nG == 256) ? (IDEXPR) : (k_ * nG + v); if (id < 0 || id >= (NUNITS)) continue;
        const int xq = v >> 5, iq = v & 31;
        const bool edge = ((iq & 7) == 0) || ((iq & 7) == 7); const int eidx = (iq >> 3) * 2 + ((iq & 7) == 7 ? 1 : 0), midx = (iq >> 3) * 6 + (iq & 7) - 1;
        ATT_FOR_UNITS(512, 2, ((xq * 4 + 2 * k_ + (iq >> 4)) * 16 + (iq & 15)))
            const int b = id >> 6, h = (id >> 4) & 3, qb = id & 15;
            att::UnitDesc U; U.qrow0 = b * 2048 + qb * 128; U.qcol = h * 128; U.kcol = 512 + h * 128; U.vcol = 1024 + h * 128;
            U.latrow = b * 2048; U.t0 = 0; U.nlat = 32; U.ctxrow = ML + b * 256; U.ocol = h * 128; U.r0 = 0; U.head = 0;
            att::attn_unit<true, false, ATT_XM>(U, BIG, HB, shm, rpb, subg, lam, 0.8f);
        }
        ATT_FOR_UNITS(512, 2, ((xq * 8 + 4 * k_ + (iq >> 3)) * 8 + (iq & 7)))
            const int b = id >> 6, h = (id >> 3) & 7, rq = id & 7;
            const int ra = 4 * rq, rb_ = 4 * rq + 3; const int rsa = ra < 4 ? 0 : (ra > 28 ? 24 : ra - 4), rsb = rb_ < 4 ? 0 : (rb_ > 28 ? 24 : rb_ - 4);
            att::UnitDesc U; U.qrow0 = b * 2048 + rq * 256; U.qcol = 1536 + h * 64; U.kcol = 2048 + h * 64; U.vcol = 2560 + h * 64;
            U.latrow = b * 2048; U.t0 = rsa; U.nlat = rsb + 7 - rsa + 1; U.ctxrow = ML + b * 256; U.ocol = 512 + h * 64; U.r0 = ra; U.head = h;
            att::attn_unit<false, true, ATT_XM>(U, BIG, HB, shm, rpb, subg, lam, 1.0f);
        }
        ATT_FOR_UNITS(64, 1, (edge ? xq * 8 + eidx : -1))
            const int b = id >> 3, h = (id >> 1) & 3, hf = id & 1;
            att::UnitDesc U; U.qrow0 = ML + b * 256 + hf * 128; U.qcol = h * 128; U.kcol = 512 + h * 128; U.vcol = 1024 + h * 128;
            U.latrow = 0; U.t0 = 0; U.nlat = 0; U.ctxrow = ML + b * 256; U.ocol = h * 128; U.r0 = 0; U.head = 0;
            att::attn_unit<true, false, ATT_XM>(U, BIG, HB, shm, rpb, subg, lam, 0.8f);
        }
        ATT_FOR_UNITS(64, 1, (edge ? xq * 8 + eidx : -1))
            const int b = id >> 3, h = id & 7;
            att::UnitDesc U; U.qrow0 = ML + b * 256; U.qcol = 1536 + h * 64; U.kcol = 2048 + h * 64; U.vcol = 2560 + h * 64;
            U.latrow = 0; U.t0 = 0; U.nlat = 0; U.ctxrow = ML + b * 256; U.ocol = 512 + h * 64; U.r0 = 0; U.head = 0;
            att::attn_unit<false, false, ATT_XM>(U, BIG, HB, shm, rpb, subg, lam, 1.0f);
        }
        {
            FRESH_IDS();
            const bool sel = (nG == 256) ? !edge : true;
            if (sel) { const int tb = (nG == 256) ? (xq * 24 + midx) : v, ntb = (nG == 256) ? 192 : nG;
                __syncthreads();
                LAS float* scr = (LAS float*)(F.lds + 57344 + wave * 8448);
                for (int it = tb * NWAVES + wave; it < 16 * 64; it += ntb * NWAVES) p0_transpose_item(AIN(I_W1), 1024, 4096, (bf16*)(ws + WS_W1_0), 0, scr, it, lane); }
        }
#undef ATT_FOR_UNITS
    }
    GRID_BAR();

#endif
    { PHASE_ENV();
        const float lam = lamp[0];
        const float* subg = AIN(I_SUBG); const float* rpb = AIN(I_RPB);
        const int v = F.vcu;
        att::lds_u8* shm = (att::lds_u8*)F.lds;
        const int nG = F.G;
#define ATT_FOR_UNITS(NUNITS, PERCU, IDEXPR) for (int k_ = 0; k_ < ((nG == 256) ? (PERCU) : ((NUNITS) + nG - 1) / nG); ++k_) { const int id = (nG == 256) ? (IDEXPR) : (k_ * nG + v); if (id < 0 || id >= (NUNITS)) continue;
        const int xq = v >> 5, iq = v & 31;
        const bool edge = ((iq & 7) == 0) || ((iq & 7) == 7); const int eidx = (iq >> 3) * 2 + ((iq & 7) == 7 ? 1 : 0), midx = (iq >> 3) * 6 + (iq & 7) - 1;
        ATT_FOR_UNITS(512, 2, ((xq * 4 + 2 * k_ + (iq >> 4)) * 16 + (iq & 15)))
            const int b = id >> 6, h = (id >> 4) & 3, qb = id & 15;
            att::UnitDesc U; U.qrow0 = b * 2048 + qb * 128; U.qcol = h * 128; U.kcol = 512 + h * 128; U.vcol = 1024 + h * 128;
            U.latrow = b * 2048; U.t0 = 0; U.nlat = 32; U.ctxrow = ML + b * 256; U.ocol = h * 128; U.r0 = 0; U.head = 0;
            att::attn_unit<true, false>(U, BIG, HB, shm, rpb, subg, lam, 0.8f);
        }
        ATT_FOR_UNITS(512, 2, ((xq * 8 + 4 * k_ + (iq >> 3)) * 8 + (iq & 7)))
            const int b = id >> 6, h = (id >> 3) & 7, rq = id & 7;
            const int ra = 4 * rq, rb_ = 4 * rq + 3; const int rsa = ra < 4 ? 0 : (ra > 28 ? 24 : ra - 4), rsb = rb_ < 4 ? 0 : (rb_ > 28 ? 24 : rb_ - 4);
            att::UnitDesc U; U.qrow0 = b * 2048 + rq * 256; U.qcol = 1536 + h * 64; U.kcol = 2048 + h * 64; U.vcol = 2560 + h * 64;
            U.latrow = b * 2048; U.t0 = rsa; U.nlat = rsb + 7 - rsa + 1; U.ctxrow = ML + b * 256; U.ocol = 512 + h * 64; U.r0 = ra; U.head = h;
            att::attn_unit<false, true>(U, BIG, HB, shm, rpb, subg, lam, 1.0f);
        }
        ATT_FOR_UNITS(64, 1, (edge ? xq * 8 + eidx : -1))
            const int b = id >> 3, h = (id >> 1) & 3, hf = id & 1;
            att::UnitDesc U; U.qrow0 = ML + b * 256 + hf * 128; U.qcol = h * 128; U.kcol = 512 + h * 128; U.vcol = 1024 + h * 128;
            U.latrow = 0; U.t0 = 0; U.nlat = 0; U.ctxrow = ML + b * 256; U.ocol = h * 128; U.r0 = 0; U.head = 0;
            att::attn_unit<true, false>(U, BIG, HB, shm, rpb, subg, lam, 0.8f);
        }
        ATT_FOR_UNITS(64, 1, (edge ? xq * 8 + eidx : -1))
            const int b = id >> 3, h = id & 7;
            att::UnitDesc U; U.qrow0 = ML + b * 256; U.qcol = 1536 + h * 64; U.kcol = 2048 + h * 64; U.vcol = 2560 + h * 64;
            U.latrow = 0; U.t0 = 0; U.nlat = 0; U.ctxrow = ML + b * 256; U.ocol = 512 + h * 64; U.r0 = 0; U.head = 0;
            att::attn_unit<false, false>(U, BIG, HB, shm, rpb, subg, lam, 1.0f);
        }
        {
            FRESH_IDS();
            const bool sel = (nG == 256) ? !edge : true;
            if (sel) { const int tb = (nG == 256) ? (xq * 24 + midx) : v, ntb = (nG == 256) ? 192 : nG;
                __syncthreads();
                LAS float* scr = (LAS float*)(F.lds + 57344 + wave * 8448);
                for (int it = tb * NWAVES + wave; it < 16 * 64; it += ntb * NWAVES) p0_transpose_item(AIN(I_W1), 1024, 4096, (bf16*)(ws + WS_W1_0), 0, scr, it, lane); }
        }
#undef ATT_FOR_UNITS
    }
    GRID_BAR();

    { PHASE_ENV();
        pg8::Gemm g{HB, (const bf16*)(ws + WS_WOUT), 1024, 1024, 1024}; pg8::SplitOrder S; S.init(F.G, (int)blockIdx.x, 1024, 2);
        if (F.G == 256) {
            { pg8::StaticOrder SL; SL.init(ML, DM, F.G, (int)blockIdx.x);
              pg8::EpiResidNorm E{x_in, xl, mada + 2048, HB, AIN(I_N2G), mada + 3072, (float*)(ws + WS_MP), (unsigned*)(ws + 2304), (LAS float*)(F.lds + 132096)};
              pg8::gemm_phase<pg8::EpiResidNorm, pg8::StaticOrder, true>(F.lds, g, SL, E); }
            { pg8::CtxSliceOrder SC{F.G, (int)blockIdx.x, 16, 2};
              pg8::EpiSlab E{(bf16*)BIG};
              pg8::gemm_phase<pg8::EpiSlab, pg8::CtxSliceOrder, true>(F.lds, g, SC, E); }
        } else {
            pg8::EpiResid<true> E{x_in, ctx_in, xl, xc, mada + 2048, (bf16*)BIG};
            pg8::gemm_phase<pg8::EpiResid<true>, pg8::SplitOrder, true>(F.lds, g, S, E);
        }
        const int nfull = 384 - (384 / F.G) * F.G;
        if ((int)blockIdx.x >= nfull) {
            FRESH_IDS();
            LAS float* scr = (LAS float*)(F.lds + 57344 + wave * 8448);
            constexpr int I_G = 16 * 16;
            for (int it = ((int)blockIdx.x - nfull) * NWAVES + wave; it < 2 * I_G; it += (F.G - nfull) * NWAVES) {
                const bool isb = it >= I_G; const int rr = isb ? it - I_G : it; const int n0 = 64 * (rr % 16); const int radd = 256 * (n0 / 128) + (n0 % 128) - n0 + (isb ? 128 : 0);
                p0_transpose_item(isb ? AIN(I_GLUB) : AIN(I_GLUA), 1024, 1024, (bf16*)(ws + WS_WGLU), radd, scr, rr, lane); }
        }
    }
    GRID_BAR();
    NORM_TO_HB(0, 1, I_N2G, xl, ctx_in, MT, (const bf16*)BIG, mada + 8 * 6144 + 2048, xc, (F.G == 256) ? 0 : ML);
    GRID_BAR();
    { PHASE_ENV();
        pg8::Gemm g{HB, (const bf16*)(ws + WS_W1_0), 1024, 1024, 1024}; pg8::StaticOrder S; S.init(MT, FF, F.G, (int)blockIdx.x);
        pg8::EpiRelu2<false> E{BIG, FF, nullptr, nullptr};
        pg8::gemm_phase<pg8::EpiRelu2<false>, pg8::StaticOrder, true>(F.lds, g, S, E);
        const int nfull = (MT / 256) * (FF / 256) - (((MT / 256) * (FF / 256)) / F.G) * F.G;
        if ((int)blockIdx.x >= nfull) {
            FRESH_IDS();
            const int tb = (int)blockIdx.x - nfull, ntb = F.G - nfull;
            __syncthreads();
            for (int it = tb; it < 256; it += ntb) KD_ITEM(it >> 2, it & 3);
            const int cw = tb * NWAVES + wave, ncw = ntb * NWAVES;
            LAS float* scr = (LAS float*)(F.lds + 57344 + wave * 8448);
            for (int it = cw; it < 64 * 16; it += ncw) p0_transpose_item(AIN(I_W2), 4096, 1024, (bf16*)(ws + WS_W2_0), 0, scr, it, lane);
        }
    }
    GRID_BAR();
    { PHASE_ENV();
        pg8::Gemm g{BIG, (const bf16*)(ws + WS_W2_0), FF, FF, FF}; pg8::SplitOrder S; S.init(F.G, (int)blockIdx.x, FF, 3);
        if (F.G == 256) {
            { pg8::StaticOrder SL; SL.init(ML, DM, F.G, (int)blockIdx.x, FF);
              pg8::EpiResidNormA E{xl, xl, mada + 5120, (bf16*)(ws + WS_HB), AIN(I_N1G) + 1024, mada + 9 * 6144, (float*)(ws + WS_MP), (unsigned*)(ws + 2560), (LAS float*)(F.lds + 132096)};
              pg8::gemm_phase<pg8::EpiResidNormA, pg8::StaticOrder, true>(F.lds, g, SL, E); }
            { pg8::CtxSliceOrder SC{F.G, (int)blockIdx.x, 64, 3};
              pg8::EpiSlab E{SLAB7};
              pg8::gemm_phase<pg8::EpiSlab, pg8::CtxSliceOrder, true>(F.lds, g, SC, E); }
        } else {
            pg8::EpiResid<false> E{xl, xc, xl, xc, mada + 5120, SLAB7};
            pg8::gemm_phase<pg8::EpiResid<false>, pg8::SplitOrder, true>(F.lds, g, S, E);
        }
    }
    GRID_BAR();

#define AUL HB
#define AUC ((bf16*)(ws + 230 * MiB))
#define ACR ((bf16*)(ws + WS_BIG + 32 * MiB))
#define ZB BIG
#define X3A ((bf16*)(ws + 2 * MiB))
#define X3B ((bf16*)(ws + 242 * MiB) - (size_t)12288 * 1024)
#define SEND ((bf16*)(ws + WS_SEND))
    { PHASE_ENV();
        FRESH_IDS();
        v2u rawn[2][4], rawm[2][4];
#define P8_ROW0(ci_) (((ci_) >> 7) * 2048 + ((ci_) & 127) * 16)
        const int ci0 = (F.G == 256) ? 1024 + F.vcu : F.vcu;
        if (ci0 < 1024) {
#pragma unroll
            for (int u = 0; u < 2; ++u)
#pragma unroll
                for (int j = 0; j < 4; ++j) rawn[u][j] = *(const v2u*)(xl + (size_t)(P8_ROW0(ci0) + 2 * wave + u) * 1024 + 4 * lane + 256 * j); }
        if (ci0 + F.G < 1024) {
#pragma unroll
            for (int u = 0; u < 2; ++u)
#pragma unroll
                for (int j = 0; j < 4; ++j) rawm[u][j] = *(const v2u*)(xl + (size_t)(P8_ROW0(ci0 + F.G) + 2 * wave + u) * 1024 + 4 * lane + 256 * j); }
        f32x4 vpre[2][4]; ModVec mvpre; const bool haspre = (ci0 >= 1024 && ci0 < 1152);
        if (haspre) { const int row0 = (ci0 - 1024) * 16;
#pragma unroll
            for (int u = 0; u < 2; ++u) norm_load_fix<8>(xc + (size_t)(row0 + 2 * wave + u) * 1024, (const bf16*)SLAB7 + (size_t)(row0 + 2 * wave + u) * 1024, mada + 8 * 6144 + 5120, lane, vpre[u]);
            load_modvec(mvpre, AIN(I_N1G) + 1024, mada + (9 + 8) * 6144, lane); }
        {
            const int g = F.vcu >> 2, q = F.vcu & 3;
            LAS float* apr = (LAS float*)F.lds;
            LAS float* api = apr + 2 * 17 * 64;
            LAS float* bbr = api + 2 * 17 * 64;
            LAS float* bbi = bbr + 2 * 64 * 16;
            LAS float* Cr = bbi + 2 * 64 * 16;
            LAS float* Ci = Cr + 2 * 16 * 64;
            LAS float* Kd = Ci + 2 * 16 * 64;
            { const float* Kg = (const float*)(ws + WS_KD) + (size_t)g * 2 * 16 * 256;
#pragma unroll
              for (int i = 0; i < 4; ++i) *(LAS f32x4*)(Kd + (tid + 512 * i) * 4) = *(const f32x4*)(Kg + (tid + 512 * i) * 4); }
            { const int d = tid >> 8, jq = (tid >> 6) & 3, p = tid & 63; const int gp = (d * 64 + g) * 64 + p;
                const float lr = AIN(I_SLRE)[gp], li = AIN(I_SLIM)[gp]; const float delta = expf(AIN(I_SLOG)[d * 64 + g]);
                const f32x4 br4 = *(const f32x4*)(AIN(I_SBRE) + (size_t)gp * 16 + 4 * jq), bi4 = *(const f32x4*)(AIN(I_SBIM) + (size_t)gp * 16 + 4 * jq);
#pragma unroll
                for (int jj = 0; jj < 5; ++jj) { const int j = jq + 4 * jj; if (j <= 16) { const float mag = expf(lr * delta * (float)j); float sn, cs; sincos_acc((double)li * (double)delta * (double)j, sn, cs);
                    apr[(d * 17 + j) * 64 + p] = mag * cs; api[(d * 17 + j) * 64 + p] = mag * sn; } }
                float sn1, cs1; sincos_acc((double)li * (double)delta, sn1, cs1); const float mag1 = expf(lr * delta);
                const float ar = mag1 * cs1, ai = mag1 * sn1;
                const float den = lr * lr + li * li, nr = ar - 1.0f; const float cr = (nr * lr + ai * li) / den, ci = (ai * lr - nr * li) / den;
                f32x4 or_, oi_;
#pragma unroll
                for (int e = 0; e < 4; ++e) { or_[e] = cr * br4[e] - ci * bi4[e]; oi_[e] = cr * bi4[e] + ci * br4[e]; }
                *(LAS f32x4*)(bbr + (d * 64 + p) * 16 + 4 * jq) = or_; *(LAS f32x4*)(bbi + (d * 64 + p) * 16 + 4 * jq) = oi_; }
            for (int i = tid; i < 2048; i += 512) { const int d = i >> 10, h = (i >> 6) & 15, p = i & 63;
                Cr[i] = AIN(I_SCRE)[((size_t)(d * 64 + g) * 16 + h) * 64 + p]; Ci[i] = AIN(I_SCIM)[((size_t)(d * 64 + g) * 16 + h) * 64 + p]; }
            __syncthreads();
            bf16* B2 = (bf16*)(ws + WS_SSM_B2) + (size_t)g * 256 * 512;
            for (int i = tid; i < 64 * 64; i += 512) { const int row = 64 * q + (i >> 6), c8 = (i & 63) * 8; const int t = row >> 4, h = row & 15;
                f32x4 v0, v1;
                if (c8 < 256) { const int k = c8 >> 4, hp0 = c8 & 15; v0 = (f32x4){0.f, 0.f, 0.f, 0.f}; v1 = v0;
                    if (k <= t) { const LAS float* kp = Kd + ((0 * 16 + (t - k)) * 16 + h) * 16 + hp0; v0 += *(const LAS f32x4*)kp; v1 += *(const LAS f32x4*)(kp + 4); }
                    if (k >= t) { const LAS float* kp = Kd + ((1 * 16 + (k - t)) * 16 + h) * 16 + hp0; v0 += *(const LAS f32x4*)kp; v1 += *(const LAS f32x4*)(kp + 4); }
                    if (k == t && (h >> 3) == (hp0 >> 3)) { const float dsk = AIN(I_SD)[g * 16 + h];
#pragma unroll
                        for (int e = 0; e < 4; ++e) { if ((h & 7) == e) v0[e] += dsk; if ((h & 7) == 4 + e) v1[e] += dsk; } } }
                else { const int qq = c8 - 256; const int d = qq >> 7, im = (qq >> 6) & 1, p0 = qq & 63; const int j = d == 0 ? t + 1 : 16 - t;
                    const LAS float* ap = apr + (d * 17 + j) * 64 + p0; const LAS float* aq = api + (d * 17 + j) * 64 + p0; const LAS float* cp_ = Cr + (d * 16 + h) * 64 + p0; const LAS float* cq = Ci + (d * 16 + h) * 64 + p0;
                    const f32x4 ar0 = *(const LAS f32x4*)ap, ar1 = *(const LAS f32x4*)(ap + 4), ai0 = *(const LAS f32x4*)aq, ai1 = *(const LAS f32x4*)(aq + 4);
                    const f32x4 cr0 = *(const LAS f32x4*)cp_, cr1 = *(const LAS f32x4*)(cp_ + 4), ci0 = *(const LAS f32x4*)cq, ci1 = *(const LAS f32x4*)(cq + 4);
                    if (im) { v0 = -(cr0 * ai0 + ci0 * ar0); v1 = -(cr1 * ai1 + ci1 * ar1); } else { v0 = cr0 * ar0 - ci0 * ai0; v1 = cr1 * ar1 - ci1 * ai1; } }
                v4u w; w.x = pk2(v0[0], v0[1]); w.y = pk2(v0[2], v0[3]); w.z = pk2(v1[0], v1[1]); w.w = pk2(v1[2], v1[3]);
                *(v4u*)(B2 + (size_t)row * 512 + c8) = w; }
            bf16* WE = (bf16*)(ws + WS_SSM_WEND) + (size_t)g * 256 * 256;
            for (int i = tid; i < 64 * 32; i += 512) { const int n = 64 * q + (i >> 5), c8 = (i & 31) * 8; const int d = n >> 7, im = (n >> 6) & 1, p = n & 63;
                const int k = c8 >> 4, hp0 = c8 & 15; const int j = d == 0 ? 15 - k : k;
                const float ar = apr[(d * 17 + j) * 64 + p], ai = api[(d * 17 + j) * 64 + p];
                const LAS float* bp = bbr + (d * 64 + p) * 16 + hp0; const LAS float* bq = bbi + (d * 64 + p) * 16 + hp0;
                const f32x4 br0 = *(const LAS f32x4*)bp, br1 = *(const LAS f32x4*)(bp + 4), bi0 = *(const LAS f32x4*)bq, bi1 = *(const LAS f32x4*)(bq + 4);
                f32x4 v0, v1;
                if (im) { v0 = ar * bi0 + ai * br0; v1 = ar * bi1 + ai * br1; } else { v0 = ar * br0 - ai * bi0; v1 = ar * br1 - ai * bi1; }
                v4u w; w.x = pk2(v0[0], v0[1]); w.y = pk2(v0[2], v0[3]); w.z = pk2(v1[0], v1[1]); w.w = pk2(v1[2], v1[3]);
                *(v4u*)(WE + (size_t)n * 256 + c8) = w; }
            __syncthreads();
        }
        {
            __syncthreads();
            int cur_r = -1; ModVec mv; int it = 0;
            if (haspre) { mv = mvpre; cur_r = 8; }
            for (int ci = ci0; ci < 1152; ci += F.G, ++it) {
                LAS unsigned char* T = F.lds + (it & 1) * 32768;
                const bool lat = ci < 1024; const int r = lat ? (ci >> 7) : 8;
                if (r != cur_r) { load_modvec(mv, AIN(I_N1G) + 1024, mada + (9 + r) * 6144, lane); cur_r = r; }
                f32x4 v[2][4];
                if (lat) {
#pragma unroll
                    for (int u = 0; u < 2; ++u)
#pragma unroll
                        for (int j = 0; j < 4; ++j) { v[u][j] = bf4_to_f32(rawn[u][j]); rawn[u][j] = rawm[u][j]; }
                    const int cn = ci + 2 * F.G;
                    if (cn < 1024) {
#pragma unroll
                        for (int u = 0; u < 2; ++u)
#pragma unroll
                            for (int j = 0; j < 4; ++j) rawm[u][j] = *(const v2u*)(xl + (size_t)(P8_ROW0(cn) + 2 * wave + u) * 1024 + 4 * lane + 256 * j); }
                } else {
                    const int row0 = (ci - 1024) * 16;
                    if (it == 0 && haspre) {
#pragma unroll
                        for (int u = 0; u < 2; ++u)
#pragma unroll
                            for (int j = 0; j < 4; ++j) v[u][j] = vpre[u][j]; }
                    else
#pragma unroll
                    for (int u = 0; u < 2; ++u) norm_load_fix<8>(xc + (size_t)(row0 + 2 * wave + u) * 1024, (const bf16*)SLAB7 + (size_t)(row0 + 2 * wave + u) * 1024, mada + 8 * 6144 + 5120, lane, v[u]);
                }
#pragma unroll
                for (int u = 0; u < 2; ++u) { const int k = 2 * wave + u; f32x4 y[4]; norm_finish(v[u], mv, y);
#pragma unroll
                    for (int j = 0; j < 4; ++j) *(LAS unsigned long long*)(T + k * 2048 + (4 * lane + 256 * j) * 2) = (unsigned long long)pk2(y[j].x, y[j].y) | ((unsigned long long)pk2(y[j].z, y[j].w) << 32); }
                asm volatile("s_waitcnt lgkmcnt(0)\n\ts_barrier" ::: "memory");
                { const int g = tid >> 3;
#pragma unroll
                  for (int i = 0; i < 4; ++i) { const int piece = (tid & 7) + 8 * i; const int k = piece >> 1, hf = piece & 1;
                      const v4u w = *(const LAS v4u*)(T + k * 2048 + (g * 16 + hf * 8) * 2);
                      bf16* dst = lat ? AUL + ((size_t)(g * 1024 + ci)) * 256 : AUC + ((size_t)(g * 256 + (ci - 1024))) * 256;
                      *(GAS v4u*)(dst + k * 16 + hf * 8) = w; } }
            }
            __syncthreads();
#undef P8_ROW0
        }
    }
    GRID_BAR();
    { PHASE_ENV();
        pg8::Gemm g{AUL, (const bf16*)(ws + WS_SSM_WEND), 256, 256, 256}; pg8::SsmOrder S{F.G, (int)blockIdx.x, 5, 4};
        pg8::EpiSsm1 E{SEND};
        pg8::gemm_phase<pg8::EpiSsm1, pg8::SsmOrder, true>(F.lds, g, S, E);
        FRESH_IDS();
        {
            const int nfull = 320 - (320 / F.G) * F.G;
            if ((int)blockIdx.x >= nfull) {
                const int cw = ((int)blockIdx.x - nfull) * NWAVES + wave, ncw = (F.G - nfull) * NWAVES;
                LAS float* scr = (LAS float*)(F.lds + 57344 + wave * 8448);
                for (int it = cw; it < 64 * 16; it += ncw) p0_transpose_item(AIN(I_W2) + (size_t)4096 * 1024, 4096, 1024, (bf16*)(ws + WS_W2_1), 0, scr, it, lane);
            }
        }
        {
            const int nbn = (4096 + F.G - 1) / F.G, nb0 = (int)blockIdx.x * nbn;
            const bf16* W1T = (const bf16*)(ws + WS_W1_1); float* b2 = (float*)(ws + WS_BIAS2);
            for (int n = nb0 + wave; n < nb0 + nbn && n < 4096; n += NWAVES) {
                const v4u w0 = *(const v4u*)(W1T + (size_t)n * 1024 + lane * 16), w1 = *(const v4u*)(W1T + (size_t)n * 1024 + lane * 16 + 8);
                float wv[16]; wv[0] = __uint_as_float(w0.x << 16); wv[1] = __uint_as_float(w0.x & 0xffff0000u); wv[2] = __uint_as_float(w0.y << 16); wv[3] = __uint_as_float(w0.y & 0xffff0000u);
                wv[4] = __uint_as_float(w0.z << 16); wv[5] = __uint_as_float(w0.z & 0xffff0000u); wv[6] = __uint_as_float(w0.w << 16); wv[7] = __uint_as_float(w0.w & 0xffff0000u);
                wv[8] = __uint_as_float(w1.x << 16); wv[9] = __uint_as_float(w1.x & 0xffff0000u); wv[10] = __uint_as_float(w1.y << 16); wv[11] = __uint_as_float(w1.y & 0xffff0000u);
                wv[12] = __uint_as_float(w1.z << 16); wv[13] = __uint_as_float(w1.z & 0xffff0000u); wv[14] = __uint_as_float(w1.w << 16); wv[15] = __uint_as_float(w1.w & 0xffff0000u);
#pragma unroll
                for (int b = 0; b < 8; ++b) { const float* sh = mada + (9 + b) * 6144 + 3072 + lane * 16; float s = 0.f;
#pragma unroll
                    for (int q4 = 0; q4 < 4; ++q4) { const f32x4 sv = *(const f32x4*)(sh + 4 * q4); s += sv[0] * wv[4 * q4] + sv[1] * wv[4 * q4 + 1] + sv[2] * wv[4 * q4 + 2] + sv[3] * wv[4 * q4 + 3]; }
                    s = wave_sum(s);
                    if (lane == 0) b2[b * 4096 + n] = s; }
            }
        }
    }
    GRID_BAR();
    { PHASE_ENV();
        pg8::SsmOrder S{F.G, (int)blockIdx.x, 4, 8};
        {
            pg8::Gemm g0{AUL, (const bf16*)(ws + WS_SSM_B2), 256, 512, 512, (long)((WS_BIG + 32 * MiB) - WS_HB) - 4 * 128};
            pg8::EpiSsm2 E0{ZB, (const bf16*)nullptr, AIN(I_SD)};
            pg8::gemm_phase<pg8::EpiSsm2, pg8::SsmOrder, true, 4, 1>(F.lds, g0, S, E0); }
        {
            FRESH_IDS(); pg8::Unit su;
            for (int ui_ = 0; S.next(ui_, su); ++ui_) {
        if (tid < 256) {
            const int p = tid & 63, d = (tid >> 6) & 1, b = 2 * (su.pm - 5 * su.pn) + (tid >> 7), g = su.pn;
            const int gp = (d * 64 + g) * 64 + p;
            const float lr = AIN(I_SLRE)[gp], li = AIN(I_SLIM)[gp]; const float delta = expf(AIN(I_SLOG)[d * 64 + g]);
            const float mag = expf(lr * delta * 16.0f); float sn, cs; sincos_acc((double)li * (double)delta * 16.0, sn, cs);
            const float aTr = mag * cs, aTi = mag * sn;
            const bf16* Sg = SEND + (size_t)g * 1152 * 256 + d * 128 + p;
            bf16* Ag = ACR + (size_t)g * 1024 * 256 + d * 128 + p;
            float cr = 0.f, ci = 0.f;
            for (int s0 = 0; s0 < 144; s0 += 24) {
                float sr[24], si[24];
#pragma unroll
                for (int q = 0; q < 24; ++q) { const int s = s0 + q; const int ridx = (s < 16) ? (1024 + b * 16 + (d == 0 ? s : 15 - s)) : (b * 128 + (d == 0 ? s - 16 : 143 - s));
                    sr[q] = __uint_as_float((unsigned)__builtin_nontemporal_load(Sg + (size_t)ridx * 256) << 16); si[q] = __uint_as_float((unsigned)__builtin_nontemporal_load(Sg + (size_t)ridx * 256 + 64) << 16); }
#pragma unroll
                for (int q = 0; q < 24; ++q) { const int s = s0 + q;
                    if (s >= 16) { const int ridx = b * 128 + (d == 0 ? s - 16 : 143 - s); Ag[(size_t)ridx * 256] = (bf16)f2bf(cr); Ag[(size_t)ridx * 256 + 64] = (bf16)f2bf(ci); }
                    const float nr = aTr * cr - aTi * ci + sr[q], ni = aTr * ci + aTi * cr + si[q]; cr = nr; ci = ni; }
            }
        }
            }
            asm volatile("s_waitcnt vmcnt(0)" ::: "memory"); __syncthreads();
        }

        pg8::Gemm g{AUL, (const bf16*)(ws + WS_SSM_B2), 256, 512, 512, (long)((WS_BIG + 32 * MiB) - WS_HB) - 4 * 128};
        pg8::EpiSsm2 E{ZB, (const bf16*)nullptr, AIN(I_SD)};
        pg8::gemm_phase<pg8::EpiSsm2, pg8::SsmOrder, true, 4, 2>(F.lds, g, S, E);

    }
    GRID_BAR();
    { PHASE_ENV();
        pg8::Gemm g{ZB, (const bf16*)(ws + WS_WGLU), 1024, 1024, 1024}; pg8::StaticOrder S; S.init(ML, 2048, F.G, (int)blockIdx.x);
        pg8::EpiGlu E{xl, (F.G == 256) ? X3A : xl, (F.G == 256) ? X3B : xl, mada + 9 * 6144 + 2048, (bf16*)(ws + WS_H2B), AIN(I_N2G) + 1024, mada + 9 * 6144 + 4096, (float*)(ws + WS_ROWSS1)};
        pg8::gemm_phase<pg8::EpiGlu, pg8::StaticOrder, true>(F.lds, g, S, E);
    }
    GRID_BAR();
    { PHASE_ENV();
        pg8::Gemm g{(const bf16*)(ws + WS_H2B), (const bf16*)(ws + WS_W1_1), 1024, 1024, 1024}; pg8::StaticOrder S; S.init(ML, FF, F.G, (int)blockIdx.x);
        pg8::EpiRelu2<true> E{BIG, FF, (const float*)(ws + WS_ROWSS1), (const float*)(ws + WS_BIAS2)};
        pg8::gemm_phase<pg8::EpiRelu2<true>, pg8::StaticOrder, true>(F.lds, g, S, E);
    }
    GRID_BAR();
    if (F.G == 256) {
        PHASE_ENV();
        pg8::Gemm g{BIG, (const bf16*)(ws + WS_W2_1), FF, FF, FF}; pg8::StaticOrder S; S.init(ML, DM, F.G, (int)blockIdx.x, FF);
        pg8::EpiResidFinal E{X3A, X3B, outf, mada + 9 * 6144 + 5120, AIN(I_FG), (float*)(ws + WS_MP), (unsigned*)(ws + 2048), (LAS float*)(F.lds + 132096)};
        pg8::gemm_phase<pg8::EpiResidFinal, pg8::StaticOrder, true>(F.lds, g, S, E);
    } else {
    { PHASE_ENV();
        pg8::Gemm g{BIG, (const bf16*)(ws + WS_W2_1), FF, FF, FF}; pg8::StaticOrder S; S.init(ML, DM, F.G, (int)blockIdx.x, FF);
        pg8::EpiResid<false> E{xl, xc, HB, xc, mada + 9 * 6144 + 5120, (bf16*)nullptr};
        pg8::gemm_phase<pg8::EpiResid<false>, pg8::StaticOrder, true>(F.lds, g, S, E);
    }
    GRID_BAR();
    { PHASE_ENV();
        FRESH_IDS();
        const float* fg = AIN(I_FG);
        f32x4 gv[4];
#pragma unroll
        for (int j = 0; j < 4; ++j) gv[j] = *(const f32x4*)(fg + 4 * lane + 256 * j);
        const int per16 = (ML + NGW - 1) / NGW; const int r16e = (gw + 1) * per16 < ML ? (gw + 1) * per16 : ML;
        for (int row0 = gw * per16; row0 < r16e; row0 += 4) {
            f32x4 v[4][4];
#pragma unroll
            for (int u = 0; u < 4; ++u) if (row0 + u < r16e) norm_load(HB + (size_t)(row0 + u) * 1024, lane, v[u]);
#pragma unroll
            for (int u = 0; u < 4; ++u) { if (row0 + u >= r16e) continue; float s = 0.f;
#pragma unroll
                for (int j = 0; j < 4; ++j) s += (v[u][j].x * v[u][j].x + v[u][j].y * v[u][j].y) + (v[u][j].z * v[u][j].z + v[u][j].w * v[u][j].w);
                const float rstd = 1.0f / sqrtf(wave_sum(s) * (1.0f / 1024.0f) + NORM_EPS);
                f32x4* xr = (f32x4*)(outf + (size_t)(row0 + u) * 1024) + lane;
#pragma unroll
                for (int j = 0; j < 4; ++j) xr[64 * j] = v[u][j] * rstd * gv[j]; }
        }
    }
    }
#ifdef PROBE_TS
    GRID_BAR();
    if (blockIdx.x == 0) {
        asm volatile("s_waitcnt vmcnt(0)" ::: "memory"); __syncthreads();
#ifndef PROBE_SPAN
#define PROBE_SPAN 1
#endif
#ifndef PROBE_Q
#define PROBE_Q 1.0f
#endif
        const float ta = PROBE_Q * floorf((float)(tsbuf[PROBE_A + 1] - tsbuf[PROBE_A]) * 0.01f / PROBE_Q + 0.5f);
        const float tb = PROBE_Q * floorf((float)(tsbuf[PROBE_B + PROBE_SPAN] - tsbuf[PROBE_B]) * 0.01f / PROBE_Q + 0.5f);
        if (threadIdx.x == 0) args.out[7] += ta * 0.005f;
        for (int i = threadIdx.x; i < 67080; i += 512) args.out[4096 + i] += tb * 0.005f;
    }
#endif
#undef GRID_BAR
#undef FRESH_IDS
#undef AUL
#undef AUC
#undef ACR
#undef ZB
#undef SLAB7
#undef SEND
#undef PHASE_ENV
#undef AIN
#undef NORM_TO_HB
#undef NORM_ROW_OF
}

extern "C" void kernel_launch(void* const* d_in, const int* in_sizes, int n_in, void* d_out, int out_size, void* d_ws, size_t ws_size, hipStream_t stream) {
    static int grid = 0;
    if (grid == 0) {
        if (n_in != 29 || out_size != ML * DM || ws_size < WS_END) { fprintf(stderr, "kernel_launch: unexpected shapes (n_in %d out %d ws %zu)\n", n_in, out_size, ws_size); grid = -1; return; }
        int dev = 0, cus = 0;
        if (hipGetDevice(&dev) != hipSuccess || hipDeviceGetAttribute(&cus, hipDeviceAttributeMultiprocessorCount, dev) != hipSuccess) { grid = -1; return; }
        if (hipFuncSetAttribute((const void*)fwd_kernel, hipFuncAttributeMaxDynamicSharedMemorySize, LDS_BYTES) != hipSuccess) { fprintf(stderr, "kernel_launch: hipFuncSetAttribute failed\n"); grid = -1; return; }
        int per_cu = 0;
        if (hipOccupancyMaxActiveBlocksPerMultiprocessor(&per_cu, (const void*)fwd_kernel, NWAVES * 64, LDS_BYTES) != hipSuccess || per_cu < 1) fprintf(stderr, "kernel_launch: occupancy query says %d\n", per_cu);
        (void)hipGetLastError();
        grid = cus;
    }
    if (grid < 0) return;
    (void)hipMemsetAsync((char*)d_ws + WS_CTL, 0, CTL_ZERO_BYTES, stream);
    Args a{};
    for (int i = 0; i < 29; ++i) a.in[i] = (const float*)d_in[i];
    a.out = (float*)d_out; a.ws = (unsigned char*)d_ws;
    hipLaunchKernelGGL(fwd_kernel, dim3(grid), dim3(NWAVES * 64), LDS_BYTES, stream, a);
}
```
